# Optimizing an MI355X kernel written in HIP

```python
import math
import jax, jax.numpy as jnp
from jax import lax
import numpy as np

D_MODEL = 1024
BATCH = 16
SEQ = 2048
DEPTH = 2

CHUNK = 64
Q_BLOCK = 128

D_MIX = D_MODEL
A_HEADS = 4
A_HEAD_DIM = 64
A_WIDTH = A_HEADS * A_HEAD_DIM
DECAY_LORA = 64
ICLR_LORA = 64
GATE_LORA = 128
A_COLS = 3 * A_WIDTH + DECAY_LORA + ICLR_LORA + GATE_LORA
B_HEADS = 4
B_QK_DIM = 64
B_V_DIM = 2 * B_QK_DIM
B_WIDTH = B_HEADS * B_V_DIM
B_QK_COLS = B_HEADS * 2 * B_QK_DIM
B_COLS = 2 * B_QK_COLS + B_WIDTH
C_WIDTH = D_MIX - A_WIDTH - B_WIDTH
CONV_WIDTH = 31
C_COLS = 2 * C_WIDTH
N_IN = A_COLS + B_COLS + C_COLS
D_FF = 4 * D_MODEL
RMS_EPS = 1e-6
LN_EPS = 1e-5
LNX_EPS = 64e-5
NEG_INF = -1e30

kernel_name = 'hybrid_rwkv7_diffattn_conformer_block'


def rms_norm(x, g, eps=RMS_EPS):
    xf = x.astype(jnp.float32)
    y = xf * lax.rsqrt(jnp.mean(xf * xf, axis=-1, keepdims=True) + eps)
    return (y * g.astype(jnp.float32)).astype(x.dtype)


def layer_norm(x, w, b, eps):
    xf = x.astype(jnp.float32)
    mu = jnp.mean(xf, axis=-1, keepdims=True)
    var = jnp.mean(jnp.square(xf - mu), axis=-1, keepdims=True)
    y = (xf - mu) * lax.rsqrt(var + eps)
    return (y * w.astype(jnp.float32) + b.astype(jnp.float32)).astype(x.dtype)


def alibi_slopes(n_heads):
    return jnp.asarray([2.0 ** (-8.0 * (h + 1) / n_heads) for h in range(n_heads)], dtype=jnp.float32)


def rwkv7_mix(p_a, mu, w0, w2, a0, a2, g2, k_k, k_a, r_k, lnx_w, lnx_b):
    bsz, t_len, _ = p_a.shape
    prev = jnp.pad(p_a[:, :-1], ((0, 0), (1, 0), (0, 0)))
    p_a = p_a + mu * (prev - p_a)
    r, k, v, dw, da, dg = jnp.split(
        p_a, [A_WIDTH, 2 * A_WIDTH, 3 * A_WIDTH, 3 * A_WIDTH + DECAY_LORA,
              3 * A_WIDTH + DECAY_LORA + ICLR_LORA], axis=-1)
    w = -jax.nn.softplus(-(w0 + jnp.tanh(dw) @ w2)) - 0.5
    decay = jnp.exp(-jnp.exp(w.astype(jnp.float32)))
    a = jax.nn.sigmoid(a0 + da @ a2)
    g = jax.nn.sigmoid(dg) @ g2
    hs = (bsz, t_len, A_HEADS, A_HEAD_DIM)
    kk = (k * k_k).astype(jnp.float32).reshape(hs)
    kk = kk / jnp.maximum(jnp.linalg.norm(kk, axis=-1, keepdims=True), 1e-12)
    k = k * (1.0 + (a - 1.0) * k_a)
    rh = r.astype(jnp.float32).reshape(hs)
    kh = k.astype(jnp.float32).reshape(hs)
    vh = v.astype(jnp.float32).reshape(hs)
    ah = a.astype(jnp.float32).reshape(hs)
    wh = decay.reshape(hs)

    def step(state, inp):
        r_t, w_t, k_t, v_t, kk_t, a_t = inp
        sa = jnp.einsum('bhij,bhj->bhi', state, -kk_t)
        state = (state * w_t[:, :, None, :]
                 + sa[..., None] * (kk_t * a_t)[:, :, None, :]
                 + v_t[..., None] * k_t[:, :, None, :])
        y_t = jnp.einsum('bhij,bhj->bhi', state, r_t)
        return state, y_t

    xs = tuple(jnp.moveaxis(arr, 1, 0) for arr in (rh, wh, kh, vh, kk, ah))
    s0 = jnp.zeros((bsz, A_HEADS, A_HEAD_DIM, A_HEAD_DIM), jnp.float32)
    _, ys = lax.scan(step, s0, xs)
    y = jnp.moveaxis(ys, 0, 1)
    y = layer_norm(y, lnx_w.reshape(A_HEADS, A_HEAD_DIM), lnx_b.reshape(A_HEADS, A_HEAD_DIM), LNX_EPS)
    bonus = jnp.sum(rh * kh * r_k.astype(jnp.float32), axis=-1, keepdims=True) * vh
    out = (y + bonus).reshape(bsz, t_len, A_WIDTH).astype(p_a.dtype) * g
    return out


def diff_attention(p_b, q_norm_g, k_norm_g, lq1, lk1, lq2, lk2, subln_g, lambda_init):
    bsz, t_len, _ = p_b.shape
    q, k, v = jnp.split(p_b, [B_QK_COLS, 2 * B_QK_COLS], axis=-1)
    q = q.reshape(bsz, t_len, B_HEADS, 2, B_QK_DIM)
    k = k.reshape(bsz, t_len, B_HEADS, 2, B_QK_DIM)
    v = v.reshape(bsz, t_len, B_HEADS, B_V_DIM).astype(jnp.float32)
    q = rms_norm(q, q_norm_g) * (B_QK_DIM ** -0.5)
    k = rms_norm(k, k_norm_g)
    lam = (jnp.exp(jnp.sum(lq1.astype(jnp.float32) * lk1.astype(jnp.float32)))
           - jnp.exp(jnp.sum(lq2.astype(jnp.float32) * lk2.astype(jnp.float32))) + lambda_init)
    slopes = alibi_slopes(B_HEADS)[:, None, None, None]
    outs = []
    for blk in range(t_len // Q_BLOCK):
        q0 = blk * Q_BLOCK
        k_end = q0 + Q_BLOCK
        tq = jnp.arange(q0, k_end)
        tk = jnp.arange(k_end)
        s = jnp.einsum('bqhcd,bkhcd->bhcqk', q[:, q0:k_end], k[:, :k_end]).astype(jnp.float32)
        dist = jnp.abs(tq[:, None] - tk[None, :]).astype(jnp.float32)
        s = s - slopes * dist
        allowed = (tk[None, :] // CHUNK) <= (tq[:, None] // CHUNK)
        s = jnp.where(allowed, s, NEG_INF)
        p = jax.nn.softmax(s, axis=-1)
        attn = p[:, :, 0] - lam * p[:, :, 1]
        outs.append(jnp.einsum('bhqk,bkhe->bqhe', attn, v[:, :k_end]))
    o = jnp.concatenate(outs, axis=1)
    o = rms_norm(o, subln_g) * (1.0 - lambda_init)
    return o.reshape(bsz, t_len, B_WIDTH).astype(p_b.dtype)


def conformer_conv(p_c, conv_w, conv_b, ln_w, ln_b):
    a, b = jnp.split(p_c, 2, axis=-1)
    h = a * jax.nn.sigmoid(b)
    h = lax.conv_general_dilated(
        h, conv_w[:, None, :], window_strides=(1,), padding=[(CONV_WIDTH - 1, 0)],
        dimension_numbers=('NWC', 'WIO', 'NWC'), feature_group_count=C_WIDTH) + conv_b
    h = layer_norm(h, ln_w, ln_b, LN_EPS)
    return jax.nn.silu(h)


def setup_inputs(seed: int = 0) -> dict:
    key = jax.random.key(seed)
    ks = iter(jax.random.split(key, 40))

    def nrm(shape, scale):
        return jax.random.normal(next(ks), shape, jnp.float32) * scale

    def near_one(shape, noise=0.05):
        return 1.0 + nrm(shape, noise)

    L = DEPTH
    return {
        'x': nrm((BATCH, SEQ, D_MODEL), 1.0),
        'c': nrm((BATCH, D_MODEL), 1.0),
        'ada_w': nrm((L, D_MODEL, 6 * D_MODEL), 0.5 * D_MODEL ** -0.5),
        'ada_b': nrm((L, 6 * D_MODEL), 0.01),
        'norm1_g': near_one((L, D_MODEL)),
        'w_in': nrm((L, D_MODEL, N_IN), D_MODEL ** -0.5),
        'tshift_mu': jax.random.uniform(next(ks), (L, A_COLS), jnp.float32),
        'decay_w0': jax.random.uniform(next(ks), (L, A_WIDTH), jnp.float32, minval=-6.0, maxval=-1.0),
        'decay_w2': nrm((L, DECAY_LORA, A_WIDTH), 0.1 * DECAY_LORA ** -0.5),
        'iclr_a0': nrm((L, A_WIDTH), 0.1),
        'iclr_a2': nrm((L, ICLR_LORA, A_WIDTH), 0.5 * ICLR_LORA ** -0.5),
        'gate_g2': nrm((L, GATE_LORA, A_WIDTH), GATE_LORA ** -0.5),
        'k_k': 0.85 + nrm((L, A_WIDTH), 0.05),
        'k_a': near_one((L, A_WIDTH)),
        'r_k': nrm((L, A_HEADS, A_HEAD_DIM), 0.1),
        'lnx_w': near_one((L, A_WIDTH)),
        'lnx_b': nrm((L, A_WIDTH), 0.01),
        'q_norm_g': near_one((L, B_QK_DIM)),
        'k_norm_g': near_one((L, B_QK_DIM)),
        'lambda_q1': nrm((L, B_QK_DIM), 0.1),
        'lambda_k1': nrm((L, B_QK_DIM), 0.1),
        'lambda_q2': nrm((L, B_QK_DIM), 0.1),
        'lambda_k2': nrm((L, B_QK_DIM), 0.1),
        'subln_g': near_one((L, B_V_DIM)),
        'conv_w': nrm((L, CONV_WIDTH, C_WIDTH), CONV_WIDTH ** -0.5),
        'conv_b': nrm((L, C_WIDTH), 0.01),
        'conv_ln_w': near_one((L, C_WIDTH)),
        'conv_ln_b': nrm((L, C_WIDTH), 0.01),
        'w_out': nrm((L, D_MIX, D_MODEL), D_MIX ** -0.5),
        'norm2_g': near_one((L, D_MODEL)),
        'mlp_w1': nrm((L, D_MODEL, D_FF), D_MODEL ** -0.5),
        'mlp_w2': nrm((L, D_FF, D_MODEL), D_FF ** -0.5),
    }


def reference(x, c, ada_w, ada_b, norm1_g, w_in, tshift_mu, decay_w0, decay_w2, iclr_a0,
              iclr_a2, gate_g2, k_k, k_a, r_k, lnx_w, lnx_b, q_norm_g, k_norm_g,
              lambda_q1, lambda_k1, lambda_q2, lambda_k2, subln_g, conv_w, conv_b,
              conv_ln_w, conv_ln_b, w_out, norm2_g, mlp_w1, mlp_w2):
    cond = jax.nn.silu(c)
    for i in range(DEPTH):
        mod = cond @ ada_w[i] + ada_b[i]
        sh1, sc1, g1, sh2, sc2, g2 = [m[:, None, :] for m in jnp.split(mod, 6, axis=-1)]
        lambda_init = 0.8 - 0.6 * math.exp(-0.3 * i)

        h = rms_norm(x, norm1_g[i]) * (1.0 + sc1) + sh1
        proj = h @ w_in[i]
        p_a, p_b, p_c = jnp.split(proj, [A_COLS, A_COLS + B_COLS], axis=-1)
        y_a = rwkv7_mix(p_a, tshift_mu[i], decay_w0[i], decay_w2[i], iclr_a0[i], iclr_a2[i],
                        gate_g2[i], k_k[i], k_a[i], r_k[i], lnx_w[i], lnx_b[i])
        y_b = diff_attention(p_b, q_norm_g[i], k_norm_g[i], lambda_q1[i], lambda_k1[i],
                             lambda_q2[i], lambda_k2[i], subln_g[i], lambda_init)
        y_c = conformer_conv(p_c, conv_w[i], conv_b[i], conv_ln_w[i], conv_ln_b[i])
        y = jnp.concatenate([y_a, y_b, y_c], axis=-1) @ w_out[i]
        x = x + g1 * y

        h = rms_norm(x, norm2_g[i]) * (1.0 + sc2) + sh2
        f = jnp.square(jax.nn.relu(h @ mlp_w1[i])) @ mlp_w2[i]
        x = x + g2 * f
    return x
```

```cpp
#include <hip/hip_runtime.h>
#include <hip/hip_cooperative_groups.h>
#include <hip/hip_fp16.h>
#include <cstdio>
#include <cstdint>
namespace cg = cooperative_groups;
namespace pg8 {
#define PG8_LAS __attribute__((address_space(3)))
typedef unsigned short bf16_t;
typedef short bf16x8 __attribute__((ext_vector_type(8)));
typedef float f32x4 __attribute__((ext_vector_type(4)));
typedef unsigned u32x4 __attribute__((ext_vector_type(4)));
constexpr int BM = 256, BK = 64, HALF = 128, HTB = HALF * BK * 2  , STAGE_BYTES = 8 * HTB, NXCD = 8, WGM = 8;

__host__ __device__ __forceinline__ int lds_byte(int r, int c) { const int st = (r >> 4) * 2 + (c >> 5), rr = r & 15, cc = c & 31, ob = rr * 64 + cc * 2; return st * 1024 + (ob ^ (((ob >> 9) & 1) << 5)); }
__host__ __device__ __forceinline__ void stage_rc(int b, int& R, int& C) { const int st = b / 1024, sb = b % 1024, swz = sb ^ (((sb >> 9) & 1) << 5); R = (st >> 1) * 16 + swz / 64; C = (st & 1) * 32 + (swz % 64) / 2; }
__host__ __device__ __forceinline__ int perm32(int rho) { const int n = rho >> 4, i = rho & 15; return 8 * (i >> 2) + 4 * n + (i & 3); }

struct Unit { int pm, pn; };
struct Gemm { const bf16_t* A; const bf16_t* Bt; int M, N, K; };

struct StaticOrder {
    int nM, nN, nwg, G, c;
    __host__ __device__ void init(int M, int N, int G_, int c_) { nM = M / BM; nN = N / BM; nwg = nM * nN; G = G_; c = c_; }
    __host__ __device__ bool next(int i, Unit& u) const {
        const long L = (long)i * G + c; if (L >= nwg) return false;
        int wgid = (int)L; { const int q = nwg / NXCD, r = nwg % NXCD, xcd = wgid % NXCD, off = wgid / NXCD; wgid = (xcd < r ? xcd * (q + 1) : r * (q + 1) + (xcd - r) * q) + off; }
        const int nig = WGM * nN, gid = wgid / nig, fm = gid * WGM, gsz = (nM - fm) < WGM ? (nM - fm) : WGM;
        u.pm = fm + ((wgid % nig) % gsz); u.pn = (wgid % nig) / gsz; return true;
    }
    __device__ __forceinline__ void a_ready(const Unit&) const {}
    __device__ __forceinline__ void done(const Unit&) const {}
};

typedef __bf16 bf16x2_t __attribute__((ext_vector_type(2)));
typedef float f32x2_t __attribute__((ext_vector_type(2)));
__device__ __forceinline__ unsigned cvt_pk_bf16(float lo, float hi) { const f32x2_t v = {lo, hi}; return __builtin_bit_cast(unsigned, __builtin_convertvector(v, bf16x2_t)); }
template <int ACT  > struct EpiAct {
    static constexpr bool PERM = true, AFTER_DRAIN = false;
    bf16_t* O; int ldc;
    __device__ __forceinline__ void operator()(const f32x4 (&acc)[2][2][4][2], const Unit& u, int wr, int wc, int fr, int fq) const {
        const int row0 = u.pm * BM + wr * 64 + fr; const int col0 = u.pn * BM + wc * 32 + 8 * fq;
#pragma unroll
        for (int ai = 0; ai < 2; ++ai)
#pragma unroll
            for (int m = 0; m < 4; ++m) { bf16_t* rowp = O + (size_t)(row0 + ai * HALF + m * 16) * ldc + col0;
#pragma unroll
                for (int bj = 0; bj < 2; ++bj) { f32x4 v0 = acc[ai][bj][m][0], v1 = acc[ai][bj][m][1];
                    if (ACT == 1) {
#pragma unroll
                        for (int e = 0; e < 4; ++e) { float a = fmaxf(v0[e], 0.f), b = fmaxf(v1[e], 0.f); v0[e] = a * a; v1[e] = b * b; } }
                    u32x4 w; w.x = cvt_pk_bf16(v0[0], v0[1]); w.y = cvt_pk_bf16(v0[2], v0[3]); w.z = cvt_pk_bf16(v1[0], v1[1]); w.w = cvt_pk_bf16(v1[2], v1[3]);
                    *(u32x4*)(rowp + bj * HALF) = w; } }
    }
};
struct EpiRes {
    static constexpr bool PERM = false, AFTER_DRAIN = false;
    const float* base; float* out; const float* gate;
    __device__ __forceinline__ void operator()(const f32x4 (&acc)[2][2][4][2], const Unit& u, int wr, int wc, int fr, int fq) const {
        const int col0 = u.pn * BM + wc * 32 + 4 * fq;
        const float* gp = gate + (size_t)((u.pm * BM) >> 11) * 6144 + col0;
        f32x4 gv[2][2];
#pragma unroll
        for (int bj = 0; bj < 2; ++bj)
#pragma unroll
            for (int n = 0; n < 2; ++n) gv[bj][n] = *(const f32x4*)(gp + bj * HALF + n * 16);
#pragma unroll
        for (int ai = 0; ai < 2; ++ai)
#pragma unroll
            for (int m = 0; m < 4; ++m) { const size_t off = (size_t)(u.pm * BM + ai * HALF + wr * 64 + m * 16 + fr) * 1024 + col0;
#pragma unroll
                for (int bj = 0; bj < 2; ++bj)
#pragma unroll
                    for (int n = 0; n < 2; ++n) { const f32x4 bs = *(const f32x4*)(base + off + bj * HALF + n * 16);
                        *(f32x4*)(out + off + bj * HALF + n * 16) = bs + gv[bj][n] * acc[ai][bj][m][n]; } }
    }
};
typedef unsigned u32x2_ __attribute__((ext_vector_type(2)));
__device__ __forceinline__ float shx_(float v, int m) { int l = __builtin_amdgcn_mbcnt_hi(~0u, __builtin_amdgcn_mbcnt_lo(~0u, 0u)); asm volatile("" : "+v"(l));
    return __builtin_bit_cast(float, __builtin_amdgcn_ds_bpermute((l ^ m) << 2, __builtin_bit_cast(int, v))); }
struct EpiDyn {
    static constexpr bool PERM = true, AFTER_DRAIN = false;
    int kind; bf16_t* O; int ldc; const float* base; float* out; const float* gate;
    const float* ssq_in; const float* bias; int bstride; const PG8_LAS float* rtab;
    bf16_t* XS; float* ssq_out; const float* gn; const float* scv;
    __device__ __forceinline__ void operator()(const f32x4 (&acc)[2][2][4][2], const Unit& u, int wr, int wc, int fr, int fq, int ui) const {
        const int row0 = u.pm * BM + wr * 64 + fr; const int col0 = u.pn * BM + wc * 32 + 8 * fq; const int b = (u.pm * BM) >> 11;
        if (kind < 2) {
            f32x4 bv[2][2];
#pragma unroll
            for (int bj = 0; bj < 2; ++bj)
#pragma unroll
                for (int n = 0; n < 2; ++n) bv[bj][n] = ssq_in ? *(const f32x4*)(bias + (size_t)b * bstride + col0 + bj * HALF + n * 4) : (f32x4){0.f, 0.f, 0.f, 0.f};
#pragma unroll
            for (int ai = 0; ai < 2; ++ai)
#pragma unroll
                for (int m = 0; m < 4; ++m) { const int row = row0 + ai * HALF + m * 16; bf16_t* rowp = O + (size_t)row * ldc + col0;
                    float rstd = 1.f;
                    if (ssq_in) rstd = rtab[ui * 256 + wr * 64 + fr + ai * HALF + m * 16];
#pragma unroll
                    for (int bj = 0; bj < 2; ++bj) { f32x4 v0 = acc[ai][bj][m][0] * rstd + bv[bj][0], v1 = acc[ai][bj][m][1] * rstd + bv[bj][1];
                        if (kind == 1) {
#pragma unroll
                            for (int e = 0; e < 4; ++e) { float a = fmaxf(v0[e], 0.f), c = fmaxf(v1[e], 0.f); v0[e] = a * a; v1[e] = c * c; } }
                        u32x4 w; w.x = cvt_pk_bf16(v0[0], v0[1]); w.y = cvt_pk_bf16(v0[2], v0[3]); w.z = cvt_pk_bf16(v1[0], v1[1]); w.w = cvt_pk_bf16(v1[2], v1[3]);
                        *(u32x4*)(rowp + bj * HALF) = w; } }
        } else {
            const float* gp = gate + (size_t)b * 6144 + col0;
            f32x4 gv[2][2], gm[2][2];
#pragma unroll
            for (int bj = 0; bj < 2; ++bj)
#pragma unroll
                for (int n = 0; n < 2; ++n) { gv[bj][n] = *(const f32x4*)(gp + bj * HALF + n * 4);
                    gm[bj][n] = XS ? *(const f32x4*)(gn + col0 + bj * HALF + n * 4) * (*(const f32x4*)(scv + (size_t)b * 6144 + col0 + bj * HALF + n * 4) + 1.f) : (f32x4){0.f, 0.f, 0.f, 0.f}; }
#pragma unroll
            for (int aim = 0; aim < 4; ++aim) { const int ai = aim >> 1, m0 = (aim & 1) * 2;
                f32x4 bs[4][2][2];
#pragma unroll
                for (int m = m0; m < m0 + 2; ++m) { const size_t off = (size_t)(row0 + ai * HALF + m * 16) * 1024 + col0;
#pragma unroll
                    for (int bj = 0; bj < 2; ++bj)
#pragma unroll
                        for (int n = 0; n < 2; ++n) bs[m][bj][n] = *(const f32x4*)(base + off + bj * HALF + n * 4); }
                asm volatile("" ::: "memory");
#pragma unroll
                for (int m = m0; m < m0 + 2; ++m) { const int row = row0 + ai * HALF + m * 16; const size_t off = (size_t)row * 1024 + col0; float sq = 0.f;
#pragma unroll
                    for (int bj = 0; bj < 2; ++bj)
#pragma unroll
                        for (int n = 0; n < 2; ++n) {
                            const f32x4 o = bs[m][bj][n] + gv[bj][n] * acc[ai][bj][m][n];
                            *(f32x4*)(out + off + bj * HALF + n * 4) = o;
                            if (XS) { sq += (o[0] * o[0] + o[1] * o[1]) + (o[2] * o[2] + o[3] * o[3]); const f32x4 x = o * gm[bj][n];
                                u32x2_ w; w.x = cvt_pk_bf16(x[0], x[1]); w.y = cvt_pk_bf16(x[2], x[3]); *(u32x2_*)(XS + off + bj * HALF + n * 4) = w; } }
                    if (XS) { sq += shx_(sq, 16); sq += shx_(sq, 32); if (fq == 0) ssq_out[(size_t)row * 16 + u.pn * 4 + wc] = sq; } }
                asm volatile("" ::: "memory");
            }
        }
    }
};
template <class Epi, class Sched, bool ALIGN_EPI = false, bool SP2 = false>
__device__ __forceinline__ void gemm_phase(PG8_LAS unsigned char* lds, const Gemm g, const Sched& S, const Epi& E, const int tid_in) {
    int tid = tid_in; asm volatile("" : "+v"(tid));
    const int wid = __builtin_amdgcn_readfirstlane(tid >> 6), lane = tid & 63, wr = wid >> 2, wc = wid & 3, fr = lane & 15, fq = lane >> 4;
    const int K = g.K, nt = K / BK;
    unsigned voffA[2], voffB[2];
#pragma unroll
    for (int i = 0; i < 2; ++i) { int R, C; stage_rc(tid * 16 + i * 8192, R, C); const int Rb = Epi::PERM ? ((R & ~31) + perm32(R & 31)) : R;
        voffA[i] = (unsigned)(R * K + C) * 2u; voffB[i] = (unsigned)(Rb * K + C) * 2u; }
    const size_t kstep = (size_t)(BK * 2);
    const size_t hstep = (size_t)HALF * K * 2;
    const size_t tstep = 2 * hstep;
    const unsigned ldsw = (unsigned)wid * 1024u;
    const int aoff = lds_byte(wr * 64 + fr, fq * 8), boff = lds_byte(wc * 32 + fr, fq * 8);
#define PG8_SA(b, h) (((b) * 2 + (h)) * HTB)
#define PG8_SB(b, h) ((4 + (b) * 2 + (h)) * HTB)
#define PG8_STAGE(bufoff, gbase, voff) do { _Pragma("unroll") for (int _i = 0; _i < 2; ++_i) \
        __builtin_amdgcn_global_load_lds((const unsigned*)((const char*)(gbase) + (voff)[_i]), (PG8_LAS unsigned*)(lds + (bufoff) + ldsw + _i * 8192), 16, 0, 0); } while (0)
#define PG8_LDA(dst, b, h) do { _Pragma("unroll") for (int m = 0; m < 4; ++m) _Pragma("unroll") for (int k = 0; k < 2; ++k) dst[m][k] = *(const PG8_LAS bf16x8*)(lds + PG8_SA(b, h) + aoff + m * 2048 + k * 1024); } while (0)
#define PG8_LDB(dst, b, h) do { _Pragma("unroll") for (int n = 0; n < 2; ++n) _Pragma("unroll") for (int k = 0; k < 2; ++k) dst[n][k] = *(const PG8_LAS bf16x8*)(lds + PG8_SB(b, h) + boff + n * 2048 + k * 1024); } while (0)
#define PG8_MMA(ai, bj, At, Bt) do { __builtin_amdgcn_s_setprio(1); _Pragma("unroll") for (int m = 0; m < 4; ++m) _Pragma("unroll") for (int n = 0; n < 2; ++n) _Pragma("unroll") for (int k = 0; k < 2; ++k) \
        acc[ai][bj][m][n] = __builtin_amdgcn_mfma_f32_16x16x32_bf16(Bt[n][k], At[m][k], acc[ai][bj][m][n], 0, 0, 0); __builtin_amdgcn_s_setprio(0); } while (0)
#define PG8_WAIT_V(n) asm volatile("s_waitcnt vmcnt(" #n ")" ::: "memory")
#define PG8_WAIT_L(n) asm volatile("s_waitcnt lgkmcnt(" #n ")" ::: "memory")
#define PG8_BAR __builtin_amdgcn_s_barrier()
#define PG8_SCHED __builtin_amdgcn_sched_barrier(0)
    Unit cur, nxt; int ui = 0;
    if (!S.next(0, cur)) return;
    f32x4 acc[2][2][4][2];
#pragma unroll
    for (int a = 0; a < 2; ++a)
#pragma unroll
        for (int b = 0; b < 2; ++b)
#pragma unroll
            for (int m = 0; m < 4; ++m)
#pragma unroll
                for (int n = 0; n < 2; ++n) acc[a][b][m][n] = (f32x4){0.f, 0.f, 0.f, 0.f};
    bf16x8 At[4][2], B0[2][2], B1[2][2];
    const char* cA = (const char*)g.A + (size_t)cur.pm * tstep; const char* cB = (const char*)g.Bt + (size_t)cur.pn * tstep;
    S.a_ready(cur);
    if constexpr (SP2) {
        PG8_STAGE(PG8_SB(0, 0), cB, voffB); PG8_STAGE(PG8_SB(0, 1), cB + hstep, voffB); PG8_STAGE(PG8_SA(0, 0), cA, voffA); PG8_STAGE(PG8_SA(0, 1), cA + hstep, voffA);
        if (wr == 1) PG8_BAR;
        PG8_WAIT_V(2); PG8_BAR;
        PG8_STAGE(PG8_SB(1, 0), cB + kstep, voffB); PG8_STAGE(PG8_SA(1, 0), cA + kstep, voffA); PG8_STAGE(PG8_SB(1, 1), cB + hstep + kstep, voffB);
        PG8_WAIT_V(6); PG8_BAR;
    } else {
        PG8_STAGE(PG8_SB(0, 0), cB, voffB); PG8_STAGE(PG8_SA(0, 0), cA, voffA); PG8_STAGE(PG8_SB(0, 1), cB + hstep, voffB); PG8_STAGE(PG8_SA(0, 1), cA + hstep, voffA);
        if (wr == 1) PG8_BAR;
        PG8_WAIT_V(4); PG8_BAR;
        PG8_STAGE(PG8_SB(1, 0), cB + kstep, voffB); PG8_STAGE(PG8_SA(1, 0), cA + kstep, voffA); PG8_STAGE(PG8_SB(1, 1), cB + hstep + kstep, voffB);
        PG8_WAIT_V(6); PG8_BAR;
    }
    for (;;) {
        const bool has_next = S.next(ui + 1, nxt);
        const char* nA = has_next ? (const char*)g.A + (size_t)nxt.pm * tstep : cA; const char* nB = has_next ? (const char*)g.Bt + (size_t)nxt.pn * tstep : cB;
        for (int t = 0; t < nt; t += 2) {
            const bool last = (t == nt - 2);
            const char* a1 = cA + (size_t)(t + 1) * kstep;
            const char* a2 = last ? nA : cA + (size_t)(t + 2) * kstep; const char* b2 = last ? nB : cB + (size_t)(t + 2) * kstep;
            const char* a3 = a2 + kstep; const char* b3 = b2 + kstep;
            if (last && has_next) S.a_ready(nxt);
            if constexpr (SP2) {
            PG8_LDB(B0, 0, 0); PG8_LDB(B1, 0, 1); PG8_SCHED; PG8_LDA(At, 0, 0); PG8_STAGE(PG8_SA(1, 1), a1 + hstep, voffA);
            PG8_WAIT_V(8); PG8_WAIT_L(0); PG8_BAR; PG8_MMA(0, 0, At, B0); PG8_MMA(0, 1, At, B1); PG8_BAR; PG8_SCHED;
            PG8_LDA(At, 0, 1); PG8_STAGE(PG8_SB(0, 0), b2, voffB); PG8_STAGE(PG8_SB(0, 1), b2 + hstep, voffB); PG8_STAGE(PG8_SA(0, 0), a2, voffA);
            PG8_WAIT_V(8); PG8_WAIT_L(0); PG8_BAR; PG8_MMA(1, 0, At, B0); PG8_MMA(1, 1, At, B1); PG8_BAR; PG8_SCHED;
            PG8_LDB(B0, 1, 0); PG8_LDB(B1, 1, 1); PG8_SCHED; PG8_LDA(At, 1, 0); PG8_STAGE(PG8_SA(0, 1), a2 + hstep, voffA);
            PG8_WAIT_V(8); PG8_WAIT_L(0); PG8_BAR; PG8_MMA(0, 0, At, B0); PG8_MMA(0, 1, At, B1); PG8_BAR; PG8_SCHED;
            PG8_LDA(At, 1, 1); PG8_STAGE(PG8_SB(1, 0), b3, voffB); PG8_STAGE(PG8_SB(1, 1), b3 + hstep, voffB); PG8_STAGE(PG8_SA(1, 0), a3, voffA);
            PG8_WAIT_V(8); PG8_WAIT_L(0); PG8_BAR; PG8_MMA(1, 0, At, B0); PG8_MMA(1, 1, At, B1); PG8_BAR; PG8_SCHED;
            } else {
            PG8_LDB(B0, 0, 0); PG8_SCHED; PG8_LDA(At, 0, 0); PG8_STAGE(PG8_SA(1, 1), a1 + hstep, voffA);
            PG8_WAIT_L(8); PG8_BAR; PG8_WAIT_L(0); PG8_MMA(0, 0, At, B0); PG8_BAR; PG8_SCHED;
            PG8_LDB(B1, 0, 1); PG8_STAGE(PG8_SB(0, 0), b2, voffB);
            PG8_BAR; PG8_WAIT_L(0); PG8_MMA(0, 1, At, B1); PG8_BAR;
            PG8_LDA(At, 0, 1); PG8_STAGE(PG8_SA(0, 0), a2, voffA);
            PG8_BAR; PG8_WAIT_L(0); PG8_MMA(1, 0, At, B0); PG8_BAR; PG8_SCHED;
            PG8_STAGE(PG8_SB(0, 1), b2 + hstep, voffB);
            PG8_WAIT_V(6); PG8_BAR; PG8_MMA(1, 1, At, B1); PG8_BAR;
            PG8_LDB(B0, 1, 0); PG8_SCHED; PG8_LDA(At, 1, 0); PG8_STAGE(PG8_SA(0, 1), a2 + hstep, voffA);
            PG8_WAIT_L(8); PG8_BAR; PG8_WAIT_L(0); PG8_MMA(0, 0, At, B0); PG8_BAR; PG8_SCHED;
            PG8_LDB(B1, 1, 1); PG8_STAGE(PG8_SB(1, 0), b3, voffB);
            PG8_BAR; PG8_WAIT_L(0); PG8_MMA(0, 1, At, B1); PG8_BAR;
            PG8_LDA(At, 1, 1); PG8_STAGE(PG8_SA(1, 0), a3, voffA);
            PG8_BAR; PG8_WAIT_L(0); PG8_MMA(1, 0, At, B0); PG8_BAR; PG8_SCHED;
            PG8_STAGE(PG8_SB(1, 1), b3 + hstep, voffB);
            PG8_WAIT_V(6); PG8_BAR; PG8_MMA(1, 1, At, B1); PG8_BAR;
            }
        }
        if constexpr (ALIGN_EPI) { if (wr == 0) PG8_BAR; }
        if constexpr (!Epi::AFTER_DRAIN) { E(acc, cur, wr, wc, fr, fq, ui); S.done(cur); }
        if (!has_next) break;
#pragma unroll
        for (int a = 0; a < 2; ++a)
#pragma unroll
            for (int b = 0; b < 2; ++b)
#pragma unroll
                for (int m = 0; m < 4; ++m)
#pragma unroll
                    for (int n = 0; n < 2; ++n) acc[a][b][m][n] = (f32x4){0.f, 0.f, 0.f, 0.f};
        cur = nxt; cA = nA; cB = nB; ++ui;
        if constexpr (ALIGN_EPI) { if (wr == 1) PG8_BAR; }
    }
    PG8_WAIT_V(0);
    if constexpr (!ALIGN_EPI) { if (wr == 0) PG8_BAR; }
    PG8_BAR;
    if constexpr (Epi::AFTER_DRAIN) { E.fused(acc, cur, wr, wc, fr, fq, lds, wid, lane); S.done(cur); }
#undef PG8_SA
#undef PG8_SB
#undef PG8_STAGE
#undef PG8_LDA
#undef PG8_LDB
#undef PG8_MMA
#undef PG8_WAIT_V
#undef PG8_WAIT_L
#undef PG8_BAR
#undef PG8_SCHED
}
}

constexpr int BATCH = 16, T = 2048, D = 1024, M = BATCH * T, NIN = 3072, FF = 4096;
constexpr size_t MiB = 1u << 20;
constexpr size_t WS_WB = 1 * MiB;
constexpr size_t WB_LAYER = 24 * MiB, WB_IN = 0, WB_OUT = 6 * MiB, WB_W1 = 8 * MiB, WB_W2 = 16 * MiB;
constexpr size_t WS_MOD = 49 * MiB;
constexpr size_t WS_LORA = 50 * MiB;
constexpr size_t LORA_LAYER = 131072, LORA_W2 = 0, LORA_A2 = 32768, LORA_G2 = 65536;
constexpr size_t WS_SCAL = 51 * MiB;
constexpr size_t WS_XN = 53 * MiB;
constexpr size_t WS_SW = WS_XN, WS_YR = WS_XN + 32 * MiB;
constexpr size_t WS_Y = 117 * MiB;
constexpr size_t WS_P = 181 * MiB;
constexpr size_t WS_S16 = 373 * MiB;
constexpr size_t S16_ARR = 16 * MiB;
constexpr size_t WS_G = 453 * MiB;
constexpr size_t WS_H = WS_P;
constexpr size_t WS_VT = 469 * MiB;
constexpr size_t WS_SSQA = 501 * MiB, WS_SSQB = 503 * MiB;
constexpr size_t WS_BIAS = 505 * MiB;
constexpr size_t WS_END = 506 * MiB;
constexpr int LDS_BYTES = 147456;
constexpr size_t WS_BAR = 16384;
constexpr int LDS_CTL = LDS_BYTES - 64;

#define LAS __attribute__((address_space(3)))
typedef unsigned short bf16;
typedef _Float16 h16;
typedef float f32x4 __attribute__((ext_vector_type(4)));
typedef float f32x2 __attribute__((ext_vector_type(2)));
typedef short bf16x8 __attribute__((ext_vector_type(8)));
typedef unsigned u32x4 __attribute__((ext_vector_type(4)));
typedef unsigned u32x2 __attribute__((ext_vector_type(2)));
typedef h16 h16x4 __attribute__((ext_vector_type(4)));
typedef h16 h16x8 __attribute__((ext_vector_type(8)));

__device__ __forceinline__ unsigned pk2(float lo, float hi) { return pg8::cvt_pk_bf16(lo, hi); }
__device__ __forceinline__ unsigned f2bf(float f) { return pg8::cvt_pk_bf16(f, 0.f) & 0xffffu; }
__device__ __forceinline__ float bf2f(unsigned h) { return __builtin_bit_cast(float, h << 16); }
__device__ __forceinline__ float bflo(unsigned w) { return __builtin_bit_cast(float, w << 16); }
__device__ __forceinline__ float bfhi(unsigned w) { return __builtin_bit_cast(float, w & 0xffff0000u); }
__device__ __forceinline__ float shx(float v, int m) { int l = __builtin_amdgcn_mbcnt_hi(~0u, __builtin_amdgcn_mbcnt_lo(~0u, 0u)); asm volatile("" : "+v"(l));
    return __builtin_bit_cast(float, __builtin_amdgcn_ds_bpermute((l ^ m) << 2, __builtin_bit_cast(int, v))); }
__device__ __forceinline__ float wave_sum(float v) {
#pragma unroll
    for (int o = 1; o < 64; o <<= 1) v += shx(v, o);
    return v;
}
__device__ __forceinline__ float sum16(float v) {
    v += shx(v, 1); v += shx(v, 2); v += shx(v, 4); v += shx(v, 8); return v;
}
__device__ __forceinline__ float sigmoidf_(float x) { return 1.f / (1.f + __expf(-x)); }
#define LDS_WAIT() asm volatile("s_waitcnt lgkmcnt(0)" ::: "memory")

struct Args { const float* in[32]; float* out; unsigned char* ws; int ph_lo, ph_hi; };

__device__ __forceinline__ const float* inp(const Args& a, int i) { asm volatile("" : "+s"(i)); return a.in[i]; }
__device__ __forceinline__ void p0_transpose_item(const float* W, int K, int N, bf16* WT, float* scr, int item, int lane) {
    const int nblk = N / 32, kb = item / nblk, nb = item % nblk, k0 = 64 * kb, n0 = 32 * nb;
#pragma unroll 8
    for (int i = 0; i < 32; ++i) { const int kk = 2 * i + (lane >> 5); scr[kk * 33 + (lane & 31)] = W[(size_t)(k0 + kk) * N + n0 + (lane & 31)]; }
    LDS_WAIT(); asm volatile("" ::: "memory");
    const int c = lane & 7;
#pragma unroll
    for (int j = 0; j < 4; ++j) { const int n = (lane >> 3) + 8 * j; const float* s = scr + (8 * c) * 33 + n;
        u32x4 o; o.x = pk2(s[0 * 33], s[1 * 33]); o.y = pk2(s[2 * 33], s[3 * 33]); o.z = pk2(s[4 * 33], s[5 * 33]); o.w = pk2(s[6 * 33], s[7 * 33]);
        *(u32x4*)(WT + (size_t)(n0 + n) * K + k0 + 8 * c) = o; }
    LDS_WAIT(); asm volatile("" ::: "memory");
}
__device__ __forceinline__ void phase_weights(const Args& a, unsigned char* lds, int wave, int lane) {
    float* scr = (float*)(lds + wave * 16384);
    const int gw = blockIdx.x * 8 + wave, NGW = gridDim.x * 8;
    constexpr int I_IN = 16 * 96, I_OUT = 16 * 32, I_W1 = 16 * 128, I_W2 = 64 * 32, I_L2 = 8, I_G2 = 16;
    constexpr int PER = I_IN + I_OUT + I_W1 + I_W2 + 2 * I_L2 + I_G2;
    for (int it = gw; it < 2 * PER; it += NGW) {
        const int l = it / PER; int r = it % PER;
        unsigned char* wb = a.ws + WS_WB + (size_t)l * WB_LAYER; unsigned char* lo = a.ws + WS_LORA + (size_t)l * LORA_LAYER;
        if (r < I_IN) { p0_transpose_item(inp(a, 5) + (size_t)l * D * NIN, D, NIN, (bf16*)(wb + WB_IN), scr, r, lane); continue; } r -= I_IN;
        if (r < I_OUT) { p0_transpose_item(inp(a, 28) + (size_t)l * D * D, D, D, (bf16*)(wb + WB_OUT), scr, r, lane); continue; } r -= I_OUT;
        if (r < I_W1) { p0_transpose_item(inp(a, 30) + (size_t)l * D * FF, D, FF, (bf16*)(wb + WB_W1), scr, r, lane); continue; } r -= I_W1;
        if (r < I_W2) { p0_transpose_item(inp(a, 31) + (size_t)l * FF * D, FF, D, (bf16*)(wb + WB_W2), scr, r, lane); continue; } r -= I_W2;
        if (r < I_L2) { p0_transpose_item(inp(a, 8) + (size_t)l * 64 * 256, 64, 256, (bf16*)(lo + LORA_W2), scr, r, lane); continue; } r -= I_L2;
        if (r < I_L2) { p0_transpose_item(inp(a, 10) + (size_t)l * 64 * 256, 64, 256, (bf16*)(lo + LORA_A2), scr, r, lane); continue; } r -= I_L2;
        p0_transpose_item(inp(a, 11) + (size_t)l * 128 * 256, 128, 256, (bf16*)(lo + LORA_G2), scr, r, lane);
    }
}
__device__ __forceinline__ void phase_ada(const Args& a, unsigned char* lds, int tid, int wave, int lane) {
    float* cond = (float*)lds; float* red = cond + 16384;
    const float* c = inp(a, 1); float* mod = (float*)(a.ws + WS_MOD);
    for (int i = tid; i < 16384; i += 512) { const float v = c[i]; cond[i] = v / (1.f + __expf(-v)); }
    __syncthreads();
    for (int item = blockIdx.x; item < 192; item += gridDim.x) {
        const int l = item / 96, n0 = (item % 96) * 64;
        const float* W = inp(a, 2) + (size_t)l * 1024 * 6144 + n0 + lane;
        float acc[16];
#pragma unroll
        for (int b = 0; b < 16; ++b) acc[b] = 0.f;
        const int k0 = wave * 128;
#pragma unroll 2
        for (int k = k0; k < k0 + 128; k += 4) {
            const float w0 = W[(size_t)k * 6144], w1 = W[(size_t)(k + 1) * 6144], w2 = W[(size_t)(k + 2) * 6144], w3 = W[(size_t)(k + 3) * 6144];
#pragma unroll
            for (int b = 0; b < 16; ++b) { const f32x4 cv = *(const f32x4*)(cond + b * 1024 + k); acc[b] += cv[0] * w0 + cv[1] * w1 + cv[2] * w2 + cv[3] * w3; }
        }
#pragma unroll
        for (int b = 0; b < 16; ++b) red[(wave * 16 + b) * 64 + lane] = acc[b];
        __syncthreads();
        for (int o = tid; o < 1024; o += 512) { const int b = o >> 6, n = o & 63; float s = 0.f;
#pragma unroll
            for (int w = 0; w < 8; ++w) s += red[(w * 16 + b) * 64 + n];
            mod[(size_t)(l * 16 + b) * 6144 + n0 + n] = s + inp(a, 3)[(size_t)l * 6144 + n0 + n]; }
        __syncthreads();
    }
}
__device__ __forceinline__ void phase_xn(const float* x, const float* g, const float* modl, int sh_off, int sc_off, bf16* XN, int wave, int lane) {
    const int gw = blockIdx.x * 8 + wave, NGW = gridDim.x * 8;
    for (int m = gw; m < M; m += NGW) {
        const int b = m >> 11;
        const f32x4* xr = (const f32x4*)(x + (size_t)m * D) + lane;
        f32x4 v[4]; float ss = 0.f;
#pragma unroll
        for (int j = 0; j < 4; ++j) { v[j] = xr[64 * j]; ss += (v[j][0] * v[j][0] + v[j][1] * v[j][1]) + (v[j][2] * v[j][2] + v[j][3] * v[j][3]); }
        const float rstd = rsqrtf(wave_sum(ss) * (1.f / D) + 1e-6f);
        const float* mb = modl + (size_t)b * 6144;
#pragma unroll
        for (int j = 0; j < 4; ++j) { const int col = 4 * lane + 256 * j;
            const f32x4 gg = *(const f32x4*)(g + col), sc = *(const f32x4*)(mb + sc_off + col), sh = *(const f32x4*)(mb + sh_off + col);
            const f32x4 y = (v[j] * rstd) * gg * (sc + 1.f) + sh;
            u32x2 w; w.x = pk2(y[0], y[1]); w.y = pk2(y[2], y[3]);
            *(u32x2*)(XN + (size_t)m * D + col) = w; }
    }
}

__device__ __forceinline__ f32x4 mfma16(bf16x8 A, bf16x8 B, f32x4 C) { return __builtin_amdgcn_mfma_f32_16x16x32_bf16(A, B, C, 0, 0, 0); }
__device__ __forceinline__ void phase_bias(const Args& a, int wave, int lane) {
    const int gw = blockIdx.x * 8 + wave, NGW = gridDim.x * 8;
    const int r = lane & 15, g = lane >> 4;
    float* BIAS = (float*)(a.ws + WS_BIAS);
    for (int t = gw; t < 704; t += NGW) {
        int idx, tile; if (t < 192) { idx = 0; tile = t; } else if (t < 448) { idx = 1; tile = t - 192; } else { idx = 2; tile = t - 448; }
        const int lsel = idx == 1 ? 0 : 1, N = idx == 0 ? NIN : FF;
        const float* sh = (const float*)(a.ws + WS_MOD) + (size_t)lsel * 16 * 6144 + (idx == 0 ? 0 : 3072) + (size_t)r * 6144 + g * 8;
        const bf16* Bt = (const bf16*)(a.ws + WS_WB + (size_t)lsel * WB_LAYER + (idx == 0 ? WB_IN : WB_W1)) + (size_t)(tile * 16 + r) * 1024 + g * 8;
        float* outp = BIAS + (idx == 0 ? 0 : (idx == 1 ? 16 * NIN : 16 * NIN + 16 * FF));
        f32x4 acc = {0.f, 0.f, 0.f, 0.f};
#pragma unroll 4
        for (int ks = 0; ks < 32; ++ks) {
            const f32x4 x0 = *(const f32x4*)(sh + ks * 32), x1 = *(const f32x4*)(sh + ks * 32 + 4);
            u32x4 hi, lo;
            hi.x = pk2(x0[0], x0[1]); hi.y = pk2(x0[2], x0[3]); hi.z = pk2(x1[0], x1[1]); hi.w = pk2(x1[2], x1[3]);
            lo.x = pk2(x0[0] - bflo(hi.x), x0[1] - bfhi(hi.x)); lo.y = pk2(x0[2] - bflo(hi.y), x0[3] - bfhi(hi.y));
            lo.z = pk2(x1[0] - bflo(hi.z), x1[1] - bfhi(hi.z)); lo.w = pk2(x1[2] - bflo(hi.w), x1[3] - bfhi(hi.w));
            const bf16x8 B = *(const bf16x8*)(Bt + ks * 32);
            acc = mfma16(__builtin_bit_cast(bf16x8, hi), B, acc); acc = mfma16(__builtin_bit_cast(bf16x8, lo), B, acc);
        }
#pragma unroll
        for (int j = 0; j < 4; ++j) outp[(size_t)(4 * g + j) * N + tile * 16 + r] = acc[j];
    }
}

template <int CTRL> __device__ __forceinline__ float dppf(float x) { return __builtin_bit_cast(float, __builtin_amdgcn_update_dpp(0, __builtin_bit_cast(int, x), CTRL, 0xf, 0xf, true)); }
__device__ __forceinline__ float rowsum16(float x) { x += dppf<0xB1>(x); x += dppf<0x4E>(x); x += dppf<0x124>(x); x += dppf<0x128>(x); return x; }
__device__ __forceinline__ float softplusf_(float x) { return x > 0.f ? x + log1pf(__expf(-x)) : log1pf(__expf(x)); }
__device__ __forceinline__ float sel4(f32x4 v, int j) { return j == 0 ? v[0] : (j == 1 ? v[1] : (j == 2 ? v[2] : v[3])); }
__device__ __forceinline__ float tanhf_(float x) { return 1.f - 2.f / (1.f + __expf(2.f * x)); }
__device__ __forceinline__ void phase_premix(const Args& a, int l, unsigned char* lds, int tid, int wave, int lane) {
    bf16* P = (bf16*)(a.ws + WS_P);
    const bf16* w2t = (const bf16*)(a.ws + WS_LORA + (size_t)l * LORA_LAYER + LORA_W2);
    const bf16* a2t = (const bf16*)(a.ws + WS_LORA + (size_t)l * LORA_LAYER + LORA_A2);
    const bf16* g2t = (const bf16*)(a.ws + WS_LORA + (size_t)l * LORA_LAYER + LORA_G2);
    h16* S16 = (h16*)(a.ws + WS_S16); float* SW = (float*)(a.ws + WS_SW); bf16* G = (bf16*)(a.ws + WS_G); float* SCAL = (float*)(a.ws + WS_SCAL);
    constexpr size_t ARR = (size_t)M * 256;
    bf16* praw = (bf16*)lds;
    bf16* act = (bf16*)(lds + 33 * 2048);
    bf16* vbuf = (bf16*)(lds + 33 * 2048 + 32 * 264 * 2);
    float* par = (float*)(lds + 33 * 2048 + 32 * 264 * 2 + 32 * 520 * 2);
    bf16* VT = (bf16*)(a.ws + WS_VT);
    if (tid < 256) { const float* mu = inp(a, 6) + l * 1024;
        par[tid] = mu[tid]; par[256 + tid] = mu[256 + tid]; par[512 + tid] = mu[512 + tid]; par[768 + tid] = mu[768 + tid];
        par[1024 + tid] = inp(a, 7)[l * 256 + tid]; par[1280 + tid] = inp(a, 9)[l * 256 + tid]; par[1536 + tid] = inp(a, 12)[l * 256 + tid];
        par[1792 + tid] = inp(a, 13)[l * 256 + tid]; par[2048 + tid] = inp(a, 14)[l * 256 + tid]; }
    else if (tid < 320) par[2304 + tid - 256] = inp(a, 17)[l * 64 + tid - 256];
    else if (tid < 384) par[2368 + tid - 320] = inp(a, 18)[l * 64 + tid - 320];
    __syncthreads();
    for (int tile = blockIdx.x; tile < M / 32; tile += gridDim.x) {
        int ln_ = lane; asm volatile("" : "+v"(ln_)); const int r = ln_ & 15, g = ln_ >> 4;
        const int b = tile >> 6, t0 = (tile & 63) * 32; const size_t row0 = (size_t)b * T + t0;
        const int tt = wave >> 2, h = wave & 3;
        u32x4 pr_[9], vv_[4], q0_[4], q1_[4]; u32x2 ga_[4], gb_[4];
#pragma unroll
        for (int i = 0; i < 9; ++i) { const int ch = tid + 512 * i, rr = ch >> 7, cc = ch & 127; pr_[i] = (u32x4){0u, 0u, 0u, 0u};
            if (ch < 33 * 128 && (rr > 0 || t0 > 0)) pr_[i] = *(const u32x4*)(P + (row0 + rr - 1) * NIN + cc * 8); }
#pragma unroll
        for (int i = 0; i < 4; ++i) { const int ch = tid + 512 * i, rr = ch >> 6, cc = ch & 63; vv_[i] = *(const u32x4*)(P + (row0 + rr) * NIN + 2048 + cc * 8);
            const bf16* prow = P + (row0 + wave * 4 + i) * NIN;
            q0_[i] = *(const u32x4*)(prow + 1024 + ln_ * 16); q1_[i] = *(const u32x4*)(prow + 1024 + ln_ * 16 + 8);
            ga_[i] = *(const u32x2*)(prow + 2560 + ln_ * 4); gb_[i] = *(const u32x2*)(prow + 2816 + ln_ * 4); }
#pragma unroll
        for (int i = 0; i < 9; ++i) { const int ch = tid + 512 * i, rr = ch >> 7, cc = ch & 127; if (ch < 33 * 128) *(u32x4*)(praw + rr * 1024 + cc * 8) = pr_[i]; }
#pragma unroll
        for (int i = 0; i < 4; ++i) { const int ch = tid + 512 * i, rr = ch >> 6, cc = ch & 63; *(u32x4*)(vbuf + rr * 520 + cc * 8) = vv_[i]; }
        {
            const float* gam = par + (ln_ < 32 ? 2304 : 2368) + (ln_ & 3) * 16;
            const float qs_ = ln_ < 32 ? 0.125f * 1.4426950408889634f : 1.f;
#pragma unroll
            for (int i = 0; i < 4; ++i) { bf16* prow = P + (row0 + wave * 4 + i) * NIN;
                float f[16];
#pragma unroll
                for (int e = 0; e < 4; ++e) { f[2 * e] = bflo(q0_[i][e]); f[2 * e + 1] = bfhi(q0_[i][e]); f[8 + 2 * e] = bflo(q1_[i][e]); f[8 + 2 * e + 1] = bfhi(q1_[i][e]); }
                float ss = 0.f;
#pragma unroll
                for (int e = 0; e < 16; ++e) ss += f[e] * f[e];
                ss += dppf<0xB1>(ss); ss += dppf<0x4E>(ss);
                const float sc = rsqrtf(ss * (1.f / 64.f) + 1e-6f) * qs_;
                u32x4 o0, o1;
#pragma unroll
                for (int e = 0; e < 4; ++e) { o0[e] = pk2(f[2 * e] * sc * gam[2 * e], f[2 * e + 1] * sc * gam[2 * e + 1]); o1[e] = pk2(f[8 + 2 * e] * sc * gam[8 + 2 * e], f[8 + 2 * e + 1] * sc * gam[8 + 2 * e + 1]); }
                *(u32x4*)(prow + 1024 + ln_ * 16) = o0; *(u32x4*)(prow + 1024 + ln_ * 16 + 8) = o1;
                u32x2 hv;
                hv.x = pk2(bflo(ga_[i].x) * sigmoidf_(bflo(gb_[i].x)), bfhi(ga_[i].x) * sigmoidf_(bfhi(gb_[i].x)));
                hv.y = pk2(bflo(ga_[i].y) * sigmoidf_(bflo(gb_[i].y)), bfhi(ga_[i].y) * sigmoidf_(bfhi(gb_[i].y)));
                *(u32x2*)(prow + 2560 + ln_ * 4) = hv; }
        }
        __syncthreads();
        bf16x8 Bw[2][4], Ba[2][4], Bg[4][4];
#pragma unroll
        for (int ct = 0; ct < 4; ++ct) {
#pragma unroll
            for (int ks = 0; ks < 2; ++ks) { const size_t wo = (size_t)(h * 64 + ct * 16 + r) * 64 + ks * 32 + g * 8; Bw[ks][ct] = *(const bf16x8*)(w2t + wo); Ba[ks][ct] = *(const bf16x8*)(a2t + wo); }
#pragma unroll
            for (int ks = 0; ks < 4; ++ks) Bg[ks][ct] = *(const bf16x8*)(g2t + (size_t)(h * 64 + ct * 16 + r) * 128 + ks * 32 + g * 8); }
        {
            bf16* dst = VT + ((size_t)b * 512 + tid) * T + t0;
#pragma unroll
            for (int q = 0; q < 4; ++q) { u32x4 o;
#pragma unroll
                for (int e = 0; e < 4; ++e) { const int k0_ = (e >> 1) * 16 + q * 4 + (e & 1) * 2; o[e] = (unsigned)vbuf[k0_ * 520 + tid] | ((unsigned)vbuf[(k0_ + 1) * 520 + tid] << 16); }
                *(u32x4*)(dst + q * 8) = o; } }
#pragma unroll 4
        for (int idx = tid; idx < 32 * 256; idx += 512) { const int tok = idx >> 8, c = idx & 255, col = 768 + c;
            const float cur = bf2f(praw[(tok + 1) * 1024 + col]), prev = bf2f(praw[tok * 1024 + col]);
            const float pa = cur + par[768 + c] * (prev - cur);
            const float o = c < 64 ? tanhf_(pa) : (c < 128 ? pa : sigmoidf_(pa));
            act[tok * 264 + c] = (bf16)f2bf(o); }
        __syncthreads();
        f32x4 aw[4], aa[4], ag[4];
#pragma unroll
        for (int ct = 0; ct < 4; ++ct) { aw[ct] = (f32x4){0.f, 0.f, 0.f, 0.f}; aa[ct] = aw[ct]; ag[ct] = aw[ct]; }
        const bf16* arow = act + (tt * 16 + r) * 264 + g * 8;
#pragma unroll
        for (int ks = 0; ks < 2; ++ks) { const bf16x8 A = *(const bf16x8*)(arow + ks * 32), A2 = *(const bf16x8*)(arow + 64 + ks * 32);
#pragma unroll
            for (int ct = 0; ct < 4; ++ct) { aw[ct] = mfma16(A, Bw[ks][ct], aw[ct]); aa[ct] = mfma16(A2, Ba[ks][ct], aa[ct]); } }
#pragma unroll
        for (int ks = 0; ks < 4; ++ks) { const bf16x8 A = *(const bf16x8*)(arow + 128 + ks * 32);
#pragma unroll
            for (int ct = 0; ct < 4; ++ct) ag[ct] = mfma16(A, Bg[ks][ct], ag[ct]); }
#pragma unroll 1
        for (int j = 0; j < 4; ++j) {
            const int tok = tt * 16 + 4 * g + j; const size_t token = row0 + tok;
            float kkv[4], k2v[4], rv[4], av[4], vv[4], dv[4]; float ss = 0.f;
#pragma unroll
            for (int ct = 0; ct < 4; ++ct) { const int c = h * 64 + ct * 16 + r;
                const bf16* pc = praw + (tok + 1) * 1024; const bf16* pp = praw + tok * 1024;
                float x0 = bf2f(pc[c]), x1 = bf2f(pc[256 + c]), x2 = bf2f(pc[512 + c]);
                x0 += par[c] * (bf2f(pp[c]) - x0); x1 += par[256 + c] * (bf2f(pp[256 + c]) - x1); x2 += par[512 + c] * (bf2f(pp[512 + c]) - x2);
                const float wl = par[1024 + c] + sel4(aw[ct], j);
                const float wlog = -__logf(1.f + __expf(-wl)) - 0.5f;
                dv[ct] = __expf(-__expf(wlog));
                av[ct] = sigmoidf_(par[1280 + c] + sel4(aa[ct], j));
                rv[ct] = x0; vv[ct] = x2;
                kkv[ct] = x1 * par[1536 + c]; ss += kkv[ct] * kkv[ct];
                k2v[ct] = x1 * (1.f + (av[ct] - 1.f) * par[1792 + c]); }
            ss = rowsum16(ss);
            const float inv = 1.f / fmaxf(sqrtf(ss), 1e-12f);
            float c1 = 0.f, c2 = 0.f, bn = 0.f;
#pragma unroll
            for (int ct = 0; ct < 4; ++ct) { const int c = h * 64 + ct * 16 + r; const size_t o = token * 256 + c;
                const float kkn = kkv[ct] * inv, ka = kkn * av[ct];
                c1 += ka * rv[ct]; c2 += k2v[ct] * rv[ct]; bn += rv[ct] * k2v[ct] * par[2048 + c];
                S16[o] = (h16)(-kkn); S16[ARR + o] = (h16)(dv[ct] * rv[ct]); S16[2 * ARR + o] = (h16)ka; S16[3 * ARR + o] = (h16)k2v[ct]; S16[4 * ARR + o] = (h16)vv[ct];
                SW[o] = dv[ct]; G[o] = (bf16)f2bf(sel4(ag[ct], j)); }
            c1 = rowsum16(c1); c2 = rowsum16(c2); bn = rowsum16(bn);
            if (r == 0) { float* sp = SCAL + (token * 4 + h) * 4; sp[0] = c1; sp[1] = c2; sp[2] = bn; sp[3] = 0.f; }
            asm volatile("" ::: "memory");
        }
        __syncthreads();
    }
}

__device__ __forceinline__ void st8(float* d, h16x8 v) {
    *(f32x4*)d = (f32x4){(float)v[0], (float)v[1], (float)v[2], (float)v[3]}; *(f32x4*)(d + 4) = (f32x4){(float)v[4], (float)v[5], (float)v[6], (float)v[7]}; }
constexpr int SC_REC = 384, SC_CH = 32, SC_NCH = T / SC_CH;
__device__ __forceinline__ void scan_load(const h16* S16, const float* SW, const float* SCAL, size_t tok0, int h, int rg, float* dst, int ltid) {
    constexpr size_t ARR = (size_t)M * 256;
    { const int s = ltid >> 3, q = ltid & 7; const h16* p = S16 + (tok0 + s) * 256 + h * 64 + q * 8; float* rec = dst + s * SC_REC + q * 8;
      const h16x8 v0 = *(const h16x8*)p, v1 = *(const h16x8*)(p + ARR), v2 = *(const h16x8*)(p + 2 * ARR), v3 = *(const h16x8*)(p + 3 * ARR);
      st8(rec, v0); st8(rec + 64, v1); st8(rec + 192, v2); st8(rec + 256, v3); }
#pragma unroll
    for (int i = 0; i < 2; ++i) { const int id = ltid + 256 * i, s = id >> 4, q = id & 15;
        *(f32x4*)(dst + s * SC_REC + 128 + q * 4) = *(const f32x4*)(SW + (tok0 + s) * 256 + h * 64 + q * 4); }
    if (ltid < 64) { const int s = ltid >> 1, q = ltid & 1; st8(dst + s * SC_REC + 320 + q * 8, *(const h16x8*)(S16 + 4 * ARR + (tok0 + s) * 256 + h * 64 + rg * 16 + q * 8)); }
    else if (ltid < 128) { const int s = (ltid - 64) >> 1, wh = ltid & 1; dst[s * SC_REC + 336 + wh] = SCAL[((tok0 + s) * 4 + h) * 4 + wh]; }
}
struct ScanOps { f32x4 nkk, wr, w, ka, k2; f32x2 c; float vi; };
__device__ __forceinline__ void scan_ld(ScanOps& o, const float* rec, int jq, int rowl) {
    o.nkk = *(const f32x4*)(rec + 4 * jq); o.wr = *(const f32x4*)(rec + 64 + 4 * jq); o.w = *(const f32x4*)(rec + 128 + 4 * jq);
    o.ka = *(const f32x4*)(rec + 192 + 4 * jq); o.k2 = *(const f32x4*)(rec + 256 + 4 * jq); o.vi = rec[320 + rowl]; o.c = *(const f32x2*)(rec + 336);
}
__device__ __forceinline__ void scan_step(f32x4& S, float& yk, const ScanOps& o, int jq, int sidx) {
    float sa = (S[0] * o.nkk[0] + S[1] * o.nkk[1]) + (S[2] * o.nkk[2] + S[3] * o.nkk[3]);
    float ys = (S[0] * o.wr[0] + S[1] * o.wr[1]) + (S[2] * o.wr[2] + S[3] * o.wr[3]);
    sa = rowsum16(sa); ys = rowsum16(ys);
    const float y = ys + sa * o.c[0] + o.vi * o.c[1];
    yk = (jq == (sidx & 15)) ? y : yk;
    S = S * o.w + o.ka * sa + o.k2 * o.vi;
}
__device__ __forceinline__ void phase_scan(const Args& a, unsigned char* lds, int tid, int wave, int lane) {
    const h16* S16 = (const h16*)(a.ws + WS_S16); const float* SW = (const float*)(a.ws + WS_SW); const float* SCAL = (const float*)(a.ws + WS_SCAL); float* YR = (float*)(a.ws + WS_YR);
    float* buf = (float*)lds;
    for (int it = blockIdx.x; it < 256; it += gridDim.x) {
        asm volatile("" : "+v"(tid), "+v"(lane));
        const int bh = it >> 2, rg = it & 3, b = bh >> 2, h = bh & 3;
        const size_t tokb = (size_t)b * T;
        if (wave >= 4) scan_load(S16, SW, SCAL, tokb, h, rg, buf, tid - 256);
        __syncthreads();
        const int rowl = (wave & 3) * 4 + (lane >> 4), jq = lane & 15;
        f32x4 S = {0.f, 0.f, 0.f, 0.f}; float yk = 0.f;
        float* yout = YR + (tokb + jq) * 256 + h * 64 + rg * 16 + rowl;
        for (int ch = 0; ch < SC_NCH; ++ch) {
            if (wave >= 4) { if (ch + 1 < SC_NCH) scan_load(S16, SW, SCAL, tokb + (size_t)(ch + 1) * SC_CH, h, rg, buf + ((ch + 1) & 1) * SC_CH * SC_REC, tid - 256); }
            else {
                const float* src = buf + (ch & 1) * SC_CH * SC_REC;
                ScanOps A, B;
                scan_ld(A, src, jq, rowl);
#pragma unroll
                for (int s = 0; s < SC_CH; s += 2) {
                    scan_ld(B, src + (s + 1) * SC_REC, jq, rowl);
                    scan_step(S, yk, A, jq, s);
                    if (s + 2 < SC_CH) scan_ld(A, src + (s + 2) * SC_REC, jq, rowl);
                    scan_step(S, yk, B, jq, s + 1);
                    if ((s & 15) == 14) yout[(size_t)(ch * SC_CH + (s & 16)) * 256] = yk;
                }
            }
            __syncthreads();
        }
    }
}

constexpr int AT_KP = 72;
__device__ __forceinline__ void attn_issue(const bf16* P, const bf16* VT, size_t rowk0, size_t vtb, int h, int tid, u32x4 (&kr)[2], u32x4 (&vr)[2]) {
#pragma unroll
    for (int i = 0; i < 2; ++i) {
        kr[i] = *(const u32x4*)(P + (rowk0 + ((tid >> 3) & 63)) * NIN + 1536 + (h * 2 + i) * 64 + (tid & 7) * 8);
        vr[i] = *(const u32x4*)(VT + vtb + (size_t)((tid >> 3) + 64 * i) * T + (tid & 7) * 8); }
}
__device__ __forceinline__ void attn_store(bf16* Kl, int tid, const u32x4 (&kr)[2], const u32x4 (&vr)[2]) {
#pragma unroll
    for (int i = 0; i < 2; ++i) {
        *(u32x4*)(Kl + i * 64 * AT_KP + ((tid >> 3) & 63) * AT_KP + (tid & 7) * 8) = kr[i];
        *(u32x4*)(Kl + 2 * 64 * AT_KP + ((tid >> 3) + 64 * i) * AT_KP + (tid & 7) * 8) = vr[i]; }
}
constexpr int AT_BUF = (2 * 64 + 128) * AT_KP;
__device__ __forceinline__ void attn_tile(const bf16* Lb, int kt, bool diag, int r, int g, int tq, float slope2, float bsh, const bf16x8* qb, f32x4 (&O)[2][8], float (&lsum)[2]) {
    const bf16* K0 = Lb; const bf16* K1 = Lb + 64 * AT_KP; const bf16* Vt = Lb + 2 * 64 * AT_KP;
    bf16x8 kf0[4][2], kf1[4][2];
#pragma unroll
    for (int k4 = 0; k4 < 4; ++k4)
#pragma unroll
        for (int ks = 0; ks < 2; ++ks) { kf0[k4][ks] = *(const bf16x8*)(K0 + (k4 * 16 + r) * AT_KP + ks * 32 + g * 8); kf1[k4][ks] = *(const bf16x8*)(K1 + (k4 * 16 + r) * AT_KP + ks * 32 + g * 8); }
    bf16x8 qf[2][2];
#pragma unroll
    for (int c = 0; c < 2; ++c)
#pragma unroll
        for (int ks = 0; ks < 2; ++ks) qf[c][ks] = qb[(c * 2 + ks) * 64];
    f32x4 init[4];
    if (diag) {
#pragma unroll
        for (int k4 = 0; k4 < 4; ++k4)
#pragma unroll
            for (int j = 0; j < 4; ++j) init[k4][j] = -slope2 * fabsf((float)(tq - (kt * 64 + k4 * 16 + 4 * g + j))) - bsh;
    } else {
        const float base = slope2 * (float)(kt * 64 + 4 * g - tq) - bsh;
#pragma unroll
        for (int k4 = 0; k4 < 4; ++k4)
#pragma unroll
            for (int j = 0; j < 4; ++j) init[k4][j] = fmaf(slope2, (float)(k4 * 16 + j), base);
    }
    __builtin_amdgcn_sched_barrier(0);
    f32x4 s0[4], s1[4];
#pragma unroll
    for (int k4 = 0; k4 < 4; ++k4) { s0[k4] = mfma16(kf0[k4][0], qf[0][0], init[k4]); s1[k4] = mfma16(kf1[k4][0], qf[1][0], init[k4]); }
#pragma unroll
    for (int k4 = 0; k4 < 4; ++k4) { s0[k4] = mfma16(kf0[k4][1], qf[0][1], s0[k4]); s1[k4] = mfma16(kf1[k4][1], qf[1][1], s1[k4]); }
    bf16x8 vf0[8], vf1[8];
#pragma unroll
    for (int nt = 0; nt < 8; ++nt) { vf0[nt] = *(const bf16x8*)(Vt + (nt * 16 + r) * AT_KP + g * 8); vf1[nt] = *(const bf16x8*)(Vt + (nt * 16 + r) * AT_KP + 32 + g * 8); }
    __builtin_amdgcn_sched_barrier(0);
    float p0 = 0.f, p1 = 0.f;
#pragma unroll
    for (int k4 = 0; k4 < 4; ++k4)
#pragma unroll
        for (int j = 0; j < 4; ++j) { s0[k4][j] = __builtin_amdgcn_exp2f(s0[k4][j]); p0 += s0[k4][j]; s1[k4][j] = __builtin_amdgcn_exp2f(s1[k4][j]); p1 += s1[k4][j]; }
    lsum[0] += p0; lsum[1] += p1;
    u32x4 a0, a1, b0, b1;
    a0.x = pg8::cvt_pk_bf16(s0[0][0], s0[0][1]); a0.y = pg8::cvt_pk_bf16(s0[0][2], s0[0][3]); a0.z = pg8::cvt_pk_bf16(s0[1][0], s0[1][1]); a0.w = pg8::cvt_pk_bf16(s0[1][2], s0[1][3]);
    a1.x = pg8::cvt_pk_bf16(s0[2][0], s0[2][1]); a1.y = pg8::cvt_pk_bf16(s0[2][2], s0[2][3]); a1.z = pg8::cvt_pk_bf16(s0[3][0], s0[3][1]); a1.w = pg8::cvt_pk_bf16(s0[3][2], s0[3][3]);
    b0.x = pg8::cvt_pk_bf16(s1[0][0], s1[0][1]); b0.y = pg8::cvt_pk_bf16(s1[0][2], s1[0][3]); b0.z = pg8::cvt_pk_bf16(s1[1][0], s1[1][1]); b0.w = pg8::cvt_pk_bf16(s1[1][2], s1[1][3]);
    b1.x = pg8::cvt_pk_bf16(s1[2][0], s1[2][1]); b1.y = pg8::cvt_pk_bf16(s1[2][2], s1[2][3]); b1.z = pg8::cvt_pk_bf16(s1[3][0], s1[3][1]); b1.w = pg8::cvt_pk_bf16(s1[3][2], s1[3][3]);
    const bf16x8 A0 = __builtin_bit_cast(bf16x8, a0), A1 = __builtin_bit_cast(bf16x8, a1), B0 = __builtin_bit_cast(bf16x8, b0), B1 = __builtin_bit_cast(bf16x8, b1);
#pragma unroll
    for (int nt = 0; nt < 8; ++nt) { O[0][nt] = mfma16(vf0[nt], A0, O[0][nt]); O[1][nt] = mfma16(vf0[nt], B0, O[1][nt]); }
#pragma unroll
    for (int nt = 0; nt < 8; ++nt) { O[0][nt] = mfma16(vf1[nt], A1, O[0][nt]); O[1][nt] = mfma16(vf1[nt], B1, O[1][nt]); }
}
__device__ __forceinline__ void attn_unit(const Args& a, int l, float lam, float one_m_li, float bsh, int b, int h, int p, unsigned char* lds, int tid, int wave, int lane) {
    asm volatile("" : "+v"(tid), "+v"(lane));
    const bf16* P = (const bf16*)(a.ws + WS_P); const bf16* VT = (const bf16*)(a.ws + WS_VT); bf16* Y = (bf16*)(a.ws + WS_Y);
    bf16* L0 = (bf16*)lds;
    const int r = lane & 15, g = lane >> 4;
    const int qc = 2 * p + (wave >> 2), nt_all = 2 * p + 2;
    const int tq = 128 * p + 16 * wave + r; const size_t rowb = (size_t)b * T; const size_t vtb = ((size_t)b * 4 + h) * 128 * T;
    const float slope2 = exp2f(-2.f * (float)(h + 1)) * 1.4426950408889634f;
    bf16x8* qb = (bf16x8*)(lds + 2 * AT_BUF * 2) + wave * 256 + lane;
#pragma unroll
    for (int c = 0; c < 2; ++c)
#pragma unroll
        for (int ks = 0; ks < 2; ++ks) qb[(c * 2 + ks) * 64] = *(const bf16x8*)(P + (rowb + tq) * NIN + 1024 + (h * 2 + c) * 64 + ks * 32 + g * 8);
    float lsum[2] = {0.f, 0.f};
    f32x4 O[2][8];
#pragma unroll
    for (int nt = 0; nt < 8; ++nt) { O[0][nt] = (f32x4){0.f, 0.f, 0.f, 0.f}; O[1][nt] = O[0][nt]; }
    u32x4 kr[2], vr[2];
    attn_issue(P, VT, rowb, vtb, h, tid, kr, vr);
    attn_store(L0, tid, kr, vr);
    attn_issue(P, VT, rowb + 64, vtb + 64, h, tid, kr, vr);
    __syncthreads();
    for (int kt = 0; kt < nt_all; ++kt) {
        if (kt + 1 < nt_all) { attn_store(L0 + ((kt + 1) & 1) * AT_BUF, tid, kr, vr);
            if (kt + 2 < nt_all) attn_issue(P, VT, rowb + (size_t)(kt + 2) * 64, vtb + (size_t)(kt + 2) * 64, h, tid, kr, vr); }
        if (kt <= qc) attn_tile(L0 + (kt & 1) * AT_BUF, kt, kt == qc, r, g, tq, slope2, bsh, qb, O, lsum);
        __syncthreads();
    }
    float l0 = lsum[0], l1 = lsum[1];
    l0 += shx(l0, 16); l0 += shx(l0, 32); l1 += shx(l1, 16); l1 += shx(l1, 32);
    const float i0 = 1.f / l0, i1 = lam / l1;
    float ss = 0.f;
#pragma unroll
    for (int nt = 0; nt < 8; ++nt)
#pragma unroll
        for (int j = 0; j < 4; ++j) { const float o = O[0][nt][j] * i0 - O[1][nt][j] * i1; O[0][nt][j] = o; ss += o * o; }
    ss += shx(ss, 16); ss += shx(ss, 32);
    const float sc = rsqrtf(ss * (1.f / 128.f) + 1e-6f) * one_m_li;
    const float* sg = inp(a, 23) + l * 128;
    bf16* yp = Y + (rowb + tq) * 1024 + 256 + h * 128;
#pragma unroll
    for (int nt = 0; nt < 8; ++nt) { const int v0 = nt * 16 + 4 * g; const f32x4 gg = *(const f32x4*)(sg + v0);
        u32x2 w; w.x = pk2(O[0][nt][0] * sc * gg[0], O[0][nt][1] * sc * gg[1]); w.y = pk2(O[0][nt][2] * sc * gg[2], O[0][nt][3] * sc * gg[3]);
        *(u32x2*)(yp + v0) = w; }
}
constexpr int SA_CH = 16, SA_NCH = T / SA_CH, SA_TICKS = 132;
constexpr int SA_SCB = 0, SA_KV = 2 * SA_CH * SC_REC * 4, SA_STAGE = 32768, SA_QB = SA_KV + 2 * SA_STAGE;
static_assert(SA_QB + 4 * 4096 <= LDS_CTL, "LDS map of the fused scan/attention phase");
#define SA_BAR() do { asm volatile("s_waitcnt vmcnt(0) lgkmcnt(0)" ::: "memory"); __builtin_amdgcn_s_barrier(); asm volatile("" ::: "memory"); } while (0)
#define SA_BAR_L() do { asm volatile("s_waitcnt lgkmcnt(0)" ::: "memory"); __builtin_amdgcn_s_barrier(); asm volatile("" ::: "memory"); } while (0)
__device__ __forceinline__ void role_bar(volatile LAS unsigned* cnt, unsigned& target, int lane, bool drain_vm) {
    if (drain_vm) asm volatile("s_waitcnt vmcnt(0) lgkmcnt(0)" ::: "memory"); else asm volatile("s_waitcnt lgkmcnt(0)" ::: "memory");
    target += 4u;
    if (lane == 0) __hip_atomic_fetch_add((LAS unsigned*)cnt, 1u, __ATOMIC_RELAXED, __HIP_MEMORY_SCOPE_WORKGROUP);
    unsigned spins = 0u;
    for (;;) { const unsigned v = (unsigned)__builtin_amdgcn_readfirstlane((int)*cnt); if (v >= target || ++spins > (1u << 18)) break; __builtin_amdgcn_s_sleep(1); }
    asm volatile("s_waitcnt lgkmcnt(0)" ::: "memory");
}
struct ScanPre { h16x8 a0, a1, v; f32x4 w; float sc; };
__device__ __forceinline__ void scanpre_issue(ScanPre& p, const h16* S16, const float* SW, const float* SCAL, size_t tok0, int h, int rg, int stid) {
    constexpr size_t ARR = (size_t)M * 256;
    const int ps = stid >> 7, sq = stid & 127, s = sq >> 3, q = sq & 7;
    const h16* bp = S16 + (size_t)(2 * ps) * ARR + (tok0 + s) * 256 + h * 64 + q * 8;
    p.a0 = *(const h16x8*)bp; p.a1 = *(const h16x8*)(bp + ARR);
    p.w = *(const f32x4*)(SW + (tok0 + (stid >> 4)) * 256 + h * 64 + (stid & 15) * 4);
    if (stid < 32) p.v = *(const h16x8*)(S16 + 4 * ARR + (tok0 + (stid >> 1)) * 256 + h * 64 + rg * 16 + (stid & 1) * 8);
    else if (stid < 64) p.sc = SCAL[((tok0 + ((stid - 32) >> 1)) * 4 + h) * 4 + (stid & 1)];
}
__device__ __forceinline__ void scanpre_store(const ScanPre& p, float* dst, int stid) {
    const int ps = stid >> 7, sq = stid & 127, s = sq >> 3, q = sq & 7;
    float* rec = dst + s * SC_REC + q * 8 + (ps ? 192 : 0);
    st8(rec, p.a0); st8(rec + 64, p.a1);
    *(f32x4*)(dst + (stid >> 4) * SC_REC + 128 + (stid & 15) * 4) = p.w;
    if (stid < 32) st8(dst + (stid >> 1) * SC_REC + 320 + (stid & 1) * 8, p.v);
    else if (stid < 64) dst[((stid - 32) >> 1) * SC_REC + 336 + (stid & 1)] = p.sc;
}
__device__ __forceinline__ void attn_dma(const bf16* P, const bf16* VT, size_t rowk, size_t vtk, int h, int aw, int lane, LAS unsigned char* stage) {
    const int q = (lane & 7) ^ ((lane >> 3) & 7);
    const char* ub; unsigned voff, kstride;
    if (aw < 2) { ub = (const char*)(P + rowk * NIN + 1536 + (h * 2 + aw) * 64); voff = (unsigned)(((lane >> 3) * NIN + q * 8) * 2); kstride = 8u * NIN * 2u; }
    else { ub = (const char*)(VT + vtk + (size_t)(aw - 2) * 64 * T); voff = (unsigned)(((lane >> 3) * T + q * 8) * 2); kstride = 8u * T * 2u; }
#pragma unroll
    for (int k = 0; k < 8; ++k)
        __builtin_amdgcn_global_load_lds((const unsigned*)(ub + (size_t)k * kstride + voff), (LAS unsigned*)(stage + aw * 8192 + k * 1024), 16, 0, 0);
}
__device__ __forceinline__ void attn_tile_sw(const unsigned char* Lb, int kt, bool diag, int r, int g, int tq, float slope2, float bsh, const bf16x8* qb, f32x4 (&O)[2][8], float (&lsum)[2]) {
    const int r7 = r & 7;
    bf16x8 kf0[4][2], kf1[4][2];
#pragma unroll
    for (int k4 = 0; k4 < 4; ++k4)
#pragma unroll
        for (int ks = 0; ks < 2; ++ks) { const int off = ((k4 * 16 + r) * 8 + ((ks * 4 + g) ^ r7)) * 16; kf0[k4][ks] = *(const bf16x8*)(Lb + off); kf1[k4][ks] = *(const bf16x8*)(Lb + 8192 + off); }
    bf16x8 qf[2][2];
#pragma unroll
    for (int c = 0; c < 2; ++c)
#pragma unroll
        for (int ks = 0; ks < 2; ++ks) if (c * 2 + ks < 3) qf[c][ks] = qb[(c * 2 + ks) * 64];
    f32x4 init[4];
    if (diag) {
#pragma unroll
        for (int k4 = 0; k4 < 4; ++k4)
#pragma unroll
            for (int j = 0; j < 4; ++j) init[k4][j] = -slope2 * fabsf((float)(tq - (kt * 64 + k4 * 16 + 4 * g + j))) - bsh;
    } else {
        const float base = slope2 * (float)(kt * 64 + 4 * g - tq) - bsh;
#pragma unroll
        for (int k4 = 0; k4 < 4; ++k4)
#pragma unroll
            for (int j = 0; j < 4; ++j) init[k4][j] = fmaf(slope2, (float)(k4 * 16 + j), base);
    }
    __builtin_amdgcn_sched_barrier(0);
    f32x4 s0[4], s1[4];
#pragma unroll
    for (int k4 = 0; k4 < 4; ++k4) { s0[k4] = mfma16(kf0[k4][0], qf[0][0], init[k4]); s1[k4] = mfma16(kf1[k4][0], qf[1][0], init[k4]); s0[k4] = mfma16(kf0[k4][1], qf[0][1], s0[k4]); }
    __builtin_amdgcn_sched_barrier(0);
    bf16x8 vf0[8], vf1[8];
#pragma unroll
    for (int nt = 0; nt < 8; ++nt) vf0[nt] = *(const bf16x8*)(Lb + 16384 + (nt * 16 + r) * 128 + ((g ^ r7) * 16));
    __builtin_amdgcn_sched_barrier(0);
    qf[1][1] = qb[3 * 64];
    float p0 = 0.f, p1 = 0.f;
    unsigned pa[8], pbk[8];
#pragma unroll
    for (int k4 = 0; k4 < 4; ++k4) {
        s1[k4] = mfma16(kf1[k4][1], qf[1][1], s1[k4]);
#pragma unroll
        for (int j = 0; j < 4; ++j) { s0[k4][j] = __builtin_amdgcn_exp2f(s0[k4][j]); p0 += s0[k4][j]; }
        pa[2 * k4] = pg8::cvt_pk_bf16(s0[k4][0], s0[k4][1]); pa[2 * k4 + 1] = pg8::cvt_pk_bf16(s0[k4][2], s0[k4][3]);
        __builtin_amdgcn_sched_barrier(0);
    }
    const bf16x8 A0 = __builtin_bit_cast(bf16x8, (u32x4){pa[0], pa[1], pa[2], pa[3]}), A1 = __builtin_bit_cast(bf16x8, (u32x4){pa[4], pa[5], pa[6], pa[7]});
#pragma unroll
    for (int nt = 0; nt < 8; ++nt) vf1[nt] = *(const bf16x8*)(Lb + 16384 + (nt * 16 + r) * 128 + (((4 + g) ^ r7) * 16));
    __builtin_amdgcn_sched_barrier(0);
#pragma unroll
    for (int k4 = 0; k4 < 4; ++k4) {
#pragma unroll
        for (int q = 0; q < 4; ++q) { const int nt = (4 * k4 + q) & 7; if (k4 < 2) O[0][nt] = mfma16(vf0[nt], A0, O[0][nt]); else O[0][nt] = mfma16(vf1[nt], A1, O[0][nt]); }
#pragma unroll
        for (int j = 0; j < 4; ++j) { s1[k4][j] = __builtin_amdgcn_exp2f(s1[k4][j]); p1 += s1[k4][j]; }
        pbk[2 * k4] = pg8::cvt_pk_bf16(s1[k4][0], s1[k4][1]); pbk[2 * k4 + 1] = pg8::cvt_pk_bf16(s1[k4][2], s1[k4][3]);
        __builtin_amdgcn_sched_barrier(0);
    }
    lsum[0] += p0; lsum[1] += p1;
    const bf16x8 B0 = __builtin_bit_cast(bf16x8, (u32x4){pbk[0], pbk[1], pbk[2], pbk[3]}), B1 = __builtin_bit_cast(bf16x8, (u32x4){pbk[4], pbk[5], pbk[6], pbk[7]});
#pragma unroll
    for (int nt = 0; nt < 8; ++nt) { O[1][nt] = mfma16(vf0[nt], B0, O[1][nt]); O[1][nt] = mfma16(vf1[nt], B1, O[1][nt]); }
}
__device__ __forceinline__ void phase_scan_attn(const Args& a, int l, unsigned char* lds, int tid, int wave, int lane) {
    for (int w0 = blockIdx.x; w0 < 256; w0 += gridDim.x) {
        asm volatile("" : "+v"(tid), "+v"(lane));
        const int w = (gridDim.x == 256) ? ((w0 & 7) * 32 + (w0 >> 3)) : w0;
        const int bh = w >> 2, sub = w & 3, b = bh >> 2, h = bh & 3;
        const size_t tokb = (size_t)b * T;
        volatile LAS unsigned* rcnt = (volatile LAS unsigned*)((LAS unsigned char*)lds + LDS_CTL - 64);
        if (tid < 8) rcnt[tid] = 0u;
        __syncthreads();
        unsigned rtarget = 0u;
        if (wave < 4) {
            const h16* S16 = (const h16*)(a.ws + WS_S16); const float* SW = (const float*)(a.ws + WS_SW); const float* SCAL = (const float*)(a.ws + WS_SCAL); float* YR = (float*)(a.ws + WS_YR);
            float* scb = (float*)(lds + SA_SCB);
            const int rg = sub, rowl = wave * 4 + (lane >> 4), jq = lane & 15;
            __builtin_amdgcn_s_setprio(3);
            ScanPre pre; pre.a0 = (h16x8)(h16)0.f; pre.a1 = pre.a0; pre.v = pre.a0; pre.w = (f32x4){0.f, 0.f, 0.f, 0.f}; pre.sc = 0.f;
            scanpre_issue(pre, S16, SW, SCAL, tokb, h, rg, tid); scanpre_store(pre, scb, tid);
            role_bar(rcnt, rtarget, lane, false);
            f32x4 S = {0.f, 0.f, 0.f, 0.f}; float yk = 0.f;
            float* yout = YR + (tokb + jq) * 256 + h * 64 + rg * 16 + rowl;
#pragma unroll 1
            for (int i = 0; i < SA_TICKS; ++i) {
                if (i < SA_NCH) {
                    if (i + 1 < SA_NCH) scanpre_issue(pre, S16, SW, SCAL, tokb + (size_t)(i + 1) * SA_CH, h, rg, tid);
                    const float* src = scb + (i & 1) * SA_CH * SC_REC;
                    ScanOps A, B;
                    scan_ld(A, src, jq, rowl);
#pragma unroll
                    for (int s_ = 0; s_ < SA_CH; s_ += 2) {
                        scan_ld(B, src + (s_ + 1) * SC_REC, jq, rowl);
                        scan_step(S, yk, A, jq, s_);
                        if (s_ + 2 < SA_CH) scan_ld(A, src + (s_ + 2) * SC_REC, jq, rowl);
                        scan_step(S, yk, B, jq, s_ + 1);
                    }
                    yout[(size_t)(i * SA_CH) * 256] = yk;
                    if (i + 1 < SA_NCH) scanpre_store(pre, scb + ((i + 1) & 1) * SA_CH * SC_REC, tid);
                }
                role_bar(rcnt, rtarget, lane, false);
            }
            __builtin_amdgcn_s_setprio(0);
        } else {
            const bf16* P = (const bf16*)(a.ws + WS_P); const bf16* VT = (const bf16*)(a.ws + WS_VT); bf16* Y = (bf16*)(a.ws + WS_Y);
            float s1 = 0.f, s2 = 0.f, mq = 0.f, mk = 0.f;
            for (int i = 0; i < 64; ++i) { s1 += inp(a, 19)[l * 64 + i] * inp(a, 20)[l * 64 + i]; s2 += inp(a, 21)[l * 64 + i] * inp(a, 22)[l * 64 + i];
                mq = fmaxf(mq, fabsf(inp(a, 17)[l * 64 + i])); mk = fmaxf(mk, fabsf(inp(a, 18)[l * 64 + i])); }
            const float li = __builtin_bit_cast(float, __builtin_amdgcn_readfirstlane(l == 0 ? 0x3e4ccccd : 0x3eb60549));
            const float lam = __builtin_bit_cast(float, __builtin_amdgcn_readfirstlane(__builtin_bit_cast(int, expf(s1) - expf(s2) + li))), one_m_li = 1.f - li;
            const float bsh = __builtin_bit_cast(float, __builtin_amdgcn_readfirstlane(__builtin_bit_cast(int, 8.f * mq * mk * 1.4426950408889634f)));
            const int aw = wave - 4, r = lane & 15, g = lane >> 4;
            const size_t vtb = ((size_t)b * 4 + h) * 128 * T;
            const float slope2 = exp2f(-2.f * (float)(h + 1)) * 1.4426950408889634f;
            LAS unsigned char* kv = (LAS unsigned char*)lds + SA_KV;
            bf16x8* qb = (bf16x8*)(lds + SA_QB) + aw * 256 + lane;
            const float* sg = inp(a, 23) + l * 128;
            attn_dma(P, VT, tokb, vtb, h, aw, lane, kv);
            role_bar(rcnt + 4, rtarget, lane, true);
            int ti = 0;
#pragma unroll 1
            for (int u = 0; u < 8; ++u) {
                const int pq = sub * 4 + (u >> 1), qc = (u & 1) ? 31 - pq : pq;
                const int pqn = sub * 4 + ((u + 1) >> 1);
                const int tq = qc * 64 + aw * 16 + r;
#pragma unroll
                for (int c = 0; c < 2; ++c)
#pragma unroll
                    for (int ks = 0; ks < 2; ++ks) qb[(c * 2 + ks) * 64] = *(const bf16x8*)(P + (tokb + tq) * NIN + 1024 + (h * 2 + c) * 64 + ks * 32 + g * 8);
                float lsum[2] = {0.f, 0.f};
                f32x4 O[2][8];
#pragma unroll
                for (int nt = 0; nt < 8; ++nt) { O[0][nt] = (f32x4){0.f, 0.f, 0.f, 0.f}; O[1][nt] = O[0][nt]; }
#pragma unroll 1
                for (int kt = 0; kt <= qc; ++kt) {
                    const int ktn = kt < qc ? kt + 1 : 0;
                    if (kt < qc || u < 7) attn_dma(P, VT, tokb + (size_t)ktn * 64, vtb + (size_t)ktn * 64, h, aw, lane, kv + ((ti + 1) & 1) * SA_STAGE);
                    attn_tile_sw((const unsigned char*)lds + SA_KV + (ti & 1) * SA_STAGE, kt, kt == qc, r, g, tq, slope2, bsh, qb, O, lsum);
                    if (kt == qc) {
                        float l0 = lsum[0], l1 = lsum[1];
                        l0 += shx(l0, 16); l0 += shx(l0, 32); l1 += shx(l1, 16); l1 += shx(l1, 32);
                        const float i0 = 1.f / l0, i1 = lam / l1;
                        float ss = 0.f;
#pragma unroll
                        for (int nt = 0; nt < 8; ++nt)
#pragma unroll
                            for (int j = 0; j < 4; ++j) { const float o = O[0][nt][j] * i0 - O[1][nt][j] * i1; O[0][nt][j] = o; ss += o * o; }
                        ss += shx(ss, 16); ss += shx(ss, 32);
                        const float sc = rsqrtf(ss * (1.f / 128.f) + 1e-6f) * one_m_li;
                        bf16* yp = Y + (tokb + tq) * 1024 + 256 + h * 128;
#pragma unroll
                        for (int nt = 0; nt < 8; ++nt) { const int v0 = nt * 16 + 4 * g; const f32x4 gg = *(const f32x4*)(sg + v0);
                            u32x2 wv; wv.x = pk2(O[0][nt][0] * sc * gg[0], O[0][nt][1] * sc * gg[1]); wv.y = pk2(O[0][nt][2] * sc * gg[2], O[0][nt][3] * sc * gg[3]);
                            *(u32x2*)(yp + v0) = wv; }
                    }
                    role_bar(rcnt + 4, rtarget, lane, true); ++ti;
                }
                (void)pqn;
            }
        }
        __syncthreads();
    }
}
__device__ __forceinline__ void conv_unit(const Args& a, int l, int b, int t0, unsigned char* lds, int tid, int wave, int lane) {
    const bf16* P = (const bf16*)(a.ws + WS_P); bf16* Y = (bf16*)(a.ws + WS_Y);
    constexpr int HP = 264, OP = 260;
    bf16* hb = (bf16*)lds;
    float* ob = (float*)(lds + 94 * HP * 2);
    asm volatile("" : "+v"(tid), "+v"(lane));
    const size_t rowb = (size_t)b * T;
    for (int ch = tid; ch < 94 * 32; ch += 512) { const int rr = ch >> 5, cc = ch & 31; const int t = t0 - 30 + rr;
        u32x4 v = {0u, 0u, 0u, 0u};
        if (t >= 0) v = *(const u32x4*)(P + (rowb + t) * NIN + 2560 + cc * 8);
        *(u32x4*)(hb + rr * HP + cc * 8) = v; }
    __syncthreads();
    const int cp = tid & 127, tg = tid >> 7;
    const float* cw = inp(a, 24) + (size_t)l * 31 * 256 + 2 * cp;
    const f32x2 cb = *(const f32x2*)(inp(a, 25) + l * 256 + 2 * cp);
    float acc0[16], acc1[16];
#pragma unroll
    for (int i = 0; i < 16; ++i) { acc0[i] = cb[0]; acc1[i] = cb[1]; }
    f32x2 wv[31];
#pragma unroll
    for (int w = 0; w < 31; ++w) wv[w] = *(const f32x2*)(cw + w * 256);
#pragma unroll
    for (int rho = 0; rho < 46; ++rho) { const unsigned hv = *(const unsigned*)(hb + (tg * 16 + rho) * HP + 2 * cp); const float h0 = bflo(hv), h1 = bfhi(hv);
#pragma unroll
        for (int i = 0; i < 16; ++i) { const int w = rho - i; if (w >= 0 && w < 31) { acc0[i] += h0 * wv[w][0]; acc1[i] += h1 * wv[w][1]; } } }
#pragma unroll
    for (int i = 0; i < 16; ++i) *(f32x2*)(ob + (tg * 16 + i) * OP + 2 * cp) = (f32x2){acc0[i], acc1[i]};
    __syncthreads();
    const f32x4 lw = *(const f32x4*)(inp(a, 26) + l * 256 + 4 * lane), lb = *(const f32x4*)(inp(a, 27) + l * 256 + 4 * lane);
    for (int i = 0; i < 8; ++i) { const int tok = wave * 8 + i;
        const f32x4 x = *(const f32x4*)(ob + tok * OP + 4 * lane);
        const float mu = wave_sum((x[0] + x[1]) + (x[2] + x[3])) * (1.f / 256.f);
        const f32x4 d = x - mu;
        const float var = wave_sum((d[0] * d[0] + d[1] * d[1]) + (d[2] * d[2] + d[3] * d[3])) * (1.f / 256.f);
        const f32x4 y = d * rsqrtf(var + 1e-5f) * lw + lb;
        u32x2 w; w.x = pk2(y[0] * sigmoidf_(y[0]), y[1] * sigmoidf_(y[1])); w.y = pk2(y[2] * sigmoidf_(y[2]), y[3] * sigmoidf_(y[3]));
        *(u32x2*)(Y + (rowb + t0 + tok) * 1024 + 768 + 4 * lane) = w; }
    __syncthreads();
}
__device__ __forceinline__ void phase_mix(const Args& a, int l, unsigned char* lds, int tid, int wave, int lane) {
    for (int u = blockIdx.x; u < 512; u += gridDim.x) conv_unit(a, l, u >> 5, (u & 31) * 64, lds, tid, wave, lane);
    const float* YR = (const float*)(a.ws + WS_YR); const h16* SV = (const h16*)(a.ws + WS_S16) + 4 * (size_t)M * 256; const bf16* G = (const bf16*)(a.ws + WS_G);
    const float* SCAL = (const float*)(a.ws + WS_SCAL); bf16* Y = (bf16*)(a.ws + WS_Y);
    const f32x4 lw = *(const f32x4*)(inp(a, 15) + l * 256 + 4 * lane), lb = *(const f32x4*)(inp(a, 16) + l * 256 + 4 * lane);
    const int gw = blockIdx.x * 8 + wave, NGW = gridDim.x * 8;
#pragma unroll 4
    for (int tok = gw; tok < M; tok += NGW) {
        const f32x4 y = *(const f32x4*)(YR + (size_t)tok * 256 + 4 * lane);
        const float mu = rowsum16((y[0] + y[1]) + (y[2] + y[3])) * (1.f / 64.f);
        const f32x4 d = y - mu;
        const float var = rowsum16((d[0] * d[0] + d[1] * d[1]) + (d[2] * d[2] + d[3] * d[3])) * (1.f / 64.f);
        const f32x4 yn = d * rsqrtf(var + 64e-5f) * lw + lb;
        const float bn = SCAL[((size_t)tok * 4 + (lane >> 4)) * 4 + 2];
        const h16x4 v = *(const h16x4*)(SV + (size_t)tok * 256 + 4 * lane);
        const u32x2 gv = *(const u32x2*)(G + (size_t)tok * 256 + 4 * lane);
        u32x2 w; w.x = pk2((yn[0] + bn * (float)v[0]) * bflo(gv.x), (yn[1] + bn * (float)v[1]) * bfhi(gv.x));
        w.y = pk2((yn[2] + bn * (float)v[2]) * bflo(gv.y), (yn[3] + bn * (float)v[3]) * bfhi(gv.y));
        *(u32x2*)(Y + (size_t)tok * 1024 + 4 * lane) = w;
    }
}

#define XB_TMO      128
#define XB_XCNT(j)  (256  + 64 * (j))
#define XB_XSUB(j)  (1280 + 64 * (j))
#define XB_XGEN(j)  (2304 + 64 * (j))
#define XB_TOP      3328
#define XB_TOPGEN   3392
#define XCD_BAR_WORDS 3456
#define XB_SPIN_CAP (1u << 18)

__device__ __forceinline__ unsigned xb_ld(unsigned* p)              { return __hip_atomic_load(p, __ATOMIC_RELAXED, __HIP_MEMORY_SCOPE_AGENT); }
__device__ __forceinline__ unsigned xb_add(unsigned* p, unsigned v) { return __hip_atomic_fetch_add(p, v, __ATOMIC_RELAXED, __HIP_MEMORY_SCOPE_AGENT); }
__device__ __forceinline__ unsigned xb_xcc_id() { return (unsigned)__builtin_amdgcn_s_getreg((3 << 11) | 20) & 0xFu; }
#define XB_SPIN(cond, bar) do { unsigned _sp = 0; while (cond) { __builtin_amdgcn_s_sleep(1); \
    if ((++_sp & 255u) == 0u) { if (xb_ld(&(bar)[XB_TMO])) break; if (_sp > XB_SPIN_CAP) { atomicAdd(&(bar)[XB_TMO], 1u); break; } } } } while (0)

struct XcdBarrier {
    unsigned* bar; unsigned x;
    volatile LAS unsigned* st;
};

__device__ __forceinline__ XcdBarrier xcd_barrier_post(unsigned* bar, volatile LAS unsigned* st) {
    XcdBarrier b; b.bar = bar; b.x = xb_xcc_id(); b.st = st;
    if (threadIdx.x == 0) (void)xb_add(&bar[XB_XCNT(b.x)], 1u);
    return b;
}
__device__ __forceinline__ void xcd_barrier_complete(unsigned* bar, unsigned x, unsigned& nloc, unsigned& nx) {
    const unsigned G = gridDim.x * gridDim.y * gridDim.z;
    unsigned sum, cnt, mine, sp = 0u;
    for (;;) {
        sum = 0u; cnt = 0u; mine = 0u;
#pragma unroll
        for (unsigned j = 0; j < 16; ++j) { const unsigned c = xb_ld(&bar[XB_XCNT(j)]); sum += c; cnt += (c > 0u) ? 1u : 0u; mine = (j == x) ? c : mine; }
        if (sum == G) break;
        __builtin_amdgcn_s_sleep(1);
        if ((++sp & 255u) == 0u) { if (xb_ld(&bar[XB_TMO])) break; if (sp > XB_SPIN_CAP) { atomicAdd(&bar[XB_TMO], 1u); break; } }
    }
    nloc = mine > 0u ? mine : 1u; nx = cnt > 0u ? cnt : 1u;
}

__device__ __forceinline__ void xcd_barrier(const XcdBarrier& b) {
    asm volatile("s_waitcnt vmcnt(0)" ::: "memory");
    __syncthreads();
    if (threadIdx.x == 0) {
        unsigned* bar = b.bar;
        __builtin_amdgcn_s_waitcnt(0);
        unsigned nloc = b.st[0], nx = b.st[1];
        if (nloc == 0u) { xcd_barrier_complete(bar, b.x, nloc, nx); b.st[0] = nloc; b.st[1] = nx; }
        const unsigned old = xb_add(&bar[XB_XSUB(b.x)], 1u);
        const unsigned gen = old / nloc;
        if (old + 1u == (gen + 1u) * nloc) {
            __builtin_amdgcn_fence(__ATOMIC_RELEASE, "agent");
            asm volatile("s_waitcnt vmcnt(0)" ::: "memory");
            const unsigned og = xb_add(&bar[XB_TOP], 1u);
            const unsigned tg = og / nx;
            if (og + 1u == (tg + 1u) * nx) xb_add(&bar[XB_TOPGEN], 1u);
            else XB_SPIN(xb_ld(&bar[XB_TOPGEN]) == tg, bar);
            __builtin_amdgcn_fence(__ATOMIC_ACQUIRE, "agent");
            xb_add(&bar[XB_XGEN(b.x)], 1u);
            asm volatile("s_waitcnt vmcnt(0)" ::: "memory");
        } else {
            XB_SPIN(xb_ld(&bar[XB_XGEN(b.x)]) == gen, bar);
            __builtin_amdgcn_fence(__ATOMIC_ACQUIRE, "agent");
            asm volatile("s_waitcnt vmcnt(0)" ::: "memory");
        }
    }
    __syncthreads();
}

__global__ void __launch_bounds__(512, 2) mk_fwd(Args a) {
    extern __shared__ __attribute__((aligned(16))) unsigned char lds[];
    cg::grid_group grid = cg::this_grid();
    const int wave_s = __builtin_amdgcn_readfirstlane((int)threadIdx.x >> 6);
#define TIDS int lane_ = __builtin_amdgcn_mbcnt_hi(~0u, __builtin_amdgcn_mbcnt_lo(~0u, 0u)); asm volatile("" : "+v"(lane_)); const int lane = lane_, wave = wave_s; int tid = wave * 64 + lane; (void)lane; (void)wave; (void)tid
    unsigned* barw = (unsigned*)(a.ws + WS_BAR);
    if (a.ph_lo == 0 && blockIdx.x == 0) for (int i = threadIdx.x; i < XCD_BAR_WORDS; i += 512) barw[i] = 0u;
    if (threadIdx.x < 2) ((volatile LAS unsigned*)(lds + LDS_CTL))[threadIdx.x] = 0u;
    __syncthreads();
    XcdBarrier xbar; xbar.bar = barw; xbar.x = 0; xbar.st = (volatile LAS unsigned*)(lds + LDS_CTL);
    bool posted = false;
#pragma unroll 1
    for (int ph = a.ph_lo; ph < a.ph_hi; ++ph) {
        if (ph == 0) { { TIDS; phase_weights(a, lds, wave, lane); } __syncthreads(); { TIDS; phase_ada(a, lds, tid, wave, lane); } }
        else {
            const int l = (ph - 1) / 9, k = (ph - 1) % 9;
            const float* modl = (const float*)(a.ws + WS_MOD) + (size_t)l * 16 * 6144;
            if (k == 6 || (k == 0 && l == 1)) continue;
            if (k == 1 || k == 5 || k == 7 || k == 8) {
                const unsigned char* wb = a.ws + WS_WB + (size_t)l * WB_LAYER;
                pg8::Gemm g; pg8::EpiDyn E; E.O = nullptr; E.ldc = 0; E.base = nullptr; E.out = nullptr; E.gate = nullptr;
                E.ssq_in = nullptr; E.bias = nullptr; E.bstride = 0; E.rtab = nullptr; E.XS = nullptr; E.ssq_out = nullptr; E.gn = nullptr; E.scv = nullptr;
                const float* BIAS = (const float*)(a.ws + WS_BIAS);
                if (k == 1) { g.A = (const bf16*)(a.ws + WS_XN); g.Bt = (const bf16*)(wb + WB_IN); g.N = NIN; g.K = D; E.kind = 0; E.O = (bf16*)(a.ws + WS_P); E.ldc = NIN;
                    if (l == 1) { E.ssq_in = (const float*)(a.ws + WS_SSQA); E.bias = BIAS; E.bstride = NIN; } }
                else if (k == 5) { g.A = (const bf16*)(a.ws + WS_Y); g.Bt = (const bf16*)(wb + WB_OUT); g.N = D; g.K = D; E.kind = 2; E.base = l == 0 ? inp(a, 0) : a.out; E.out = a.out; E.gate = modl + 2048;
                    E.XS = (bf16*)(a.ws + WS_XN); E.ssq_out = (float*)(a.ws + WS_SSQB); E.gn = inp(a, 29) + l * 1024; E.scv = modl + 4096; }
                else if (k == 7) { g.A = (const bf16*)(a.ws + WS_XN); g.Bt = (const bf16*)(wb + WB_W1); g.N = FF; g.K = D; E.kind = 1; E.O = (bf16*)(a.ws + WS_H); E.ldc = FF;
                    E.ssq_in = (const float*)(a.ws + WS_SSQB); E.bias = BIAS + 16 * NIN + (size_t)l * 16 * FF; E.bstride = FF; }
                else { g.A = (const bf16*)(a.ws + WS_H); g.Bt = (const bf16*)(wb + WB_W2); g.N = D; g.K = FF; E.kind = 2; E.base = a.out; E.out = a.out; E.gate = modl + 5120;
                    if (l == 0) { E.XS = (bf16*)(a.ws + WS_XN); E.ssq_out = (float*)(a.ws + WS_SSQA); E.gn = inp(a, 4) + 1024; E.scv = (const float*)(a.ws + WS_MOD) + (size_t)16 * 6144 + 1024; } }
                g.M = M;
                pg8::StaticOrder S; S.init(M, g.N, gridDim.x, blockIdx.x);
                E.rtab = (const LAS float*)((LAS unsigned char*)lds + 131072);
                if (E.ssq_in) { TIDS;
                    LAS float* rt = (LAS float*)((LAS unsigned char*)lds + 131072);
                    for (int idx = tid; idx < 8 * 256; idx += 512) { pg8::Unit u_; if (!S.next(idx >> 8, u_)) break;
                        const f32x4* sp = (const f32x4*)(E.ssq_in + (size_t)(u_.pm * 256 + (idx & 255)) * 16); const f32x4 t = (sp[0] + sp[1]) + (sp[2] + sp[3]);
                        rt[idx] = rsqrtf(((t[0] + t[1]) + (t[2] + t[3])) * (1.f / 1024.f) + 1e-6f); }
                    __syncthreads(); }
                { TIDS; pg8::gemm_phase<pg8::EpiDyn, pg8::StaticOrder, true, true>((LAS unsigned char*)lds, g, S, E, tid); }
            }
            else if (k == 0) { TIDS; phase_xn(inp(a, 0), inp(a, 4), modl, 0, 1024, (bf16*)(a.ws + WS_XN), wave, lane); phase_bias(a, wave, lane); }
            else if (k == 2) { TIDS; phase_premix(a, l, lds, tid, wave, lane); }
            else if (k == 3) { TIDS; phase_scan_attn(a, l, lds, tid, wave, lane); }
            else { TIDS; phase_mix(a, l, lds, tid, wave, lane); }
        }
        if (ph + 1 < a.ph_hi) {
            if (!posted) { grid.sync(); xbar = xcd_barrier_post(barw, (volatile LAS unsigned*)(lds + LDS_CTL)); posted = true; }
            else xcd_barrier(xbar);
        }
    }
}

#ifndef MK_MULTI
#define MK_MULTI 0
#endif
extern "C" void kernel_launch(void* const* d_in, const int* in_sizes, int n_in, void* d_out, int out_size, void* d_ws, size_t ws_size, hipStream_t stream) {
    static int grid = 0;
    if (grid == 0) {
        if (n_in != 32 || out_size != M * D || ws_size < WS_END) { fprintf(stderr, "kernel_launch: unexpected shapes (n_in %d out %d ws %zu)\n", n_in, out_size, ws_size); grid = -1; return; }
        int dev = 0, cus = 0, per_cu = 0;
        (void)hipGetDevice(&dev); (void)hipDeviceGetAttribute(&cus, hipDeviceAttributeMultiprocessorCount, dev);
        (void)hipFuncSetAttribute((const void*)mk_fwd, hipFuncAttributeMaxDynamicSharedMemorySize, LDS_BYTES);
        (void)hipOccupancyMaxActiveBlocksPerMultiprocessor(&per_cu, (const void*)mk_fwd, 512, LDS_BYTES);
        if (per_cu < 1) { fprintf(stderr, "kernel_launch: occupancy query says %d blocks per CU\n", per_cu); per_cu = 1; }
        grid = cus * per_cu;
        (void)hipGetLastError();
    }
    if (grid < 0) return;
    Args a{};
    for (int i = 0; i < 32; ++i) a.in[i] = (const float*)d_in[i];
    a.out = (float*)d_out; a.ws = (unsigned char*)d_ws;
#if MK_MULTI
    for (int p = 0; p < 19; ++p) { a.ph_lo = p; a.ph_hi = p + 1; hipLaunchKernelGGL(mk_fwd, dim3(grid), dim3(512), LDS_BYTES, stream, a); }
#else
    a.ph_lo = 0; a.ph_hi = 19;
    void* args[] = {&a};
    hipError_t e = hipLaunchCooperativeKernel((const void*)mk_fwd, dim3(grid), dim3(512), args, LDS_BYTES, stream);
    if (e != hipSuccess) fprintf(stderr, "cooperative launch failed: %s (grid %d)\n", hipGetErrorString(e), grid);
#endif
}
```

```cpp
#include <hip/hip_runtime.h>
#include <hip/hip_cooperative_groups.h>
#include <hip/hip_fp16.h>
#include <cstdio>
#include <cstdint>
namespace cg = cooperative_groups;
namespace pg8 {
#define PG8_LAS __attribute__((address_space(3)))
typedef unsigned short bf16_t;
typedef short bf16x8 __attribute__((ext_vector_type(8)));
typedef float f32x4 __attribute__((ext_vector_type(4)));
typedef unsigned u32x4 __attribute__((ext_vector_type(4)));
constexpr int BM = 256, BK = 64, HALF = 128, HTB = HALF * BK * 2  , STAGE_BYTES = 8 * HTB, NXCD = 8, WGM = 8;

__host__ __device__ __forceinline__ int lds_byte(int r, int c) { const int st = (r >> 4) * 2 + (c >> 5), rr = r & 15, cc = c & 31, ob = rr * 64 + cc * 2; return st * 1024 + (ob ^ (((ob >> 9) & 1) << 5)); }
__host__ __device__ __forceinline__ void stage_rc(int b, int& R, int& C) { const int st = b / 1024, sb = b % 1024, swz = sb ^ (((sb >> 9) & 1) << 5); R = (st >> 1) * 16 + swz / 64; C = (st & 1) * 32 + (swz % 64) / 2; }
__host__ __device__ __forceinline__ int perm32(int rho) { const int n = rho >> 4, i = rho & 15; return 8 * (i >> 2) + 4 * n + (i & 3); }

struct Unit { int pm, pn; };
struct Gemm { const bf16_t* A; const bf16_t* Bt; int M, N, K; };

struct StaticOrder {
    int nM, nN, nwg, G, c;
    __host__ __device__ void init(int M, int N, int G_, int c_) { nM = M / BM; nN = N / BM; nwg = nM * nN; G = G_; c = c_; }
    __host__ __device__ bool next(int i, Unit& u) const {
        const long L = (long)i * G + c; if (L >= nwg) return false;
        int wgid = (int)L; { const int q = nwg / NXCD, r = nwg % NXCD, xcd = wgid % NXCD, off = wgid / NXCD; wgid = (xcd < r ? xcd * (q + 1) : r * (q + 1) + (xcd - r) * q) + off; }
        const int nig = WGM * nN, gid = wgid / nig, fm = gid * WGM, gsz = (nM - fm) < WGM ? (nM - fm) : WGM;
        u.pm = fm + ((wgid % nig) % gsz); u.pn = (wgid % nig) / gsz; return true;
    }
    __device__ __forceinline__ void a_ready(const Unit&) const {}
    __device__ __forceinline__ void done(const Unit&) const {}
};

typedef __bf16 bf16x2_t __attribute__((ext_vector_type(2)));
typedef float f32x2_t __attribute__((ext_vector_type(2)));
__device__ __forceinline__ unsigned cvt_pk_bf16(float lo, float hi) { const f32x2_t v = {lo, hi}; return __builtin_bit_cast(unsigned, __builtin_convertvector(v, bf16x2_t)); }
template <int ACT  > struct EpiAct {
    static constexpr bool PERM = true, AFTER_DRAIN = false;
    bf16_t* O; int ldc;
    __device__ __forceinline__ void operator()(const f32x4 (&acc)[2][2][4][2], const Unit& u, int wr, int wc, int fr, int fq) const {
        const int row0 = u.pm * BM + wr * 64 + fr; const int col0 = u.pn * BM + wc * 32 + 8 * fq;
#pragma unroll
        for (int ai = 0; ai < 2; ++ai)
#pragma unroll
            for (int m = 0; m < 4; ++m) { bf16_t* rowp = O + (size_t)(row0 + ai * HALF + m * 16) * ldc + col0;
#pragma unroll
                for (int bj = 0; bj < 2; ++bj) { f32x4 v0 = acc[ai][bj][m][0], v1 = acc[ai][bj][m][1];
                    if (ACT == 1) {
#pragma unroll
                        for (int e = 0; e < 4; ++e) { float a = fmaxf(v0[e], 0.f), b = fmaxf(v1[e], 0.f); v0[e] = a * a; v1[e] = b * b; } }
                    u32x4 w; w.x = cvt_pk_bf16(v0[0], v0[1]); w.y = cvt_pk_bf16(v0[2], v0[3]); w.z = cvt_pk_bf16(v1[0], v1[1]); w.w = cvt_pk_bf16(v1[2], v1[3]);
                    *(u32x4*)(rowp + bj * HALF) = w; } }
    }
};
struct EpiRes {
    static constexpr bool PERM = false, AFTER_DRAIN = false;
    const float* base; float* out; const float* gate;
    __device__ __forceinline__ void operator()(const f32x4 (&acc)[2][2][4][2], const Unit& u, int wr, int wc, int fr, int fq) const {
        const int col0 = u.pn * BM + wc * 32 + 4 * fq;
        const float* gp = gate + (size_t)((u.pm * BM) >> 11) * 6144 + col0;
        f32x4 gv[2][2];
#pragma unroll
        for (int bj = 0; bj < 2; ++bj)
#pragma unroll
            for (int n = 0; n < 2; ++n) gv[bj][n] = *(const f32x4*)(gp + bj * HALF + n * 16);
#pragma unroll
        for (int ai = 0; ai < 2; ++ai)
#pragma unroll
            for (int m = 0; m < 4; ++m) { const size_t off = (size_t)(u.pm * BM + ai * HALF + wr * 64 + m * 16 + fr) * 1024 + col0;
#pragma unroll
                for (int bj = 0; bj < 2; ++bj)
#pragma unroll
                    for (int n = 0; n < 2; ++n) { const f32x4 bs = *(const f32x4*)(base + off + bj * HALF + n * 16);
                        *(f32x4*)(out + off + bj * HALF + n * 16) = bs + gv[bj][n] * acc[ai][bj][m][n]; } }
    }
};
typedef unsigned u32x2_ __attribute__((ext_vector_type(2)));
__device__ __forceinline__ float shx_(float v, int m) { int l = __builtin_amdgcn_mbcnt_hi(~0u, __builtin_amdgcn_mbcnt_lo(~0u, 0u)); asm volatile("" : "+v"(l));
    return __builtin_bit_cast(float, __builtin_amdgcn_ds_bpermute((l ^ m) << 2, __builtin_bit_cast(int, v))); }
struct EpiDyn {
    static constexpr bool PERM = true, AFTER_DRAIN = false;
    int kind; bf16_t* O; int ldc; const float* base; float* out; const float* gate;
    const float* ssq_in; const float* bias; int bstride; const PG8_LAS float* rtab;
    bf16_t* XS; float* ssq_out; const float* gn; const float* scv;
    __device__ __forceinline__ void operator()(const f32x4 (&acc)[2][2][4][2], const Unit& u, int wr, int wc, int fr, int fq, int ui) const {
        const int row0 = u.pm * BM + wr * 64 + fr; const int col0 = u.pn * BM + wc * 32 + 8 * fq; const int b = (u.pm * BM) >> 11;
        if (kind < 2) {
            f32x4 bv[2][2];
#pragma unroll
            for (int bj = 0; bj < 2; ++bj)
#pragma unroll
                for (int n = 0; n < 2; ++n) bv[bj][n] = ssq_in ? *(const f32x4*)(bias + (size_t)b * bstride + col0 + bj * HALF + n * 4) : (f32x4){0.f, 0.f, 0.f, 0.f};
#pragma unroll
            for (int ai = 0; ai < 2; ++ai)
#pragma unroll
                for (int m = 0; m < 4; ++m) { const int row = row0 + ai * HALF + m * 16; bf16_t* rowp = O + (size_t)row * ldc + col0;
                    float rstd = 1.f;
                    if (ssq_in) rstd = rtab[ui * 256 + wr * 64 + fr + ai * HALF + m * 16];
#pragma unroll
                    for (int bj = 0; bj < 2; ++bj) { f32x4 v0 = acc[ai][bj][m][0] * rstd + bv[bj][0], v1 = acc[ai][bj][m][1] * rstd + bv[bj][1];
                        if (kind == 1) {
#pragma unroll
                            for (int e = 0; e < 4; ++e) { float a = fmaxf(v0[e], 0.f), c = fmaxf(v1[e], 0.f); v0[e] = a * a; v1[e] = c * c; } }
                        u32x4 w; w.x = cvt_pk_bf16(v0[0], v0[1]); w.y = cvt_pk_bf16(v0[2], v0[3]); w.z = cvt_pk_bf16(v1[0], v1[1]); w.w = cvt_pk_bf16(v1[2], v1[3]);
                        *(u32x4*)(rowp + bj * HALF) = w; } }
        } else {
            const float* gp = gate + (size_t)b * 6144 + col0;
            f32x4 gv[2][2], gm[2][2];
#pragma unroll
            for (int bj = 0; bj < 2; ++bj)
#pragma unroll
                for (int n = 0; n < 2; ++n) { gv[bj][n] = *(const f32x4*)(gp + bj * HALF + n * 4);
                    gm[bj][n] = XS ? *(const f32x4*)(gn + col0 + bj * HALF + n * 4) * (*(const f32x4*)(scv + (size_t)b * 6144 + col0 + bj * HALF + n * 4) + 1.f) : (f32x4){0.f, 0.f, 0.f, 0.f}; }
#pragma unroll
            for (int aim = 0; aim < 4; ++aim) { const int ai = aim >> 1, m0 = (aim & 1) * 2;
                f32x4 bs[4][2][2];
#pragma unroll
                for (int m = m0; m < m0 + 2; ++m) { const size_t off = (size_t)(row0 + ai * HALF + m * 16) * 1024 + col0;
#pragma unroll
                    for (int bj = 0; bj < 2; ++bj)
#pragma unroll
                        for (int n = 0; n < 2; ++n) bs[m][bj][n] = *(const f32x4*)(base + off + bj * HALF + n * 4); }
                asm volatile("" ::: "memory");
#pragma unroll
                for (int m = m0; m < m0 + 2; ++m) { const int row = row0 + ai * HALF + m * 16; const size_t off = (size_t)row * 1024 + col0; float sq = 0.f;
#pragma unroll
                    for (int bj = 0; bj < 2; ++bj)
#pragma unroll
                        for (int n = 0; n < 2; ++n) {
                            const f32x4 o = bs[m][bj][n] + gv[bj][n] * acc[ai][bj][m][n];
                            *(f32x4*)(out + off + bj * HALF + n * 4) = o;
                            if (XS) { sq += (o[0] * o[0] + o[1] * o[1]) + (o[2] * o[2] + o[3] * o[3]); const f32x4 x = o * gm[bj][n];
                                u32x2_ w; w.x = cvt_pk_bf16(x[0], x[1]); w.y = cvt_pk_bf16(x[2], x[3]); *(u32x2_*)(XS + off + bj * HALF + n * 4) = w; } }
                    if (XS) { sq += shx_(sq, 16); sq += shx_(sq, 32); if (fq == 0) ssq_out[(size_t)row * 16 + u.pn * 4 + wc] = sq; } }
                asm volatile("" ::: "memory");
            }
        }
    }
};
template <class Epi, class Sched, bool ALIGN_EPI = false, bool SP2 = false>
__device__ __forceinline__ void gemm_phase(PG8_LAS unsigned char* lds, const Gemm g, const Sched& S, const Epi& E, const int tid_in) {
    int tid = tid_in; asm volatile("" : "+v"(tid));
    const int wid = __builtin_amdgcn_readfirstlane(tid >> 6), lane = tid & 63, wr = wid >> 2, wc = wid & 3, fr = lane & 15, fq = lane >> 4;
    const int K = g.K, nt = K / BK;
    unsigned voffA[2], voffB[2];
#pragma unroll
    for (int i = 0; i < 2; ++i) { int R, C; stage_rc(tid * 16 + i * 8192, R, C); const int Rb = Epi::PERM ? ((R & ~31) + perm32(R & 31)) : R;
        voffA[i] = (unsigned)(R * K + C) * 2u; voffB[i] = (unsigned)(Rb * K + C) * 2u; }
    const size_t kstep = (size_t)(BK * 2);
    const size_t hstep = (size_t)HALF * K * 2;
    const size_t tstep = 2 * hstep;
    const unsigned ldsw = (unsigned)wid * 1024u;
    const int aoff = lds_byte(wr * 64 + fr, fq * 8), boff = lds_byte(wc * 32 + fr, fq * 8);
#define PG8_SA(b, h) (((b) * 2 + (h)) * HTB)
#define PG8_SB(b, h) ((4 + (b) * 2 + (h)) * HTB)
#define PG8_STAGE(bufoff, gbase, voff) do { _Pragma("unroll") for (int _i = 0; _i < 2; ++_i) \
        __builtin_amdgcn_global_load_lds((const unsigned*)((const char*)(gbase) + (voff)[_i]), (PG8_LAS unsigned*)(lds + (bufoff) + ldsw + _i * 8192), 16, 0, 0); } while (0)
#define PG8_LDA(dst, b, h) do { _Pragma("unroll") for (int m = 0; m < 4; ++m) _Pragma("unroll") for (int k = 0; k < 2; ++k) dst[m][k] = *(const PG8_LAS bf16x8*)(lds + PG8_SA(b, h) + aoff + m * 2048 + k * 1024); } while (0)
#define PG8_LDB(dst, b, h) do { _Pragma("unroll") for (int n = 0; n < 2; ++n) _Pragma("unroll") for (int k = 0; k < 2; ++k) dst[n][k] = *(const PG8_LAS bf16x8*)(lds + PG8_SB(b, h) + boff + n * 2048 + k * 1024); } while (0)
#define PG8_MMA(ai, bj, At, Bt) do { __builtin_amdgcn_s_setprio(1); _Pragma("unroll") for (int m = 0; m < 4; ++m) _Pragma("unroll") for (int n = 0; n < 2; ++n) _Pragma("unroll") for (int k = 0; k < 2; ++k) \
        acc[ai][bj][m][n] = __builtin_amdgcn_mfma_f32_16x16x32_bf16(Bt[n][k], At[m][k], acc[ai][bj][m][n], 0, 0, 0); __builtin_amdgcn_s_setprio(0); } while (0)
#define PG8_WAIT_V(n) asm volatile("s_waitcnt vmcnt(" #n ")" ::: "memory")
#define PG8_WAIT_L(n) asm volatile("s_waitcnt lgkmcnt(" #n ")" ::: "memory")
#define PG8_BAR __builtin_amdgcn_s_barrier()
#define PG8_SCHED __builtin_amdgcn_sched_barrier(0)
    Unit cur, nxt; int ui = 0;
    if (!S.next(0, cur)) return;
    f32x4 acc[2][2][4][2];
#pragma unroll
    for (int a = 0; a < 2; ++a)
#pragma unroll
        for (int b = 0; b < 2; ++b)
#pragma unroll
            for (int m = 0; m < 4; ++m)
#pragma unroll
                for (int n = 0; n < 2; ++n) acc[a][b][m][n] = (f32x4){0.f, 0.f, 0.f, 0.f};
    bf16x8 At[4][2], B0[2][2], B1[2][2];
    const char* cA = (const char*)g.A + (size_t)cur.pm * tstep; const char* cB = (const char*)g.Bt + (size_t)cur.pn * tstep;
    S.a_ready(cur);
    if constexpr (SP2) {
        PG8_STAGE(PG8_SB(0, 0), cB, voffB); PG8_STAGE(PG8_SB(0, 1), cB + hstep, voffB); PG8_STAGE(PG8_SA(0, 0), cA, voffA); PG8_STAGE(PG8_SA(0, 1), cA + hstep, voffA);
        if (wr == 1) PG8_BAR;
        PG8_WAIT_V(2); PG8_BAR;
        PG8_STAGE(PG8_SB(1, 0), cB + kstep, voffB); PG8_STAGE(PG8_SA(1, 0), cA + kstep, voffA); PG8_STAGE(PG8_SB(1, 1), cB + hstep + kstep, voffB);
        PG8_WAIT_V(6); PG8_BAR;
    } else {
        PG8_STAGE(PG8_SB(0, 0), cB, voffB); PG8_STAGE(PG8_SA(0, 0), cA, voffA); PG8_STAGE(PG8_SB(0, 1), cB + hstep, voffB); PG8_STAGE(PG8_SA(0, 1), cA + hstep, voffA);
        if (wr == 1) PG8_BAR;
        PG8_WAIT_V(4); PG8_BAR;
        PG8_STAGE(PG8_SB(1, 0), cB + kstep, voffB); PG8_STAGE(PG8_SA(1, 0), cA + kstep, voffA); PG8_STAGE(PG8_SB(1, 1), cB + hstep + kstep, voffB);
        PG8_WAIT_V(6); PG8_BAR;
    }
    for (;;) {
        const bool has_next = S.next(ui + 1, nxt);
        const char* nA = has_next ? (const char*)g.A + (size_t)nxt.pm * tstep : cA; const char* nB = has_next ? (const char*)g.Bt + (size_t)nxt.pn * tstep : cB;
        for (int t = 0; t < nt; t += 2) {
            const bool last = (t == nt - 2);
            const char* a1 = cA + (size_t)(t + 1) * kstep;
            const char* a2 = last ? nA : cA + (size_t)(t + 2) * kstep; const char* b2 = last ? nB : cB + (size_t)(t + 2) * kstep;
            const char* a3 = a2 + kstep; const char* b3 = b2 + kstep;
            if (last && has_next) S.a_ready(nxt);
            if constexpr (SP2) {
            PG8_LDB(B0, 0, 0); PG8_LDB(B1, 0, 1); PG8_SCHED; PG8_LDA(At, 0, 0); PG8_STAGE(PG8_SA(1, 1), a1 + hstep, voffA);
            PG8_WAIT_V(8); PG8_WAIT_L(0); PG8_BAR; PG8_MMA(0, 0, At, B0); PG8_MMA(0, 1, At, B1); PG8_BAR; PG8_SCHED;
            PG8_LDA(At, 0, 1); PG8_STAGE(PG8_SB(0, 0), b2, voffB); PG8_STAGE(PG8_SB(0, 1), b2 + hstep, voffB); PG8_STAGE(PG8_SA(0, 0), a2, voffA);
            PG8_WAIT_V(8); PG8_WAIT_L(0); PG8_BAR; PG8_MMA(1, 0, At, B0); PG8_MMA(1, 1, At, B1); PG8_BAR; PG8_SCHED;
            PG8_LDB(B0, 1, 0); PG8_LDB(B1, 1, 1); PG8_SCHED; PG8_LDA(At, 1, 0); PG8_STAGE(PG8_SA(0, 1), a2 + hstep, voffA);
            PG8_WAIT_V(8); PG8_WAIT_L(0); PG8_BAR; PG8_MMA(0, 0, At, B0); PG8_MMA(0, 1, At, B1); PG8_BAR; PG8_SCHED;
            PG8_LDA(At, 1, 1); PG8_STAGE(PG8_SB(1, 0), b3, voffB); PG8_STAGE(PG8_SB(1, 1), b3 + hstep, voffB); PG8_STAGE(PG8_SA(1, 0), a3, voffA);
            PG8_WAIT_V(8); PG8_WAIT_L(0); PG8_BAR; PG8_MMA(1, 0, At, B0); PG8_MMA(1, 1, At, B1); PG8_BAR; PG8_SCHED;
            } else {
            PG8_LDB(B0, 0, 0); PG8_SCHED; PG8_LDA(At, 0, 0); PG8_STAGE(PG8_SA(1, 1), a1 + hstep, voffA);
            PG8_WAIT_L(8); PG8_BAR; PG8_WAIT_L(0); PG8_MMA(0, 0, At, B0); PG8_BAR; PG8_SCHED;
            PG8_LDB(B1, 0, 1); PG8_STAGE(PG8_SB(0, 0), b2, voffB);
            PG8_BAR; PG8_WAIT_L(0); PG8_MMA(0, 1, At, B1); PG8_BAR;
            PG8_LDA(At, 0, 1); PG8_STAGE(PG8_SA(0, 0), a2, voffA);
            PG8_BAR; PG8_WAIT_L(0); PG8_MMA(1, 0, At, B0); PG8_BAR; PG8_SCHED;
            PG8_STAGE(PG8_SB(0, 1), b2 + hstep, voffB);
            PG8_WAIT_V(6); PG8_BAR; PG8_MMA(1, 1, At, B1); PG8_BAR;
            PG8_LDB(B0, 1, 0); PG8_SCHED; PG8_LDA(At, 1, 0); PG8_STAGE(PG8_SA(0, 1), a2 + hstep, voffA);
            PG8_WAIT_L(8); PG8_BAR; PG8_WAIT_L(0); PG8_MMA(0, 0, At, B0); PG8_BAR; PG8_SCHED;
            PG8_LDB(B1, 1, 1); PG8_STAGE(PG8_SB(1, 0), b3, voffB);
            PG8_BAR; PG8_WAIT_L(0); PG8_MMA(0, 1, At, B1); PG8_BAR;
            PG8_LDA(At, 1, 1); PG8_STAGE(PG8_SA(1, 0), a3, voffA);
            PG8_BAR; PG8_WAIT_L(0); PG8_MMA(1, 0, At, B0); PG8_BAR; PG8_SCHED;
            PG8_STAGE(PG8_SB(1, 1), b3 + hstep, voffB);
            PG8_WAIT_V(6); PG8_BAR; PG8_MMA(1, 1, At, B1); PG8_BAR;
            }
        }
        if constexpr (ALIGN_EPI) { if (wr == 0) PG8_BAR; }
        if constexpr (!Epi::AFTER_DRAIN) { E(acc, cur, wr, wc, fr, fq, ui); S.done(cur); }
        if (!has_next) break;
#pragma unroll
        for (int a = 0; a < 2; ++a)
#pragma unroll
            for (int b = 0; b < 2; ++b)
#pragma unroll
                for (int m = 0; m < 4; ++m)
#pragma unroll
                    for (int n = 0; n < 2; ++n) acc[a][b][m][n] = (f32x4){0.f, 0.f, 0.f, 0.f};
        cur = nxt; cA = nA; cB = nB; ++ui;
        if constexpr (ALIGN_EPI) { if (wr == 1) PG8_BAR; }
    }
    PG8_WAIT_V(0);
    if constexpr (!ALIGN_EPI) { if (wr == 0) PG8_BAR; }
    PG8_BAR;
    if constexpr (Epi::AFTER_DRAIN) { E.fused(acc, cur, wr, wc, fr, fq, lds, wid, lane); S.done(cur); }
#undef PG8_SA
#undef PG8_SB
#undef PG8_STAGE
#undef PG8_LDA
#undef PG8_LDB
#undef PG8_MMA
#undef PG8_WAIT_V
#undef PG8_WAIT_L
#undef PG8_BAR
#undef PG8_SCHED
}
}

constexpr int BATCH = 16, T = 2048, D = 1024, M = BATCH * T, NIN = 3072, FF = 4096;
constexpr size_t MiB = 1u << 20;
constexpr size_t WS_WB = 1 * MiB;
constexpr size_t WB_LAYER = 24 * MiB, WB_IN = 0, WB_OUT = 6 * MiB, WB_W1 = 8 * MiB, WB_W2 = 16 * MiB;
constexpr size_t WS_MOD = 49 * MiB;
constexpr size_t WS_LORA = 50 * MiB;
constexpr size_t LORA_LAYER = 131072, LORA_W2 = 0, LORA_A2 = 32768, LORA_G2 = 65536;
constexpr size_t WS_SCAL = 51 * MiB;
constexpr size_t WS_XN = 53 * MiB;
constexpr size_t WS_SW = WS_XN, WS_YR = WS_XN + 32 * MiB;
constexpr size_t WS_Y = 117 * MiB;
constexpr size_t WS_P = 181 * MiB;
constexpr size_t WS_S16 = 373 * MiB;
constexpr size_t S16_ARR = 16 * MiB;
constexpr size_t WS_G = 453 * MiB;
constexpr size_t WS_H = WS_P;
constexpr size_t WS_VT = 469 * MiB;
constexpr size_t WS_SSQA = 501 * MiB, WS_SSQB = 503 * MiB;
constexpr size_t WS_BIAS = 505 * MiB;
constexpr size_t WS_END = 506 * MiB;
constexpr int LDS_BYTES = 147456;
constexpr size_t WS_BAR = 16384;
constexpr int LDS_CTL = LDS_BYTES - 64;

#define LAS __attribute__((address_space(3)))
typedef unsigned short bf16;
typedef _Float16 h16;
typedef float f32x4 __attribute__((ext_vector_type(4)));
typedef float f32x2 __attribute__((ext_vector_type(2)));
typedef short bf16x8 __attribute__((ext_vector_type(8)));
typedef unsigned u32x4 __attribute__((ext_vector_type(4)));
typedef unsigned u32x2 __attribute__((ext_vector_type(2)));
typedef h16 h16x4 __attribute__((ext_vector_type(4)));
typedef h16 h16x8 __attribute__((ext_vector_type(8)));

__device__ __forceinline__ unsigned pk2(float lo, float hi) { return pg8::cvt_pk_bf16(lo, hi); }
__device__ __forceinline__ unsigned f2bf(float f) { return pg8::cvt_pk_bf16(f, 0.f) & 0xffffu; }
__device__ __forceinline__ float bf2f(unsigned h) { return __builtin_bit_cast(float, h << 16); }
__device__ __forceinline__ float bflo(unsigned w) { return __builtin_bit_cast(float, w << 16); }
__device__ __forceinline__ float bfhi(unsigned w) { return __builtin_bit_cast(float, w & 0xffff0000u); }
__device__ __forceinline__ float shx(float v, int m) { int l = __builtin_amdgcn_mbcnt_hi(~0u, __builtin_amdgcn_mbcnt_lo(~0u, 0u)); asm volatile("" : "+v"(l));
    return __builtin_bit_cast(float, __builtin_amdgcn_ds_bpermute((l ^ m) << 2, __builtin_bit_cast(int, v))); }
__device__ __forceinline__ float wave_sum(float v) {
#pragma unroll
    for (int o = 1; o < 64; o <<= 1) v += shx(v, o);
    return v;
}
__device__ __forceinline__ float sum16(float v) {
    v += shx(v, 1); v += shx(v, 2); v += shx(v, 4); v += shx(v, 8); return v;
}
__device__ __forceinline__ float sigmoidf_(float x) { return 1.f / (1.f + __expf(-x)); }
#define LDS_WAIT() asm volatile("s_waitcnt lgkmcnt(0)" ::: "memory")

struct Args { const float* in[32]; float* out; unsigned char* ws; int ph_lo, ph_hi; };

__device__ __forceinline__ const float* inp(const Args& a, int i) { asm volatile("" : "+s"(i)); return a.in[i]; }
__device__ __forceinline__ void p0_transpose_item(const float* W, int K, int N, bf16* WT, float* scr, int item, int lane) {
    const int nblk = N / 32, kb = item / nblk, nb = item % nblk, k0 = 64 * kb, n0 = 32 * nb;
#pragma unroll 8
    for (int i = 0; i < 32; ++i) { const int kk = 2 * i + (lane >> 5); scr[kk * 33 + (lane & 31)] = W[(size_t)(k0 + kk) * N + n0 + (lane & 31)]; }
    LDS_WAIT(); asm volatile("" ::: "memory");
    const int c = lane & 7;
#pragma unroll
    for (int j = 0; j < 4; ++j) { const int n = (lane >> 3) + 8 * j; const float* s = scr + (8 * c) * 33 + n;
        u32x4 o; o.x = pk2(s[0 * 33], s[1 * 33]); o.y = pk2(s[2 * 33], s[3 * 33]); o.z = pk2(s[4 * 33], s[5 * 33]); o.w = pk2(s[6 * 33], s[7 * 33]);
        *(u32x4*)(WT + (size_t)(n0 + n) * K + k0 + 8 * c) = o; }
    LDS_WAIT(); asm volatile("" ::: "memory");
}
__device__ __forceinline__ void phase_weights(const Args& a, unsigned char* lds, int wave, int lane) {
    float* scr = (float*)(lds + wave * 16384);
    const int gw = blockIdx.x * 8 + wave, NGW = gridDim.x * 8;
    constexpr int I_IN = 16 * 96, I_OUT = 16 * 32, I_W1 = 16 * 128, I_W2 = 64 * 32, I_L2 = 8, I_G2 = 16;
    constexpr int PER = I_IN + I_OUT + I_W1 + I_W2 + 2 * I_L2 + I_G2;
    for (int it = gw; it < 2 * PER; it += NGW) {
        const int l = it / PER; int r = it % PER;
        unsigned char* wb = a.ws + WS_WB + (size_t)l * WB_LAYER; unsigned char* lo = a.ws + WS_LORA + (size_t)l * LORA_LAYER;
        if (r < I_IN) { p0_transpose_item(inp(a, 5) + (size_t)l * D * NIN, D, NIN, (bf16*)(wb + WB_IN), scr, r, lane); continue; } r -= I_IN;
        if (r < I_OUT) { p0_transpose_item(inp(a, 28) + (size_t)l * D * D, D, D, (bf16*)(wb + WB_OUT), scr, r, lane); continue; } r -= I_OUT;
        if (r < I_W1) { p0_transpose_item(inp(a, 30) + (size_t)l * D * FF, D, FF, (bf16*)(wb + WB_W1), scr, r, lane); continue; } r -= I_W1;
        if (r < I_W2) { p0_transpose_item(inp(a, 31) + (size_t)l * FF * D, FF, D, (bf16*)(wb + WB_W2), scr, r, lane); continue; } r -= I_W2;
        if (r < I_L2) { p0_transpose_item(inp(a, 8) + (size_t)l * 64 * 256, 64, 256, (bf16*)(lo + LORA_W2), scr, r, lane); continue; } r -= I_L2;
        if (r < I_L2) { p0_transpose_item(inp(a, 10) + (size_t)l * 64 * 256, 64, 256, (bf16*)(lo + LORA_A2), scr, r, lane); continue; } r -= I_L2;
        p0_transpose_item(inp(a, 11) + (size_t)l * 128 * 256, 128, 256, (bf16*)(lo + LORA_G2), scr, r, lane);
    }
}
__device__ __forceinline__ void phase_ada(const Args& a, unsigned char* lds, int tid, int wave, int lane) {
    float* cond = (float*)lds; float* red = cond + 16384;
    const float* c = inp(a, 1); float* mod = (float*)(a.ws + WS_MOD);
    for (int i = tid; i < 16384; i += 512) { const float v = c[i]; cond[i] = v / (1.f + __expf(-v)); }
    __syncthreads();
    for (int item = blockIdx.x; item < 192; item += gridDim.x) {
        const int l = item / 96, n0 = (item % 96) * 64;
        const float* W = inp(a, 2) + (size_t)l * 1024 * 6144 + n0 + lane;
        float acc[16];
#pragma unroll
        for (int b = 0; b < 16; ++b) acc[b] = 0.f;
        const int k0 = wave * 128;
#pragma unroll 2
        for (int k = k0; k < k0 + 128; k += 4) {
            const float w0 = W[(size_t)k * 6144], w1 = W[(size_t)(k + 1) * 6144], w2 = W[(size_t)(k + 2) * 6144], w3 = W[(size_t)(k + 3) * 6144];
#pragma unroll
            for (int b = 0; b < 16; ++b) { const f32x4 cv = *(const f32x4*)(cond + b * 1024 + k); acc[b] += cv[0] * w0 + cv[1] * w1 + cv[2] * w2 + cv[3] * w3; }
        }
#pragma unroll
        for (int b = 0; b < 16; ++b) red[(wave * 16 + b) * 64 + lane] = acc[b];
        __syncthreads();
        for (int o = tid; o < 1024; o += 512) { const int b = o >> 6, n = o & 63; float s = 0.f;
#pragma unroll
            for (int w = 0; w < 8; ++w) s += red[(w * 16 + b) * 64 + n];
            mod[(size_t)(l * 16 + b) * 6144 + n0 + n] = s + inp(a, 3)[(size_t)l * 6144 + n0 + n]; }
        __syncthreads();
    }
}
__device__ __forceinline__ void phase_xn(const float* x, const float* g, const float* modl, int sh_off, int sc_off, bf16* XN, int wave, int lane) {
    const int gw = blockIdx.x * 8 + wave, NGW = gridDim.x * 8;
    for (int m = gw; m < M; m += NGW) {
        const int b = m >> 11;
        const f32x4* xr = (const f32x4*)(x + (size_t)m * D) + lane;
        f32x4 v[4]; float ss = 0.f;
#pragma unroll
        for (int j = 0; j < 4; ++j) { v[j] = xr[64 * j]; ss += (v[j][0] * v[j][0] + v[j][1] * v[j][1]) + (v[j][2] * v[j][2] + v[j][3] * v[j][3]); }
        const float rstd = rsqrtf(wave_sum(ss) * (1.f / D) + 1e-6f);
        const float* mb = modl + (size_t)b * 6144;
#pragma unroll
        for (int j = 0; j < 4; ++j) { const int col = 4 * lane + 256 * j;
            const f32x4 gg = *(const f32x4*)(g + col), sc = *(const f32x4*)(mb + sc_off + col), sh = *(const f32x4*)(mb + sh_off + col);
            const f32x4 y = (v[j] * rstd) * gg * (sc + 1.f) + sh;
            u32x2 w; w.x = pk2(y[0], y[1]); w.y = pk2(y[2], y[3]);
            *(u32x2*)(XN + (size_t)m * D + col) = w; }
    }
}

__device__ __forceinline__ f32x4 mfma16(bf16x8 A, bf16x8 B, f32x4 C) { return __builtin_amdgcn_mfma_f32_16x16x32_bf16(A, B, C, 0, 0, 0); }
__device__ __forceinline__ void phase_bias(const Args& a, int wave, int lane) {
    const int gw = blockIdx.x * 8 + wave, NGW = gridDim.x * 8;
    const int r = lane & 15, g = lane >> 4;
    float* BIAS = (float*)(a.ws + WS_BIAS);
    for (int t = gw; t < 704; t += NGW) {
        int idx, tile; if (t < 192) { idx = 0; tile = t; } else if (t < 448) { idx = 1; tile = t - 192; } else { idx = 2; tile = t - 448; }
        const int lsel = idx == 1 ? 0 : 1, N = idx == 0 ? NIN : FF;
        const float* sh = (const float*)(a.ws + WS_MOD) + (size_t)lsel * 16 * 6144 + (idx == 0 ? 0 : 3072) + (size_t)r * 6144 + g * 8;
        const bf16* Bt = (const bf16*)(a.ws + WS_WB + (size_t)lsel * WB_LAYER + (idx == 0 ? WB_IN : WB_W1)) + (size_t)(tile * 16 + r) * 1024 + g * 8;
        float* outp = BIAS + (idx == 0 ? 0 : (idx == 1 ? 16 * NIN : 16 * NIN + 16 * FF));
        f32x4 acc = {0.f, 0.f, 0.f, 0.f};
#pragma unroll 4
        for (int ks = 0; ks < 32; ++ks) {
            const f32x4 x0 = *(const f32x4*)(sh + ks * 32), x1 = *(const f32x4*)(sh + ks * 32 + 4);
            u32x4 hi, lo;
            hi.x = pk2(x0[0], x0[1]); hi.y = pk2(x0[2], x0[3]); hi.z = pk2(x1[0], x1[1]); hi.w = pk2(x1[2], x1[3]);
            lo.x = pk2(x0[0] - bflo(hi.x), x0[1] - bfhi(hi.x)); lo.y = pk2(x0[2] - bflo(hi.y), x0[3] - bfhi(hi.y));
            lo.z = pk2(x1[0] - bflo(hi.z), x1[1] - bfhi(hi.z)); lo.w = pk2(x1[2] - bflo(hi.w), x1[3] - bfhi(hi.w));
            const bf16x8 B = *(const bf16x8*)(Bt + ks * 32);
            acc = mfma16(__builtin_bit_cast(bf16x8, hi), B, acc); acc = mfma16(__builtin_bit_cast(bf16x8, lo), B, acc);
        }
#pragma unroll
        for (int j = 0; j < 4; ++j) outp[(size_t)(4 * g + j) * N + tile * 16 + r] = acc[j];
    }
}

template <int CTRL> __device__ __forceinline__ float dppf(float x) { return __builtin_bit_cast(float, __builtin_amdgcn_update_dpp(0, __builtin_bit_cast(int, x), CTRL, 0xf, 0xf, true)); }
__device__ __forceinline__ float rowsum16(float x) { x += dppf<0xB1>(x); x += dppf<0x4E>(x); x += dppf<0x124>(x); x += dppf<0x128>(x); return x; }
__device__ __forceinline__ float softplusf_(float x) { return x > 0.f ? x + log1pf(__expf(-x)) : log1pf(__expf(x)); }
__device__ __forceinline__ float sel4(f32x4 v, int j) { return j == 0 ? v[0] : (j == 1 ? v[1] : (j == 2 ? v[2] : v[3])); }
__device__ __forceinline__ float tanhf_(float x) { return 1.f - 2.f / (1.f + __expf(2.f * x)); }
__device__ __forceinline__ void phase_premix(const Args& a, int l, unsigned char* lds, int tid, int wave, int lane) {
    bf16* P = (bf16*)(a.ws + WS_P);
    const bf16* w2t = (const bf16*)(a.ws + WS_LORA + (size_t)l * LORA_LAYER + LORA_W2);
    const bf16* a2t = (const bf16*)(a.ws + WS_LORA + (size_t)l * LORA_LAYER + LORA_A2);
    const bf16* g2t = (const bf16*)(a.ws + WS_LORA + (size_t)l * LORA_LAYER + LORA_G2);
    h16* S16 = (h16*)(a.ws + WS_S16); float* SW = (float*)(a.ws + WS_SW); bf16* G = (bf16*)(a.ws + WS_G); float* SCAL = (float*)(a.ws + WS_SCAL);
    constexpr size_t ARR = (size_t)M * 256;
    bf16* praw = (bf16*)lds;
    bf16* act = (bf16*)(lds + 33 * 2048);
    bf16* vbuf = (bf16*)(lds + 33 * 2048 + 32 * 264 * 2);
    float* par = (float*)(lds + 33 * 2048 + 32 * 264 * 2 + 32 * 520 * 2);
    bf16* VT = (bf16*)(a.ws + WS_VT);
    if (tid < 256) { const float* mu = inp(a, 6) + l * 1024;
        par[tid] = mu[tid]; par[256 + tid] = mu[256 + tid]; par[512 + tid] = mu[512 + tid]; par[768 + tid] = mu[768 + tid];
        par[1024 + tid] = inp(a, 7)[l * 256 + tid]; par[1280 + tid] = inp(a, 9)[l * 256 + tid]; par[1536 + tid] = inp(a, 12)[l * 256 + tid];
        par[1792 + tid] = inp(a, 13)[l * 256 + tid]; par[2048 + tid] = inp(a, 14)[l * 256 + tid]; }
    else if (tid < 320) par[2304 + tid - 256] = inp(a, 17)[l * 64 + tid - 256];
    else if (tid < 384) par[2368 + tid - 320] = inp(a, 18)[l * 64 + tid - 320];
    __syncthreads();
    for (int tile = blockIdx.x; tile < M / 32; tile += gridDim.x) {
        int ln_ = lane; asm volatile("" : "+v"(ln_)); const int r = ln_ & 15, g = ln_ >> 4;
        const int b = tile >> 6, t0 = (tile & 63) * 32; const size_t row0 = (size_t)b * T + t0;
        const int tt = wave >> 2, h = wave & 3;
        u32x4 pr_[9], vv_[4], q0_[4], q1_[4]; u32x2 ga_[4], gb_[4];
#pragma unroll
        for (int i = 0; i < 9; ++i) { const int ch = tid + 512 * i, rr = ch >> 7, cc = ch & 127; pr_[i] = (u32x4){0u, 0u, 0u, 0u};
            if (ch < 33 * 128 && (rr > 0 || t0 > 0)) pr_[i] = *(const u32x4*)(P + (row0 + rr - 1) * NIN + cc * 8); }
#pragma unroll
        for (int i = 0; i < 4; ++i) { const int ch = tid + 512 * i, rr = ch >> 6, cc = ch & 63; vv_[i] = *(const u32x4*)(P + (row0 + rr) * NIN + 2048 + cc * 8);
            const bf16* prow = P + (row0 + wave * 4 + i) * NIN;
            q0_[i] = *(const u32x4*)(prow + 1024 + ln_ * 16); q1_[i] = *(const u32x4*)(prow + 1024 + ln_ * 16 + 8);
            ga_[i] = *(const u32x2*)(prow + 2560 + ln_ * 4); gb_[i] = *(const u32x2*)(prow + 2816 + ln_ * 4); }
#pragma unroll
        for (int i = 0; i < 9; ++i) { const int ch = tid + 512 * i, rr = ch >> 7, cc = ch & 127; if (ch < 33 * 128) *(u32x4*)(praw + rr * 1024 + cc * 8) = pr_[i]; }
#pragma unroll
        for (int i = 0; i < 4; ++i) { const int ch = tid + 512 * i, rr = ch >> 6, cc = ch & 63; *(u32x4*)(vbuf + rr * 520 + cc * 8) = vv_[i]; }
        {
            const float* gam = par + (ln_ < 32 ? 2304 : 2368) + (ln_ & 3) * 16;
            const float qs_ = ln_ < 32 ? 0.125f * 1.4426950408889634f : 1.f;
#pragma unroll
            for (int i = 0; i < 4; ++i) { bf16* prow = P + (row0 + wave * 4 + i) * NIN;
                float f[16];
#pragma unroll
                for (int e = 0; e < 4; ++e) { f[2 * e] = bflo(q0_[i][e]); f[2 * e + 1] = bfhi(q0_[i][e]); f[8 + 2 * e] = bflo(q1_[i][e]); f[8 + 2 * e + 1] = bfhi(q1_[i][e]); }
                float ss = 0.f;
#pragma unroll
                for (int e = 0; e < 16; ++e) ss += f[e] * f[e];
                ss += dppf<0xB1>(ss); ss += dppf<0x4E>(ss);
                const float sc = rsqrtf(ss * (1.f / 64.f) + 1e-6f) * qs_;
                u32x4 o0, o1;
#pragma unroll
                for (int e = 0; e < 4; ++e) { o0[e] = pk2(f[2 * e] * sc * gam[2 * e], f[2 * e + 1] * sc * gam[2 * e + 1]); o1[e] = pk2(f[8 + 2 * e] * sc * gam[8 + 2 * e], f[8 + 2 * e + 1] * sc * gam[8 + 2 * e + 1]); }
                *(u32x4*)(prow + 1024 + ln_ * 16) = o0; *(u32x4*)(prow + 1024 + ln_ * 16 + 8) = o1;
                u32x2 hv;
                hv.x = pk2(bflo(ga_[i].x) * sigmoidf_(bflo(gb_[i].x)), bfhi(ga_[i].x) * sigmoidf_(bfhi(gb_[i].x)));
                hv.y = pk2(bflo(ga_[i].y) * sigmoidf_(bflo(gb_[i].y)), bfhi(ga_[i].y) * sigmoidf_(bfhi(gb_[i].y)));
                *(u32x2*)(prow + 2560 + ln_ * 4) = hv; }
        }
        __syncthreads();
        bf16x8 Bw[2][4], Ba[2][4], Bg[4][4];
#pragma unroll
        for (int ct = 0; ct < 4; ++ct) {
#pragma unroll
            for (int ks = 0; ks < 2; ++ks) { const size_t wo = (size_t)(h * 64 + ct * 16 + r) * 64 + ks * 32 + g * 8; Bw[ks][ct] = *(const bf16x8*)(w2t + wo); Ba[ks][ct] = *(const bf16x8*)(a2t + wo); }
#pragma unroll
            for (int ks = 0; ks < 4; ++ks) Bg[ks][ct] = *(const bf16x8*)(g2t + (size_t)(h * 64 + ct * 16 + r) * 128 + ks * 32 + g * 8); }
        {
            bf16* dst = VT + ((size_t)b * 512 + tid) * T + t0;
#pragma unroll
            for (int q = 0; q < 4; ++q) { u32x4 o;
#pragma unroll
                for (int e = 0; e < 4; ++e) { const int k0_ = (e >> 1) * 16 + q * 4 + (e & 1) * 2; o[e] = (unsigned)vbuf[k0_ * 520 + tid] | ((unsigned)vbuf[(k0_ + 1) * 520 + tid] << 16); }
                *(u32x4*)(dst + q * 8) = o; } }
#pragma unroll 4
        for (int idx = tid; idx < 32 * 256; idx += 512) { const int tok = idx >> 8, c = idx & 255, col = 768 + c;
            const float cur = bf2f(praw[(tok + 1) * 1024 + col]), prev = bf2f(praw[tok * 1024 + col]);
            const float pa = cur + par[768 + c] * (prev - cur);
            const float o = c < 64 ? tanhf_(pa) : (c < 128 ? pa : sigmoidf_(pa));
            act[tok * 264 + c] = (bf16)f2bf(o); }
        __syncthreads();
        f32x4 aw[4], aa[4], ag[4];
#pragma unroll
        for (int ct = 0; ct < 4; ++ct) { aw[ct] = (f32x4){0.f, 0.f, 0.f, 0.f}; aa[ct] = aw[ct]; ag[ct] = aw[ct]; }
        const bf16* arow = act + (tt * 16 + r) * 264 + g * 8;
#pragma unroll
        for (int ks = 0; ks < 2; ++ks) { const bf16x8 A = *(const bf16x8*)(arow + ks * 32), A2 = *(const bf16x8*)(arow + 64 + ks * 32);
#pragma unroll
            for (int ct = 0; ct < 4; ++ct) { aw[ct] = mfma16(A, Bw[ks][ct], aw[ct]); aa[ct] = mfma16(A2, Ba[ks][ct], aa[ct]); } }
#pragma unroll
        for (int ks = 0; ks < 4; ++ks) { const bf16x8 A = *(const bf16x8*)(arow + 128 + ks * 32);
#pragma unroll
            for (int ct = 0; ct < 4; ++ct) ag[ct] = mfma16(A, Bg[ks][ct], ag[ct]); }
#pragma unroll 1
        for (int j = 0; j < 4; ++j) {
            const int tok = tt * 16 + 4 * g + j; const size_t token = row0 + tok;
            float kkv[4], k2v[4], rv[4], av[4], vv[4], dv[4]; float ss = 0.f;
#pragma unroll
            for (int ct = 0; ct < 4; ++ct) { const int c = h * 64 + ct * 16 + r;
                const bf16* pc = praw + (tok + 1) * 1024; const bf16* pp = praw + tok * 1024;
                float x0 = bf2f(pc[c]), x1 = bf2f(pc[256 + c]), x2 = bf2f(pc[512 + c]);
                x0 += par[c] * (bf2f(pp[c]) - x0); x1 += par[256 + c] * (bf2f(pp[256 + c]) - x1); x2 += par[512 + c] * (bf2f(pp[512 + c]) - x2);
                const float wl = par[1024 + c] + sel4(aw[ct], j);
                const float wlog = -__logf(1.f + __expf(-wl)) - 0.5f;
                dv[ct] = __expf(-__expf(wlog));
                av[ct] = sigmoidf_(par[1280 + c] + sel4(aa[ct], j));
                rv[ct] = x0; vv[ct] = x2;
                kkv[ct] = x1 * par[1536 + c]; ss += kkv[ct] * kkv[ct];
                k2v[ct] = x1 * (1.f + (av[ct] - 1.f) * par[1792 + c]); }
            ss = rowsum16(ss);
            const float inv = 1.f / fmaxf(sqrtf(ss), 1e-12f);
            float c1 = 0.f, c2 = 0.f, bn = 0.f;
#pragma unroll
            for (int ct = 0; ct < 4; ++ct) { const int c = h * 64 + ct * 16 + r; const size_t o = token * 256 + c;
                const float kkn = kkv[ct] * inv, ka = kkn * av[ct];
                c1 += ka * rv[ct]; c2 += k2v[ct] * rv[ct]; bn += rv[ct] * k2v[ct] * par[2048 + c];
                S16[o] = (h16)(-kkn); S16[ARR + o] = (h16)(dv[ct] * rv[ct]); S16[2 * ARR + o] = (h16)ka; S16[3 * ARR + o] = (h16)k2v[ct]; S16[4 * ARR + o] = (h16)vv[ct];
                SW[o] = dv[ct]; G[o] = (bf16)f2bf(sel4(ag[ct], j)); }
            c1 = rowsum16(c1); c2 = rowsum16(c2); bn = rowsum16(bn);
            if (r == 0) { float* sp = SCAL + (token * 4 + h) * 4; sp[0] = c1; sp[1] = c2; sp[2] = bn; sp[3] = 0.f; }
            asm volatile("" ::: "memory");
        }
        __syncthreads();
    }
}

__device__ __forceinline__ void st8(float* d, h16x8 v) {
    *(f32x4*)d = (f32x4){(float)v[0], (float)v[1], (float)v[2], (float)v[3]}; *(f32x4*)(d + 4) = (f32x4){(float)v[4], (float)v[5], (float)v[6], (float)v[7]}; }
constexpr int SC_REC = 384, SC_CH = 32, SC_NCH = T / SC_CH;
__device__ __forceinline__ void scan_load(const h16* S16, const float* SW, const float* SCAL, size_t tok0, int h, int rg, float* dst, int ltid) {
    constexpr size_t ARR = (size_t)M * 256;
    { const int s = ltid >> 3, q = ltid & 7; const h16* p = S16 + (tok0 + s) * 256 + h * 64 + q * 8; float* rec = dst + s * SC_REC + q * 8;
      const h16x8 v0 = *(const h16x8*)p, v1 = *(const h16x8*)(p + ARR), v2 = *(const h16x8*)(p + 2 * ARR), v3 = *(const h16x8*)(p + 3 * ARR);
      st8(rec, v0); st8(rec + 64, v1); st8(rec + 192, v2); st8(rec + 256, v3); }
#pragma unroll
    for (int i = 0; i < 2; ++i) { const int id = ltid + 256 * i, s = id >> 4, q = id & 15;
        *(f32x4*)(dst + s * SC_REC + 128 + q * 4) = *(const f32x4*)(SW + (tok0 + s) * 256 + h * 64 + q * 4); }
    if (ltid < 64) { const int s = ltid >> 1, q = ltid & 1; st8(dst + s * SC_REC + 320 + q * 8, *(const h16x8*)(S16 + 4 * ARR + (tok0 + s) * 256 + h * 64 + rg * 16 + q * 8)); }
    else if (ltid < 128) { const int s = (ltid - 64) >> 1, wh = ltid & 1; dst[s * SC_REC + 336 + wh] = SCAL[((tok0 + s) * 4 + h) * 4 + wh]; }
}
struct ScanOps { f32x4 nkk, wr, w, ka, k2; f32x2 c; float vi; };
__device__ __forceinline__ void scan_ld(ScanOps& o, const float* rec, int jq, int rowl) {
    o.nkk = *(const f32x4*)(rec + 4 * jq); o.wr = *(const f32x4*)(rec + 64 + 4 * jq); o.w = *(const f32x4*)(rec + 128 + 4 * jq);
    o.ka = *(const f32x4*)(rec + 192 + 4 * jq); o.k2 = *(const f32x4*)(rec + 256 + 4 * jq); o.vi = rec[320 + rowl]; o.c = *(const f32x2*)(rec + 336);
}
__device__ __forceinline__ void scan_step(f32x4& S, float& yk, const ScanOps& o, int jq, int sidx) {
    float sa = (S[0] * o.nkk[0] + S[1] * o.nkk[1]) + (S[2] * o.nkk[2] + S[3] * o.nkk[3]);
    float ys = (S[0] * o.wr[0] + S[1] * o.wr[1]) + (S[2] * o.wr[2] + S[3] * o.wr[3]);
    sa = rowsum16(sa); ys = rowsum16(ys);
    const float y = ys + sa * o.c[0] + o.vi * o.c[1];
    yk = (jq == (sidx & 15)) ? y : yk;
    S = S * o.w + o.ka * sa + o.k2 * o.vi;
}
__device__ __forceinline__ void phase_scan(const Args& a, unsigned char* lds, int tid, int wave, int lane) {
    const h16* S16 = (const h16*)(a.ws + WS_S16); const float* SW = (const float*)(a.ws + WS_SW); const float* SCAL = (const float*)(a.ws + WS_SCAL); float* YR = (float*)(a.ws + WS_YR);
    float* buf = (float*)lds;
    for (int it = blockIdx.x; it < 256; it += gridDim.x) {
        asm volatile("" : "+v"(tid), "+v"(lane));
        const int bh = it >> 2, rg = it & 3, b = bh >> 2, h = bh & 3;
        const size_t tokb = (size_t)b * T;
        if (wave >= 4) scan_load(S16, SW, SCAL, tokb, h, rg, buf, tid - 256);
        __syncthreads();
        const int rowl = (wave & 3) * 4 + (lane >> 4), jq = lane & 15;
        f32x4 S = {0.f, 0.f, 0.f, 0.f}; float yk = 0.f;
        float* yout = YR + (tokb + jq) * 256 + h * 64 + rg * 16 + rowl;
        for (int ch = 0; ch < SC_NCH; ++ch) {
            if (wave >= 4) { if (ch + 1 < SC_NCH) scan_load(S16, SW, SCAL, tokb + (size_t)(ch + 1) * SC_CH, h, rg, buf + ((ch + 1) & 1) * SC_CH * SC_REC, tid - 256); }
            else {
                const float* src = buf + (ch & 1) * SC_CH * SC_REC;
                ScanOps A, B;
                scan_ld(A, src, jq, rowl);
#pragma unroll
                for (int s = 0; s < SC_CH; s += 2) {
                    scan_ld(B, src + (s + 1) * SC_REC, jq, rowl);
                    scan_step(S, yk, A, jq, s);
                    if (s + 2 < SC_CH) scan_ld(A, src + (s + 2) * SC_REC, jq, rowl);
                    scan_step(S, yk, B, jq, s + 1);
                    if ((s & 15) == 14) yout[(size_t)(ch * SC_CH + (s & 16)) * 256] = yk;
                }
            }
            __syncthreads();
        }
    }
}

constexpr int AT_KP = 72;
__device__ __forceinline__ void attn_issue(const bf16* P, const bf16* VT, size_t rowk0, size_t vtb, int h, int tid, u32x4 (&kr)[2], u32x4 (&vr)[2]) {
#pragma unroll
    for (int i = 0; i < 2; ++i) {
        kr[i] = *(const u32x4*)(P + (rowk0 + ((tid >> 3) & 63)) * NIN + 1536 + (h * 2 + i) * 64 + (tid & 7) * 8);
        vr[i] = *(const u32x4*)(VT + vtb + (size_t)((tid >> 3) + 64 * i) * T + (tid & 7) * 8); }
}
__device__ __forceinline__ void attn_store(bf16* Kl, int tid, const u32x4 (&kr)[2], const u32x4 (&vr)[2]) {
#pragma unroll
    for (int i = 0; i < 2; ++i) {
        *(u32x4*)(Kl + i * 64 * AT_KP + ((tid >> 3) & 63) * AT_KP + (tid & 7) * 8) = kr[i];
        *(u32x4*)(Kl + 2 * 64 * AT_KP + ((tid >> 3) + 64 * i) * AT_KP + (tid & 7) * 8) = vr[i]; }
}
constexpr int AT_BUF = (2 * 64 + 128) * AT_KP;
__device__ __forceinline__ void attn_tile(const bf16* Lb, int kt, bool diag, int r, int g, int tq, float slope2, float bsh, const bf16x8* qb, f32x4 (&O)[2][8], float (&lsum)[2]) {
    const bf16* K0 = Lb; const bf16* K1 = Lb + 64 * AT_KP; const bf16* Vt = Lb + 2 * 64 * AT_KP;
    bf16x8 kf0[4][2], kf1[4][2];
#pragma unroll
    for (int k4 = 0; k4 < 4; ++k4)
#pragma unroll
        for (int ks = 0; ks < 2; ++ks) { kf0[k4][ks] = *(const bf16x8*)(K0 + (k4 * 16 + r) * AT_KP + ks * 32 + g * 8); kf1[k4][ks] = *(const bf16x8*)(K1 + (k4 * 16 + r) * AT_KP + ks * 32 + g * 8); }
    bf16x8 qf[2][2];
#pragma unroll
    for (int c = 0; c < 2; ++c)
#pragma unroll
        for (int ks = 0; ks < 2; ++ks) qf[c][ks] = qb[(c * 2 + ks) * 64];
    f32x4 init[4];
    if (diag) {
#pragma unroll
        for (int k4 = 0; k4 < 4; ++k4)
#pragma unroll
            for (int j = 0; j < 4; ++j) init[k4][j] = -slope2 * fabsf((float)(tq - (kt * 64 + k4 * 16 + 4 * g + j))) - bsh;
    } else {
        const float base = slope2 * (float)(kt * 64 + 4 * g - tq) - bsh;
#pragma unroll
        for (int k4 = 0; k4 < 4; ++k4)
#pragma unroll
            for (int j = 0; j < 4; ++j) init[k4][j] = fmaf(slope2, (float)(k4 * 16 + j), base);
    }
    __builtin_amdgcn_sched_barrier(0);
    f32x4 s0[4], s1[4];
#pragma unroll
    for (int k4 = 0; k4 < 4; ++k4) { s0[k4] = mfma16(kf0[k4][0], qf[0][0], init[k4]); s1[k4] = mfma16(kf1[k4][0], qf[1][0], init[k4]); }
#pragma unroll
    for (int k4 = 0; k4 < 4; ++k4) { s0[k4] = mfma16(kf0[k4][1], qf[0][1], s0[k4]); s1[k4] = mfma16(kf1[k4][1], qf[1][1], s1[k4]); }
    bf16x8 vf0[8], vf1[8];
#pragma unroll
    for (int nt = 0; nt < 8; ++nt) { vf0[nt] = *(const bf16x8*)(Vt + (nt * 16 + r) * AT_KP + g * 8); vf1[nt] = *(const bf16x8*)(Vt + (nt * 16 + r) * AT_KP + 32 + g * 8); }
    __builtin_amdgcn_sched_barrier(0);
    float p0 = 0.f, p1 = 0.f;
#pragma unroll
    for (int k4 = 0; k4 < 4; ++k4)
#pragma unroll
        for (int j = 0; j < 4; ++j) { s0[k4][j] = __builtin_amdgcn_exp2f(s0[k4][j]); p0 += s0[k4][j]; s1[k4][j] = __builtin_amdgcn_exp2f(s1[k4][j]); p1 += s1[k4][j]; }
    lsum[0] += p0; lsum[1] += p1;
    u32x4 a0, a1, b0, b1;
    a0.x = pg8::cvt_pk_bf16(s0[0][0], s0[0][1]); a0.y = pg8::cvt_pk_bf16(s0[0][2], s0[0][3]); a0.z = pg8::cvt_pk_bf16(s0[1][0], s0[1][1]); a0.w = pg8::cvt_pk_bf16(s0[1][2], s0[1][3]);
    a1.x = pg8::cvt_pk_bf16(s0[2][0], s0[2][1]); a1.y = pg8::cvt_pk_bf16(s0[2][2], s0[2][3]); a1.z = pg8::cvt_pk_bf16(s0[3][0], s0[3][1]); a1.w = pg8::cvt_pk_bf16(s0[3][2], s0[3][3]);
    b0.x = pg8::cvt_pk_bf16(s1[0][0], s1[0][1]); b0.y = pg8::cvt_pk_bf16(s1[0][2], s1[0][3]); b0.z = pg8::cvt_pk_bf16(s1[1][0], s1[1][1]); b0.w = pg8::cvt_pk_bf16(s1[1][2], s1[1][3]);
    b1.x = pg8::cvt_pk_bf16(s1[2][0], s1[2][1]); b1.y = pg8::cvt_pk_bf16(s1[2][2], s1[2][3]); b1.z = pg8::cvt_pk_bf16(s1[3][0], s1[3][1]); b1.w = pg8::cvt_pk_bf16(s1[3][2], s1[3][3]);
    const bf16x8 A0 = __builtin_bit_cast(bf16x8, a0), A1 = __builtin_bit_cast(bf16x8, a1), B0 = __builtin_bit_cast(bf16x8, b0), B1 = __builtin_bit_cast(bf16x8, b1);
#pragma unroll
    for (int nt = 0; nt < 8; ++nt) { O[0][nt] = mfma16(vf0[nt], A0, O[0][nt]); O[1][nt] = mfma16(vf0[nt], B0, O[1][nt]); }
#pragma unroll
    for (int nt = 0; nt < 8; ++nt) { O[0][nt] = mfma16(vf1[nt], A1, O[0][nt]); O[1][nt] = mfma16(vf1[nt], B1, O[1][nt]); }
}
__device__ __forceinline__ void attn_unit(const Args& a, int l, float lam, float one_m_li, float bsh, int b, int h, int p, unsigned char* lds, int tid, int wave, int lane) {
    asm volatile("" : "+v"(tid), "+v"(lane));
    const bf16* P = (const bf16*)(a.ws + WS_P); const bf16* VT = (const bf16*)(a.ws + WS_VT); bf16* Y = (bf16*)(a.ws + WS_Y);
    bf16* L0 = (bf16*)lds;
    const int r = lane & 15, g = lane >> 4;
    const int qc = 2 * p + (wave >> 2), nt_all = 2 * p + 2;
    const int tq = 128 * p + 16 * wave + r; const size_t rowb = (size_t)b * T; const size_t vtb = ((size_t)b * 4 + h) * 128 * T;
    const float slope2 = exp2f(-2.f * (float)(h + 1)) * 1.4426950408889634f;
    bf16x8* qb = (bf16x8*)(lds + 2 * AT_BUF * 2) + wave * 256 + lane;
#pragma unroll
    for (int c = 0; c < 2; ++c)
#pragma unroll
        for (int ks = 0; ks < 2; ++ks) qb[(c * 2 + ks) * 64] = *(const bf16x8*)(P + (rowb + tq) * NIN + 1024 + (h * 2 + c) * 64 + ks * 32 + g * 8);
    float lsum[2] = {0.f, 0.f};
    f32x4 O[2][8];
#pragma unroll
    for (int nt = 0; nt < 8; ++nt) { O[0][nt] = (f32x4){0.f, 0.f, 0.f, 0.f}; O[1][nt] = O[0][nt]; }
    u32x4 kr[2], vr[2];
    attn_issue(P, VT, rowb, vtb, h, tid, kr, vr);
    attn_store(L0, tid, kr, vr);
    attn_issue(P, VT, rowb + 64, vtb + 64, h, tid, kr, vr);
    __syncthreads();
    for (int kt = 0; kt < nt_all; ++kt) {
        if (kt + 1 < nt_all) { attn_store(L0 + ((kt + 1) & 1) * AT_BUF, tid, kr, vr);
            if (kt + 2 < nt_all) attn_issue(P, VT, rowb + (size_t)(kt + 2) * 64, vtb + (size_t)(kt + 2) * 64, h, tid, kr, vr); }
        if (kt <= qc) attn_tile(L0 + (kt & 1) * AT_BUF, kt, kt == qc, r, g, tq, slope2, bsh, qb, O, lsum);
        __syncthreads();
    }
    float l0 = lsum[0], l1 = lsum[1];
    l0 += shx(l0, 16); l0 += shx(l0, 32); l1 += shx(l1, 16); l1 += shx(l1, 32);
    const float i0 = 1.f / l0, i1 = lam / l1;
    float ss = 0.f;
#pragma unroll
    for (int nt = 0; nt < 8; ++nt)
#pragma unroll
        for (int j = 0; j < 4; ++j) { const float o = O[0][nt][j] * i0 - O[1][nt][j] * i1; O[0][nt][j] = o; ss += o * o; }
    ss += shx(ss, 16); ss += shx(ss, 32);
    const float sc = rsqrtf(ss * (1.f / 128.f) + 1e-6f) * one_m_li;
    const float* sg = inp(a, 23) + l * 128;
    bf16* yp = Y + (rowb + tq) * 1024 + 256 + h * 128;
#pragma unroll
    for (int nt = 0; nt < 8; ++nt) { const int v0 = nt * 16 + 4 * g; const f32x4 gg = *(const f32x4*)(sg + v0);
        u32x2 w; w.x = pk2(O[0][nt][0] * sc * gg[0], O[0][nt][1] * sc * gg[1]); w.y = pk2(O[0][nt][2] * sc * gg[2], O[0][nt][3] * sc * gg[3]);
        *(u32x2*)(yp + v0) = w; }
}
constexpr int SA_CH = 16, SA_NCH = T / SA_CH, SA_TICKS = 132;
constexpr int SA_SCB = 0, SA_KV = 2 * SA_CH * SC_REC * 4, SA_STAGE = 32768, SA_QB = SA_KV + 2 * SA_STAGE;
static_assert(SA_QB + 4 * 4096 <= LDS_CTL, "LDS map of the fused scan/attention phase");
#define SA_BAR() do { asm volatile("s_waitcnt vmcnt(0) lgkmcnt(0)" ::: "memory"); __builtin_amdgcn_s_barrier(); asm volatile("" ::: "memory"); } while (0)
#define SA_BAR_L() do { asm volatile("s_waitcnt lgkmcnt(0)" ::: "memory"); __builtin_amdgcn_s_barrier(); asm volatile("" ::: "memory"); } while (0)
__device__ __forceinline__ void role_bar(volatile LAS unsigned* cnt, unsigned& target, int lane, bool drain_vm) {
    if (drain_vm) asm volatile("s_waitcnt vmcnt(0) lgkmcnt(0)" ::: "memory"); else asm volatile("s_waitcnt lgkmcnt(0)" ::: "memory");
    target += 4u;
    if (lane == 0) __hip_atomic_fetch_add((LAS unsigned*)cnt, 1u, __ATOMIC_RELAXED, __HIP_MEMORY_SCOPE_WORKGROUP);
    unsigned spins = 0u;
    for (;;) { const unsigned v = (unsigned)__builtin_amdgcn_readfirstlane((int)*cnt); if (v >= target || ++spins > (1u << 18)) break; __builtin_amdgcn_s_sleep(1); }
    asm volatile("s_waitcnt lgkmcnt(0)" ::: "memory");
}
struct ScanPre { h16x8 a0, a1, v; f32x4 w; float sc; };
__device__ __forceinline__ void scanpre_issue(ScanPre& p, const h16* S16, const float* SW, const float* SCAL, size_t tok0, int h, int rg, int stid) {
    constexpr size_t ARR = (size_t)M * 256;
    const int ps = stid >> 7, sq = stid & 127, s = sq >> 3, q = sq & 7;
    const h16* bp = S16 + (size_t)(2 * ps) * ARR + (tok0 + s) * 256 + h * 64 + q * 8;
    p.a0 = *(const h16x8*)bp; p.a1 = *(const h16x8*)(bp + ARR);
    p.w = *(const f32x4*)(SW + (tok0 + (stid >> 4)) * 256 + h * 64 + (stid & 15) * 4);
    if (stid < 32) p.v = *(const h16x8*)(S16 + 4 * ARR + (tok0 + (stid >> 1)) * 256 + h * 64 + rg * 16 + (stid & 1) * 8);
    else if (stid < 64) p.sc = SCAL[((tok0 + ((stid - 32) >> 1)) * 4 + h) * 4 + (stid & 1)];
}
__device__ __forceinline__ void scanpre_store(const ScanPre& p, float* dst, int stid) {
    const int ps = stid >> 7, sq = stid & 127, s = sq >> 3, q = sq & 7;
    float* rec = dst + s * SC_REC + q * 8 + (ps ? 192 : 0);
    st8(rec, p.a0); st8(rec + 64, p.a1);
    *(f32x4*)(dst + (stid >> 4) * SC_REC + 128 + (stid & 15) * 4) = p.w;
    if (stid < 32) st8(dst + (stid >> 1) * SC_REC + 320 + (stid & 1) * 8, p.v);
    else if (stid < 64) dst[((stid - 32) >> 1) * SC_REC + 336 + (stid & 1)] = p.sc;
}
__device__ __forceinline__ void attn_dma(const bf16* P, const bf16* VT, size_t rowk, size_t vtk, int h, int aw, int lane, LAS unsigned char* stage) {
    const int q = (lane & 7) ^ ((lane >> 3) & 7);
    const char* ub; unsigned voff, kstride;
    if (aw < 2) { ub = (const char*)(P + rowk * NIN + 1536 + (h * 2 + aw) * 64); voff = (unsigned)(((lane >> 3) * NIN + q * 8) * 2); kstride = 8u * NIN * 2u; }
    else { ub = (const char*)(VT + vtk + (size_t)(aw - 2) * 64 * T); voff = (unsigned)(((lane >> 3) * T + q * 8) * 2); kstride = 8u * T * 2u; }
#pragma unroll
    for (int k = 0; k < 8; ++k)
        __builtin_amdgcn_global_load_lds((const unsigned*)(ub + (size_t)k * kstride + voff), (LAS unsigned*)(stage + aw * 8192 + k * 1024), 16, 0, 0);
}
__device__ __forceinline__ void attn_tile_sw(const unsigned char* Lb, int kt, bool diag, int r, int g, int tq, float slope2, float bsh, const bf16x8* qb, f32x4 (&O)[2][8], float (&lsum)[2]) {
    const int r7 = r & 7;
    bf16x8 kf0[4][2], kf1[4][2];
#pragma unroll
    for (int k4 = 0; k4 < 4; ++k4)
#pragma unroll
        for (int ks = 0; ks < 2; ++ks) { const int off = ((k4 * 16 + r) * 8 + ((ks * 4 + g) ^ r7)) * 16; kf0[k4][ks] = *(const bf16x8*)(Lb + off); kf1[k4][ks] = *(const bf16x8*)(Lb + 8192 + off); }
    bf16x8 qf[2][2];
#pragma unroll
    for (int c = 0; c < 2; ++c)
#pragma unroll
        for (int ks = 0; ks < 2; ++ks) if (c * 2 + ks < 3) qf[c][ks] = qb[(c * 2 + ks) * 64];
    f32x4 init[4];
    if (diag) {
#pragma unroll
        for (int k4 = 0; k4 < 4; ++k4)
#pragma unroll
            for (int j = 0; j < 4; ++j) init[k4][j] = -slope2 * fabsf((float)(tq - (kt * 64 + k4 * 16 + 4 * g + j))) - bsh;
    } else {
        const float base = slope2 * (float)(kt * 64 + 4 * g - tq) - bsh;
#pragma unroll
        for (int k4 = 0; k4 < 4; ++k4)
#pragma unroll
            for (int j = 0; j < 4; ++j) init[k4][j] = fmaf(slope2, (float)(k4 * 16 + j), base);
    }
    __builtin_amdgcn_sched_barrier(0);
    f32x4 s0[4], s1[4];
#pragma unroll
    for (int k4 = 0; k4 < 4; ++k4) { s0[k4] = mfma16(kf0[k4][0], qf[0][0], init[k4]); s1[k4] = mfma16(kf1[k4][0], qf[1][0], init[k4]); s0[k4] = mfma16(kf0[k4][1], qf[0][1], s0[k4]); }
    __builtin_amdgcn_sched_barrier(0);
    bf16x8 vf0[8], vf1[8];
#pragma unroll
    for (int nt = 0; nt < 8; ++nt) vf0[nt] = *(const bf16x8*)(Lb + 16384 + (nt * 16 + r) * 128 + ((g ^ r7) * 16));
    __builtin_amdgcn_sched_barrier(0);
    qf[1][1] = qb[3 * 64];
    float p0 = 0.f, p1 = 0.f;
    unsigned pa[8], pbk[8];
#pragma unroll
    for (int k4 = 0; k4 < 4; ++k4) {
        s1[k4] = mfma16(kf1[k4][1], qf[1][1], s1[k4]);
#pragma unroll
        for (int j = 0; j < 4; ++j) { s0[k4][j] = __builtin_amdgcn_exp2f(s0[k4][j]); p0 += s0[k4][j]; }
        pa[2 * k4] = pg8::cvt_pk_bf16(s0[k4][0], s0[k4][1]); pa[2 * k4 + 1] = pg8::cvt_pk_bf16(s0[k4][2], s0[k4][3]);
        __builtin_amdgcn_sched_barrier(0);
    }
    const bf16x8 A0 = __builtin_bit_cast(bf16x8, (u32x4){pa[0], pa[1], pa[2], pa[3]}), A1 = __builtin_bit_cast(bf16x8, (u32x4){pa[4], pa[5], pa[6], pa[7]});
#pragma unroll
    for (int nt = 0; nt < 8; ++nt) vf1[nt] = *(const bf16x8*)(Lb + 16384 + (nt * 16 + r) * 128 + (((4 + g) ^ r7) * 16));
    __builtin_amdgcn_sched_barrier(0);
#pragma unroll
    for (int k4 = 0; k4 < 4; ++k4) {
#pragma unroll
        for (int q = 0; q < 4; ++q) { const int nt = (4 * k4 + q) & 7; if (k4 < 2) O[0][nt] = mfma16(vf0[nt], A0, O[0][nt]); else O[0][nt] = mfma16(vf1[nt], A1, O[0][nt]); }
#pragma unroll
        for (int j = 0; j < 4; ++j) { s1[k4][j] = __builtin_amdgcn_exp2f(s1[k4][j]); p1 += s1[k4][j]; }
        pbk[2 * k4] = pg8::cvt_pk_bf16(s1[k4][0], s1[k4][1]); pbk[2 * k4 + 1] = pg8::cvt_pk_bf16(s1[k4][2], s1[k4][3]);
        __builtin_amdgcn_sched_barrier(0);
    }
    lsum[0] += p0; lsum[1] += p1;
    const bf16x8 B0 = __builtin_bit_cast(bf16x8, (u32x4){pbk[0], pbk[1], pbk[2], pbk[3]}), B1 = __builtin_bit_cast(bf16x8, (u32x4){pbk[4], pbk[5], pbk[6], pbk[7]});
#pragma unroll
    for (int nt = 0; nt < 8; ++nt) { O[1][nt] = mfma16(vf0[nt], B0, O[1][nt]); O[1][nt] = mfma16(vf1[nt], B1, O[1][nt]); }
}
__device__ __forceinline__ void phase_scan_attn(const Args& a, int l, unsigned char* lds, int tid, int wave, int lane) {
    for (int w0 = blockIdx.x; w0 < 256; w0 += gridDim.x) {
        asm volatile("" : "+v"(tid), "+v"(lane));
        const int w = (gridDim.x == 256) ? ((w0 & 7) * 32 + (w0 >> 3)) : w0;
        const int bh = w >> 2, sub = w & 3, b = bh >> 2, h = bh & 3;
        const size_t tokb = (size_t)b * T;
        volatile LAS unsigned* rcnt = (volatile LAS unsigned*)((LAS unsigned char*)lds + LDS_CTL - 64);
        if (tid < 8) rcnt[tid] = 0u;
        __syncthreads();
        unsigned rtarget = 0u;
        if (wave < 4) {
            const h16* S16 = (const h16*)(a.ws + WS_S16); const float* SW = (const float*)(a.ws + WS_SW); const float* SCAL = (const float*)(a.ws + WS_SCAL); float* YR = (float*)(a.ws + WS_YR);
            float* scb = (float*)(lds + SA_SCB);
            const int rg = sub, rowl = wave * 4 + (lane >> 4), jq = lane & 15;
            ScanPre pre; pre.a0 = (h16x8)(h16)0.f; pre.a1 = pre.a0; pre.v = pre.a0; pre.w = (f32x4){0.f, 0.f, 0.f, 0.f}; pre.sc = 0.f;
            scanpre_issue(pre, S16, SW, SCAL, tokb, h, rg, tid); scanpre_store(pre, scb, tid);
            role_bar(rcnt, rtarget, lane, false);
            f32x4 S = {0.f, 0.f, 0.f, 0.f}; float yk = 0.f;
            float* yout = YR + (tokb + jq) * 256 + h * 64 + rg * 16 + rowl;
#pragma unroll 1
            for (int i = 0; i < SA_TICKS; ++i) {
                if (i < SA_NCH) {
                    if (i + 1 < SA_NCH) scanpre_issue(pre, S16, SW, SCAL, tokb + (size_t)(i + 1) * SA_CH, h, rg, tid);
                    const float* src = scb + (i & 1) * SA_CH * SC_REC;
                    ScanOps A, B;
                    scan_ld(A, src, jq, rowl);
#pragma unroll
                    for (int s_ = 0; s_ < SA_CH; s_ += 2) {
                        scan_ld(B, src + (s_ + 1) * SC_REC, jq, rowl);
                        scan_step(S, yk, A, jq, s_);
                        if (s_ + 2 < SA_CH) scan_ld(A, src + (s_ + 2) * SC_REC, jq, rowl);
                        scan_step(S, yk, B, jq, s_ + 1);
                    }
                    yout[(size_t)(i * SA_CH) * 256] = yk;
                    if (i + 1 < SA_NCH) scanpre_store(pre, scb + ((i + 1) & 1) * SA_CH * SC_REC, tid);
                }
                role_bar(rcnt, rtarget, lane, false);
            }
        } else {
            const bf16* P = (const bf16*)(a.ws + WS_P); const bf16* VT = (const bf16*)(a.ws + WS_VT); bf16* Y = (bf16*)(a.ws + WS_Y);
            float s1 = 0.f, s2 = 0.f, mq = 0.f, mk = 0.f;
            for (int i = 0; i < 64; ++i) { s1 += inp(a, 19)[l * 64 + i] * inp(a, 20)[l * 64 + i]; s2 += inp(a, 21)[l * 64 + i] * inp(a, 22)[l * 64 + i];
                mq = fmaxf(mq, fabsf(inp(a, 17)[l * 64 + i])); mk = fmaxf(mk, fabsf(inp(a, 18)[l * 64 + i])); }
            const float li = __builtin_bit_cast(float, __builtin_amdgcn_readfirstlane(l == 0 ? 0x3e4ccccd : 0x3eb60549));
            const float lam = __builtin_bit_cast(float, __builtin_amdgcn_readfirstlane(__builtin_bit_cast(int, expf(s1) - expf(s2) + li))), one_m_li = 1.f - li;
            const float bsh = __builtin_bit_cast(float, __builtin_amdgcn_readfirstlane(__builtin_bit_cast(int, 8.f * mq * mk * 1.4426950408889634f)));
            const int aw = wave - 4, r = lane & 15, g = lane >> 4;
            const size_t vtb = ((size_t)b * 4 + h) * 128 * T;
            const float slope2 = exp2f(-2.f * (float)(h + 1)) * 1.4426950408889634f;
            LAS unsigned char* kv = (LAS unsigned char*)lds + SA_KV;
            bf16x8* qb = (bf16x8*)(lds + SA_QB) + aw * 256 + lane;
            const float* sg = inp(a, 23) + l * 128;
            attn_dma(P, VT, tokb, vtb, h, aw, lane, kv);
            role_bar(rcnt + 4, rtarget, lane, true);
            int ti = 0;
#pragma unroll 1
            for (int u = 0; u < 8; ++u) {
                const int pq = sub * 4 + (u >> 1), qc = (u & 1) ? 31 - pq : pq;
                const int pqn = sub * 4 + ((u + 1) >> 1);
                const int tq = qc * 64 + aw * 16 + r;
#pragma unroll
                for (int c = 0; c < 2; ++c)
#pragma unroll
                    for (int ks = 0; ks < 2; ++ks) qb[(c * 2 + ks) * 64] = *(const bf16x8*)(P + (tokb + tq) * NIN + 1024 + (h * 2 + c) * 64 + ks * 32 + g * 8);
                float lsum[2] = {0.f, 0.f};
                f32x4 O[2][8];
#pragma unroll
                for (int nt = 0; nt < 8; ++nt) { O[0][nt] = (f32x4){0.f, 0.f, 0.f, 0.f}; O[1][nt] = O[0][nt]; }
#pragma unroll 1
                for (int kt = 0; kt <= qc; ++kt) {
                    const int ktn = kt < qc ? kt + 1 : 0;
                    if (kt < qc || u < 7) attn_dma(P, VT, tokb + (size_t)ktn * 64, vtb + (size_t)ktn * 64, h, aw, lane, kv + ((ti + 1) & 1) * SA_STAGE);
                    attn_tile_sw((const unsigned char*)lds + SA_KV + (ti & 1) * SA_STAGE, kt, kt == qc, r, g, tq, slope2, bsh, qb, O, lsum);
                    if (kt == qc) {
                        float l0 = lsum[0], l1 = lsum[1];
                        l0 += shx(l0, 16); l0 += shx(l0, 32); l1 += shx(l1, 16); l1 += shx(l1, 32);
                        const float i0 = 1.f / l0, i1 = lam / l1;
                        float ss = 0.f;
#pragma unroll
                        for (int nt = 0; nt < 8; ++nt)
#pragma unroll
                            for (int j = 0; j < 4; ++j) { const float o = O[0][nt][j] * i0 - O[1][nt][j] * i1; O[0][nt][j] = o; ss += o * o; }
                        ss += shx(ss, 16); ss += shx(ss, 32);
                        const float sc = rsqrtf(ss * (1.f / 128.f) + 1e-6f) * one_m_li;
                        bf16* yp = Y + (tokb + tq) * 1024 + 256 + h * 128;
#pragma unroll
                        for (int nt = 0; nt < 8; ++nt) { const int v0 = nt * 16 + 4 * g; const f32x4 gg = *(const f32x4*)(sg + v0);
                            u32x2 wv; wv.x = pk2(O[0][nt][0] * sc * gg[0], O[0][nt][1] * sc * gg[1]); wv.y = pk2(O[0][nt][2] * sc * gg[2], O[0][nt][3] * sc * gg[3]);
                            *(u32x2*)(yp + v0) = wv; }
                    }
                    role_bar(rcnt + 4, rtarget, lane, true); ++ti;
                }
                (void)pqn;
            }
        }
        __syncthreads();
    }
}
__device__ __forceinline__ void conv_unit(const Args& a, int l, int b, int t0, unsigned char* lds, int tid, int wave, int lane) {
    const bf16* P = (const bf16*)(a.ws + WS_P); bf16* Y = (bf16*)(a.ws + WS_Y);
    constexpr int HP = 264, OP = 260;
    bf16* hb = (bf16*)lds;
    float* ob = (float*)(lds + 94 * HP * 2);
    asm volatile("" : "+v"(tid), "+v"(lane));
    const size_t rowb = (size_t)b * T;
    for (int ch = tid; ch < 94 * 32; ch += 512) { const int rr = ch >> 5, cc = ch & 31; const int t = t0 - 30 + rr;
        u32x4 v = {0u, 0u, 0u, 0u};
        if (t >= 0) v = *(const u32x4*)(P + (rowb + t) * NIN + 2560 + cc * 8);
        *(u32x4*)(hb + rr * HP + cc * 8) = v; }
    __syncthreads();
    const int cp = tid & 127, tg = tid >> 7;
    const float* cw = inp(a, 24) + (size_t)l * 31 * 256 + 2 * cp;
    const f32x2 cb = *(const f32x2*)(inp(a, 25) + l * 256 + 2 * cp);
    float acc0[16], acc1[16];
#pragma unroll
    for (int i = 0; i < 16; ++i) { acc0[i] = cb[0]; acc1[i] = cb[1]; }
    f32x2 wv[31];
#pragma unroll
    for (int w = 0; w < 31; ++w) wv[w] = *(const f32x2*)(cw + w * 256);
#pragma unroll
    for (int rho = 0; rho < 46; ++rho) { const unsigned hv = *(const unsigned*)(hb + (tg * 16 + rho) * HP + 2 * cp); const float h0 = bflo(hv), h1 = bfhi(hv);
#pragma unroll
        for (int i = 0; i < 16; ++i) { const int w = rho - i; if (w >= 0 && w < 31) { acc0[i] += h0 * wv[w][0]; acc1[i] += h1 * wv[w][1]; } } }
#pragma unroll
    for (int i = 0; i < 16; ++i) *(f32x2*)(ob + (tg * 16 + i) * OP + 2 * cp) = (f32x2){acc0[i], acc1[i]};
    __syncthreads();
    const f32x4 lw = *(const f32x4*)(inp(a, 26) + l * 256 + 4 * lane), lb = *(const f32x4*)(inp(a, 27) + l * 256 + 4 * lane);
    for (int i = 0; i < 8; ++i) { const int tok = wave * 8 + i;
        const f32x4 x = *(const f32x4*)(ob + tok * OP + 4 * lane);
        const float mu = wave_sum((x[0] + x[1]) + (x[2] + x[3])) * (1.f / 256.f);
        const f32x4 d = x - mu;
        const float var = wave_sum((d[0] * d[0] + d[1] * d[1]) + (d[2] * d[2] + d[3] * d[3])) * (1.f / 256.f);
        const f32x4 y = d * rsqrtf(var + 1e-5f) * lw + lb;
        u32x2 w; w.x = pk2(y[0] * sigmoidf_(y[0]), y[1] * sigmoidf_(y[1])); w.y = pk2(y[2] * sigmoidf_(y[2]), y[3] * sigmoidf_(y[3]));
        *(u32x2*)(Y + (rowb + t0 + tok) * 1024 + 768 + 4 * lane) = w; }
    __syncthreads();
}
__device__ __forceinline__ void phase_mix(const Args& a, int l, unsigned char* lds, int tid, int wave, int lane) {
    for (int u = blockIdx.x; u < 512; u += gridDim.x) conv_unit(a, l, u >> 5, (u & 31) * 64, lds, tid, wave, lane);
    const float* YR = (const float*)(a.ws + WS_YR); const h16* SV = (const h16*)(a.ws + WS_S16) + 4 * (size_t)M * 256; const bf16* G = (const bf16*)(a.ws + WS_G);
    const float* SCAL = (const float*)(a.ws + WS_SCAL); bf16* Y = (bf16*)(a.ws + WS_Y);
    const f32x4 lw = *(const f32x4*)(inp(a, 15) + l * 256 + 4 * lane), lb = *(const f32x4*)(inp(a, 16) + l * 256 + 4 * lane);
    const int gw = blockIdx.x * 8 + wave, NGW = gridDim.x * 8;
#pragma unroll 4
    for (int tok = gw; tok < M; tok += NGW) {
        const f32x4 y = *(const f32x4*)(YR + (size_t)tok * 256 + 4 * lane);
        const float mu = rowsum16((y[0] + y[1]) + (y[2] + y[3])) * (1.f / 64.f);
        const f32x4 d = y - mu;
        const float var = rowsum16((d[0] * d[0] + d[1] * d[1]) + (d[2] * d[2] + d[3] * d[3])) * (1.f / 64.f);
        const f32x4 yn = d * rsqrtf(var + 64e-5f) * lw + lb;
        const float bn = SCAL[((size_t)tok * 4 + (lane >> 4)) * 4 + 2];
        const h16x4 v = *(const h16x4*)(SV + (size_t)tok * 256 + 4 * lane);
        const u32x2 gv = *(const u32x2*)(G + (size_t)tok * 256 + 4 * lane);
        u32x2 w; w.x = pk2((yn[0] + bn * (float)v[0]) * bflo(gv.x), (yn[1] + bn * (float)v[1]) * bfhi(gv.x));
        w.y = pk2((yn[2] + bn * (float)v[2]) * bflo(gv.y), (yn[3] + bn * (float)v[3]) * bfhi(gv.y));
        *(u32x2*)(Y + (size_t)tok * 1024 + 4 * lane) = w;
    }
}

#define XB_TMO      128
#define XB_XCNT(j)  (256  + 64 * (j))
#define XB_XSUB(j)  (1280 + 64 * (j))
#define XB_XGEN(j)  (2304 + 64 * (j))
#define XB_TOP      3328
#define XB_TOPGEN   3392
#define XCD_BAR_WORDS 3456
#define XB_SPIN_CAP (1u << 18)

__device__ __forceinline__ unsigned xb_ld(unsigned* p)              { return __hip_atomic_load(p, __ATOMIC_RELAXED, __HIP_MEMORY_SCOPE_AGENT); }
__device__ __forceinline__ unsigned xb_add(unsigned* p, unsigned v) { return __hip_atomic_fetch_add(p, v, __ATOMIC_RELAXED, __HIP_MEMORY_SCOPE_AGENT); }
__device__ __forceinline__ unsigned xb_xcc_id() { return (unsigned)__builtin_amdgcn_s_getreg((3 << 11) | 20) & 0xFu; }
#define XB_SPIN(cond, bar) do { unsigned _sp = 0; while (cond) { __builtin_amdgcn_s_sleep(1); \
    if ((++_sp & 255u) == 0u) { if (xb_ld(&(bar)[XB_TMO])) break; if (_sp > XB_SPIN_CAP) { atomicAdd(&(bar)[XB_TMO], 1u); break; } } } } while (0)

struct XcdBarrier {
    unsigned* bar; unsigned x;
    volatile LAS unsigned* st;
};

__device__ __forceinline__ XcdBarrier xcd_barrier_post(unsigned* bar, volatile LAS unsigned* st) {
    XcdBarrier b; b.bar = bar; b.x = xb_xcc_id(); b.st = st;
    if (threadIdx.x == 0) (void)xb_add(&bar[XB_XCNT(b.x)], 1u);
    return b;
}
__device__ __forceinline__ void xcd_barrier_complete(unsigned* bar, unsigned x, unsigned& nloc, unsigned& nx) {
    const unsigned G = gridDim.x * gridDim.y * gridDim.z;
    unsigned sum, cnt, mine, sp = 0u;
    for (;;) {
        sum = 0u; cnt = 0u; mine = 0u;
#pragma unroll
        for (unsigned j = 0; j < 16; ++j) { const unsigned c = xb_ld(&bar[XB_XCNT(j)]); sum += c; cnt += (c > 0u) ? 1u : 0u; mine = (j == x) ? c : mine; }
        if (sum == G) break;
        __builtin_amdgcn_s_sleep(1);
        if ((++sp & 255u) == 0u) { if (xb_ld(&bar[XB_TMO])) break; if (sp > XB_SPIN_CAP) { atomicAdd(&bar[XB_TMO], 1u); break; } }
    }
    nloc = mine > 0u ? mine : 1u; nx = cnt > 0u ? cnt : 1u;
}

__device__ __forceinline__ void xcd_barrier(const XcdBarrier& b) {
    asm volatile("s_waitcnt vmcnt(0)" ::: "memory");
    __syncthreads();
    if (threadIdx.x == 0) {
        unsigned* bar = b.bar;
        __builtin_amdgcn_s_waitcnt(0);
        unsigned nloc = b.st[0], nx = b.st[1];
        if (nloc == 0u) { xcd_barrier_complete(bar, b.x, nloc, nx); b.st[0] = nloc; b.st[1] = nx; }
        const unsigned old = xb_add(&bar[XB_XSUB(b.x)], 1u);
        const unsigned gen = old / nloc;
        if (old + 1u == (gen + 1u) * nloc) {
            __builtin_amdgcn_fence(__ATOMIC_RELEASE, "agent");
            asm volatile("s_waitcnt vmcnt(0)" ::: "memory");
            const unsigned og = xb_add(&bar[XB_TOP], 1u);
            const unsigned tg = og / nx;
            if (og + 1u == (tg + 1u) * nx) xb_add(&bar[XB_TOPGEN], 1u);
            else XB_SPIN(xb_ld(&bar[XB_TOPGEN]) == tg, bar);
            __builtin_amdgcn_fence(__ATOMIC_ACQUIRE, "agent");
            xb_add(&bar[XB_XGEN(b.x)], 1u);
            asm volatile("s_waitcnt vmcnt(0)" ::: "memory");
        } else {
            XB_SPIN(xb_ld(&bar[XB_XGEN(b.x)]) == gen, bar);
            __builtin_amdgcn_fence(__ATOMIC_ACQUIRE, "agent");
            asm volatile("s_waitcnt vmcnt(0)" ::: "memory");
        }
    }
    __syncthreads();
}

__global__ void __launch_bounds__(512, 2) mk_fwd(Args a) {
    extern __shared__ __attribute__((aligned(16))) unsigned char lds[];
    cg::grid_group grid = cg::this_grid();
    const int wave_s = __builtin_amdgcn_readfirstlane((int)threadIdx.x >> 6);
#define TIDS int lane_ = __builtin_amdgcn_mbcnt_hi(~0u, __builtin_amdgcn_mbcnt_lo(~0u, 0u)); asm volatile("" : "+v"(lane_)); const int lane = lane_, wave = wave_s; int tid = wave * 64 + lane; (void)lane; (void)wave; (void)tid
    unsigned* barw = (unsigned*)(a.ws + WS_BAR);
    if (a.ph_lo == 0 && blockIdx.x == 0) for (int i = threadIdx.x; i < XCD_BAR_WORDS; i += 512) barw[i] = 0u;
    if (threadIdx.x < 2) ((volatile LAS unsigned*)(lds + LDS_CTL))[threadIdx.x] = 0u;
    __syncthreads();
    XcdBarrier xbar; xbar.bar = barw; xbar.x = 0; xbar.st = (volatile LAS unsigned*)(lds + LDS_CTL);
    bool posted = false;
#pragma unroll 1
    for (int ph = a.ph_lo; ph < a.ph_hi; ++ph) {
        if (ph == 0) { { TIDS; phase_weights(a, lds, wave, lane); } __syncthreads(); { TIDS; phase_ada(a, lds, tid, wave, lane); } }
        else {
            const int l = (ph - 1) / 9, k = (ph - 1) % 9;
            const float* modl = (const float*)(a.ws + WS_MOD) + (size_t)l * 16 * 6144;
            if (k == 6 || (k == 0 && l == 1)) continue;
            if (k == 1 || k == 5 || k == 7 || k == 8) {
                const unsigned char* wb = a.ws + WS_WB + (size_t)l * WB_LAYER;
                pg8::Gemm g; pg8::EpiDyn E; E.O = nullptr; E.ldc = 0; E.base = nullptr; E.out = nullptr; E.gate = nullptr;
                E.ssq_in = nullptr; E.bias = nullptr; E.bstride = 0; E.rtab = nullptr; E.XS = nullptr; E.ssq_out = nullptr; E.gn = nullptr; E.scv = nullptr;
                const float* BIAS = (const float*)(a.ws + WS_BIAS);
                if (k == 1) { g.A = (const bf16*)(a.ws + WS_XN); g.Bt = (const bf16*)(wb + WB_IN); g.N = NIN; g.K = D; E.kind = 0; E.O = (bf16*)(a.ws + WS_P); E.ldc = NIN;
                    if (l == 1) { E.ssq_in = (const float*)(a.ws + WS_SSQA); E.bias = BIAS; E.bstride = NIN; } }
                else if (k == 5) { g.A = (const bf16*)(a.ws + WS_Y); g.Bt = (const bf16*)(wb + WB_OUT); g.N = D; g.K = D; E.kind = 2; E.base = l == 0 ? inp(a, 0) : a.out; E.out = a.out; E.gate = modl + 2048;
                    E.XS = (bf16*)(a.ws + WS_XN); E.ssq_out = (float*)(a.ws + WS_SSQB); E.gn = inp(a, 29) + l * 1024; E.scv = modl + 4096; }
                else if (k == 7) { g.A = (const bf16*)(a.ws + WS_XN); g.Bt = (const bf16*)(wb + WB_W1); g.N = FF; g.K = D; E.kind = 1; E.O = (bf16*)(a.ws + WS_H); E.ldc = FF;
                    E.ssq_in = (const float*)(a.ws + WS_SSQB); E.bias = BIAS + 16 * NIN + (size_t)l * 16 * FF; E.bstride = FF; }
                else { g.A = (const bf16*)(a.ws + WS_H); g.Bt = (const bf16*)(wb + WB_W2); g.N = D; g.K = FF; E.kind = 2; E.base = a.out; E.out = a.out; E.gate = modl + 5120;
                    if (l == 0) { E.XS = (bf16*)(a.ws + WS_XN); E.ssq_out = (float*)(a.ws + WS_SSQA); E.gn = inp(a, 4) + 1024; E.scv = (const float*)(a.ws + WS_MOD) + (size_t)16 * 6144 + 1024; } }
                g.M = M;
                pg8::StaticOrder S; S.init(M, g.N, gridDim.x, blockIdx.x);
                E.rtab = (const LAS float*)((LAS unsigned char*)lds + 131072);
                if (E.ssq_in) { TIDS;
                    LAS float* rt = (LAS float*)((LAS unsigned char*)lds + 131072);
                    for (int idx = tid; idx < 8 * 256; idx += 512) { pg8::Unit u_; if (!S.next(idx >> 8, u_)) break;
                        const f32x4* sp = (const f32x4*)(E.ssq_in + (size_t)(u_.pm * 256 + (idx & 255)) * 16); const f32x4 t = (sp[0] + sp[1]) + (sp[2] + sp[3]);
                        rt[idx] = rsqrtf(((t[0] + t[1]) + (t[2] + t[3])) * (1.f / 1024.f) + 1e-6f); }
                    __syncthreads(); }
                { TIDS; pg8::gemm_phase<pg8::EpiDyn, pg8::StaticOrder, true, true>((LAS unsigned char*)lds, g, S, E, tid); }
            }
            else if (k == 0) { TIDS; phase_xn(inp(a, 0), inp(a, 4), modl, 0, 1024, (bf16*)(a.ws + WS_XN), wave, lane); phase_bias(a, wave, lane); }
            else if (k == 2) { TIDS; phase_premix(a, l, lds, tid, wave, lane); }
            else if (k == 3) { TIDS; phase_scan_attn(a, l, lds, tid, wave, lane); }
            else { TIDS; phase_mix(a, l, lds, tid, wave, lane); }
        }
        if (ph + 1 < a.ph_hi) {
            if (!posted) { grid.sync(); xbar = xcd_barrier_post(barw, (volatile LAS unsigned*)(lds + LDS_CTL)); posted = true; }
            else xcd_barrier(xbar);
        }
    }
}

#ifndef MK_MULTI
#define MK_MULTI 0
#endif
extern "C" void kernel_launch(void* const* d_in, const int* in_sizes, int n_in, void* d_out, int out_size, void* d_ws, size_t ws_size, hipStream_t stream) {
    static int grid = 0;
    if (grid == 0) {
        if (n_in != 32 || out_size != M * D || ws_size < WS_END) { fprintf(stderr, "kernel_launch: unexpected shapes (n_in %d out %d ws %zu)\n", n_in, out_size, ws_size); grid = -1; return; }
        int dev = 0, cus = 0, per_cu = 0;
        (void)hipGetDevice(&dev); (void)hipDeviceGetAttribute(&cus, hipDeviceAttributeMultiprocessorCount, dev);
        (void)hipFuncSetAttribute((const void*)mk_fwd, hipFuncAttributeMaxDynamicSharedMemorySize, LDS_BYTES);
        (void)hipOccupancyMaxActiveBlocksPerMultiprocessor(&per_cu, (const void*)mk_fwd, 512, LDS_BYTES);
        if (per_cu < 1) { fprintf(stderr, "kernel_launch: occupancy query says %d blocks per CU\n", per_cu); per_cu = 1; }
        grid = cus * per_cu;
        (void)hipGetLastError();
    }
    if (grid < 0) return;
    Args a{};
    for (int i = 0; i < 32; ++i) a.in[i] = (const float*)d_in[i];
    a.out = (float*)d_out; a.ws = (unsigned char*)d_ws;
#if MK_MULTI
    for (int p = 0; p < 19; ++p) { a.ph_lo = p; a.ph_hi = p + 1; hipLaunchKernelGGL(mk_fwd, dim3(grid), dim3(512), LDS_BYTES, stream, a); }
#else
    a.ph_lo = 0; a.ph_hi = 19;
    void* args[] = {&a};
    hipError_t e = hipLaunchCooperativeKernel((const void*)mk_fwd, dim3(grid), dim3(512), args, LDS_BYTES, stream);
    if (e != hipSuccess) fprintf(stderr, "cooperative launch failed: %s (grid %d)\n", hipGetErrorString(e), grid);
#endif
}
```

```cpp
#include <hip/hip_runtime.h>
#include <hip/hip_cooperative_groups.h>
#include <hip/hip_fp16.h>
#include <cstdio>
#include <cstdint>
namespace cg = cooperative_groups;
namespace pg8 {
#define PG8_LAS __attribute__((address_space(3)))
typedef unsigned short bf16_t;
typedef short bf16x8 __attribute__((ext_vector_type(8)));
typedef float f32x4 __attribute__((ext_vector_type(4)));
typedef unsigned u32x4 __attribute__((ext_vector_type(4)));
constexpr int BM = 256, BK = 64, HALF = 128, HTB = HALF * BK * 2  , STAGE_BYTES = 8 * HTB, NXCD = 8, WGM = 8;

__host__ __device__ __forceinline__ int lds_byte(int r, int c) { const int st = (r >> 4) * 2 + (c >> 5), rr = r & 15, cc = c & 31, ob = rr * 64 + cc * 2; return st * 1024 + (ob ^ (((ob >> 9) & 1) << 5)); }
__host__ __device__ __forceinline__ void stage_rc(int b, int& R, int& C) { const int st = b / 1024, sb = b % 1024, swz = sb ^ (((sb >> 9) & 1) << 5); R = (st >> 1) * 16 + swz / 64; C = (st & 1) * 32 + (swz % 64) / 2; }
__host__ __device__ __forceinline__ int perm32(int rho) { const int n = rho >> 4, i = rho & 15; return 8 * (i >> 2) + 4 * n + (i & 3); }

struct Unit { int pm, pn; };
struct Gemm { const bf16_t* A; const bf16_t* Bt; int M, N, K; };

struct StaticOrder {
    int nM, nN, nwg, G, c;
    __host__ __device__ void init(int M, int N, int G_, int c_) { nM = M / BM; nN = N / BM; nwg = nM * nN; G = G_; c = c_; }
    __host__ __device__ bool next(int i, Unit& u) const {
        const long L = (long)i * G + c; if (L >= nwg) return false;
        int wgid = (int)L; { const int q = nwg / NXCD, r = nwg % NXCD, xcd = wgid % NXCD, off = wgid / NXCD; wgid = (xcd < r ? xcd * (q + 1) : r * (q + 1) + (xcd - r) * q) + off; }
        const int nig = WGM * nN, gid = wgid / nig, fm = gid * WGM, gsz = (nM - fm) < WGM ? (nM - fm) : WGM;
        u.pm = fm + ((wgid % nig) % gsz); u.pn = (wgid % nig) / gsz; return true;
    }
    __device__ __forceinline__ void a_ready(const Unit&) const {}
    __device__ __forceinline__ void done(const Unit&) const {}
};

typedef __bf16 bf16x2_t __attribute__((ext_vector_type(2)));
typedef float f32x2_t __attribute__((ext_vector_type(2)));
__device__ __forceinline__ unsigned cvt_pk_bf16(float lo, float hi) { const f32x2_t v = {lo, hi}; return __builtin_bit_cast(unsigned, __builtin_convertvector(v, bf16x2_t)); }
template <int ACT  > struct EpiAct {
    static constexpr bool PERM = true, AFTER_DRAIN = false;
    bf16_t* O; int ldc;
    __device__ __forceinline__ void operator()(const f32x4 (&acc)[2][2][4][2], const Unit& u, int wr, int wc, int fr, int fq) const {
        const int row0 = u.pm * BM + wr * 64 + fr; const int col0 = u.pn * BM + wc * 32 + 8 * fq;
#pragma unroll
        for (int ai = 0; ai < 2; ++ai)
#pragma unroll
            for (int m = 0; m < 4; ++m) { bf16_t* rowp = O + (size_t)(row0 + ai * HALF + m * 16) * ldc + col0;
#pragma unroll
                for (int bj = 0; bj < 2; ++bj) { f32x4 v0 = acc[ai][bj][m][0], v1 = acc[ai][bj][m][1];
                    if (ACT == 1) {
#pragma unroll
                        for (int e = 0; e < 4; ++e) { float a = fmaxf(v0[e], 0.f), b = fmaxf(v1[e], 0.f); v0[e] = a * a; v1[e] = b * b; } }
                    u32x4 w; w.x = cvt_pk_bf16(v0[0], v0[1]); w.y = cvt_pk_bf16(v0[2], v0[3]); w.z = cvt_pk_bf16(v1[0], v1[1]); w.w = cvt_pk_bf16(v1[2], v1[3]);
                    *(u32x4*)(rowp + bj * HALF) = w; } }
    }
};
struct EpiRes {
    static constexpr bool PERM = false, AFTER_DRAIN = false;
    const float* base; float* out; const float* gate;
    __device__ __forceinline__ void operator()(const f32x4 (&acc)[2][2][4][2], const Unit& u, int wr, int wc, int fr, int fq) const {
        const int col0 = u.pn * BM + wc * 32 + 4 * fq;
        const float* gp = gate + (size_t)((u.pm * BM) >> 11) * 6144 + col0;
        f32x4 gv[2][2];
#pragma unroll
        for (int bj = 0; bj < 2; ++bj)
#pragma unroll
            for (int n = 0; n < 2; ++n) gv[bj][n] = *(const f32x4*)(gp + bj * HALF + n * 16);
#pragma unroll
        for (int ai = 0; ai < 2; ++ai)
#pragma unroll
            for (int m = 0; m < 4; ++m) { const size_t off = (size_t)(u.pm * BM + ai * HALF + wr * 64 + m * 16 + fr) * 1024 + col0;
#pragma unroll
                for (int bj = 0; bj < 2; ++bj)
#pragma unroll
                    for (int n = 0; n < 2; ++n) { const f32x4 bs = *(const f32x4*)(base + off + bj * HALF + n * 16);
                        *(f32x4*)(out + off + bj * HALF + n * 16) = bs + gv[bj][n] * acc[ai][bj][m][n]; } }
    }
};
typedef unsigned u32x2_ __attribute__((ext_vector_type(2)));
__device__ __forceinline__ float shx_(float v, int m) { int l = __builtin_amdgcn_mbcnt_hi(~0u, __builtin_amdgcn_mbcnt_lo(~0u, 0u)); asm volatile("" : "+v"(l));
    return __builtin_bit_cast(float, __builtin_amdgcn_ds_bpermute((l ^ m) << 2, __builtin_bit_cast(int, v))); }
struct EpiDyn {
    static constexpr bool PERM = true, AFTER_DRAIN = false;
    int kind; bf16_t* O; int ldc; const float* base; float* out; const float* gate;
    const float* ssq_in; const float* bias; int bstride; const PG8_LAS float* rtab;
    bf16_t* XS; float* ssq_out; const float* gn; const float* scv;
    __device__ __forceinline__ void operator()(const f32x4 (&acc)[2][2][4][2], const Unit& u, int wr, int wc, int fr, int fq, int ui) const {
        const int row0 = u.pm * BM + wr * 64 + fr; const int col0 = u.pn * BM + wc * 32 + 8 * fq; const int b = (u.pm * BM) >> 11;
        if (kind < 2) {
            f32x4 bv[2][2];
#pragma unroll
            for (int bj = 0; bj < 2; ++bj)
#pragma unroll
                for (int n = 0; n < 2; ++n) bv[bj][n] = ssq_in ? *(const f32x4*)(bias + (size_t)b * bstride + col0 + bj * HALF + n * 4) : (f32x4){0.f, 0.f, 0.f, 0.f};
#pragma unroll
            for (int ai = 0; ai < 2; ++ai)
#pragma unroll
                for (int m = 0; m < 4; ++m) { const int row = row0 + ai * HALF + m * 16; bf16_t* rowp = O + (size_t)row * ldc + col0;
                    float rstd = 1.f;
                    if (ssq_in) rstd = rtab[ui * 256 + wr * 64 + fr + ai * HALF + m * 16];
#pragma unroll
                    for (int bj = 0; bj < 2; ++bj) { f32x4 v0 = acc[ai][bj][m][0] * rstd + bv[bj][0], v1 = acc[ai][bj][m][1] * rstd + bv[bj][1];
                        if (kind == 1) {
#pragma unroll
                            for (int e = 0; e < 4; ++e) { float a = fmaxf(v0[e], 0.f), c = fmaxf(v1[e], 0.f); v0[e] = a * a; v1[e] = c * c; } }
                        u32x4 w; w.x = cvt_pk_bf16(v0[0], v0[1]); w.y = cvt_pk_bf16(v0[2], v0[3]); w.z = cvt_pk_bf16(v1[0], v1[1]); w.w = cvt_pk_bf16(v1[2], v1[3]);
                        *(u32x4*)(rowp + bj * HALF) = w; } }
        } else {
            const float* gp = gate + (size_t)b * 6144 + col0;
            f32x4 gv[2][2], gm[2][2];
#pragma unroll
            for (int bj = 0; bj < 2; ++bj)
#pragma unroll
                for (int n = 0; n < 2; ++n) { gv[bj][n] = *(const f32x4*)(gp + bj * HALF + n * 4);
                    gm[bj][n] = XS ? *(const f32x4*)(gn + col0 + bj * HALF + n * 4) * (*(const f32x4*)(scv + (size_t)b * 6144 + col0 + bj * HALF + n * 4) + 1.f) : (f32x4){0.f, 0.f, 0.f, 0.f}; }
#pragma unroll
            for (int aim = 0; aim < 4; ++aim) { const int ai = aim >> 1, m0 = (aim & 1) * 2;
                f32x4 bs[4][2][2];
#pragma unroll
                for (int m = m0; m < m0 + 2; ++m) { const size_t off = (size_t)(row0 + ai * HALF + m * 16) * 1024 + col0;
#pragma unroll
                    for (int bj = 0; bj < 2; ++bj)
#pragma unroll
                        for (int n = 0; n < 2; ++n) bs[m][bj][n] = *(const f32x4*)(base + off + bj * HALF + n * 4); }
                asm volatile("" ::: "memory");
#pragma unroll
                for (int m = m0; m < m0 + 2; ++m) { const int row = row0 + ai * HALF + m * 16; const size_t off = (size_t)row * 1024 + col0; float sq = 0.f;
#pragma unroll
                    for (int bj = 0; bj < 2; ++bj)
#pragma unroll
                        for (int n = 0; n < 2; ++n) {
                            const f32x4 o = bs[m][bj][n] + gv[bj][n] * acc[ai][bj][m][n];
                            *(f32x4*)(out + off + bj * HALF + n * 4) = o;
                            if (XS) { sq += (o[0] * o[0] + o[1] * o[1]) + (o[2] * o[2] + o[3] * o[3]); const f32x4 x = o * gm[bj][n];
                                u32x2_ w; w.x = cvt_pk_bf16(x[0], x[1]); w.y = cvt_pk_bf16(x[2], x[3]); *(u32x2_*)(XS + off + bj * HALF + n * 4) = w; } }
                    if (XS) { sq += shx_(sq, 16); sq += shx_(sq, 32); if (fq == 0) ssq_out[(size_t)row * 16 + u.pn * 4 + wc] = sq; } }
                asm volatile("" ::: "memory");
            }
        }
    }
};
template <class Epi, class Sched, bool ALIGN_EPI = false, bool SP2 = false>
__device__ __forceinline__ void gemm_phase(PG8_LAS unsigned char* lds, const Gemm g, const Sched& S, const Epi& E, const int tid_in) {
    int tid = tid_in; asm volatile("" : "+v"(tid));
    const int wid = __builtin_amdgcn_readfirstlane(tid >> 6), lane = tid & 63, wr = wid >> 2, wc = wid & 3, fr = lane & 15, fq = lane >> 4;
    const int K = g.K, nt = K / BK;
    unsigned voffA[2], voffB[2];
#pragma unroll
    for (int i = 0; i < 2; ++i) { int R, C; stage_rc(tid * 16 + i * 8192, R, C); const int Rb = Epi::PERM ? ((R & ~31) + perm32(R & 31)) : R;
        voffA[i] = (unsigned)(R * K + C) * 2u; voffB[i] = (unsigned)(Rb * K + C) * 2u; }
    const size_t kstep = (size_t)(BK * 2);
    const size_t hstep = (size_t)HALF * K * 2;
    const size_t tstep = 2 * hstep;
    const unsigned ldsw = (unsigned)wid * 1024u;
    const int aoff = lds_byte(wr * 64 + fr, fq * 8), boff = lds_byte(wc * 32 + fr, fq * 8);
#define PG8_SA(b, h) (((b) * 2 + (h)) * HTB)
#define PG8_SB(b, h) ((4 + (b) * 2 + (h)) * HTB)
#define PG8_STAGE(bufoff, gbase, voff) do { _Pragma("unroll") for (int _i = 0; _i < 2; ++_i) \
        __builtin_amdgcn_global_load_lds((const unsigned*)((const char*)(gbase) + (voff)[_i]), (PG8_LAS unsigned*)(lds + (bufoff) + ldsw + _i * 8192), 16, 0, 0); } while (0)
#define PG8_LDA(dst, b, h) do { _Pragma("unroll") for (int m = 0; m < 4; ++m) _Pragma("unroll") for (int k = 0; k < 2; ++k) dst[m][k] = *(const PG8_LAS bf16x8*)(lds + PG8_SA(b, h) + aoff + m * 2048 + k * 1024); } while (0)
#define PG8_LDB(dst, b, h) do { _Pragma("unroll") for (int n = 0; n < 2; ++n) _Pragma("unroll") for (int k = 0; k < 2; ++k) dst[n][k] = *(const PG8_LAS bf16x8*)(lds + PG8_SB(b, h) + boff + n * 2048 + k * 1024); } while (0)
#define PG8_MMA(ai, bj, At, Bt) do { __builtin_amdgcn_s_setprio(1); _Pragma("unroll") for (int m = 0; m < 4; ++m) _Pragma("unroll") for (int n = 0; n < 2; ++n) _Pragma("unroll") for (int k = 0; k < 2; ++k) \
        acc[ai][bj][m][n] = __builtin_amdgcn_mfma_f32_16x16x32_bf16(Bt[n][k], At[m][k], acc[ai][bj][m][n], 0, 0, 0); __builtin_amdgcn_s_setprio(0); } while (0)
#define PG8_WAIT_V(n) asm volatile("s_waitcnt vmcnt(" #n ")" ::: "memory")
#define PG8_WAIT_L(n) asm volatile("s_waitcnt lgkmcnt(" #n ")" ::: "memory")
#define PG8_BAR __builtin_amdgcn_s_barrier()
#define PG8_SCHED __builtin_amdgcn_sched_barrier(0)
    Unit cur, nxt; int ui = 0;
    if (!S.next(0, cur)) return;
    f32x4 acc[2][2][4][2];
#pragma unroll
    for (int a = 0; a < 2; ++a)
#pragma unroll
        for (int b = 0; b < 2; ++b)
#pragma unroll
            for (int m = 0; m < 4; ++m)
#pragma unroll
                for (int n = 0; n < 2; ++n) acc[a][b][m][n] = (f32x4){0.f, 0.f, 0.f, 0.f};
    bf16x8 At[4][2], B0[2][2], B1[2][2];
    const char* cA = (const char*)g.A + (size_t)cur.pm * tstep; const char* cB = (const char*)g.Bt + (size_t)cur.pn * tstep;
    S.a_ready(cur);
    if constexpr (SP2) {
        PG8_STAGE(PG8_SB(0, 0), cB, voffB); PG8_STAGE(PG8_SB(0, 1), cB + hstep, voffB); PG8_STAGE(PG8_SA(0, 0), cA, voffA); PG8_STAGE(PG8_SA(0, 1), cA + hstep, voffA);
        if (wr == 1) PG8_BAR;
        PG8_WAIT_V(2); PG8_BAR;
        PG8_STAGE(PG8_SB(1, 0), cB + kstep, voffB); PG8_STAGE(PG8_SA(1, 0), cA + kstep, voffA); PG8_STAGE(PG8_SB(1, 1), cB + hstep + kstep, voffB);
        PG8_WAIT_V(6); PG8_BAR;
    } else {
        PG8_STAGE(PG8_SB(0, 0), cB, voffB); PG8_STAGE(PG8_SA(0, 0), cA, voffA); PG8_STAGE(PG8_SB(0, 1), cB + hstep, voffB); PG8_STAGE(PG8_SA(0, 1), cA + hstep, voffA);
        if (wr == 1) PG8_BAR;
        PG8_WAIT_V(4); PG8_BAR;
        PG8_STAGE(PG8_SB(1, 0), cB + kstep, voffB); PG8_STAGE(PG8_SA(1, 0), cA + kstep, voffA); PG8_STAGE(PG8_SB(1, 1), cB + hstep + kstep, voffB);
        PG8_WAIT_V(6); PG8_BAR;
    }
    for (;;) {
        const bool has_next = S.next(ui + 1, nxt);
        const char* nA = has_next ? (const char*)g.A + (size_t)nxt.pm * tstep : cA; const char* nB = has_next ? (const char*)g.Bt + (size_t)nxt.pn * tstep : cB;
        for (int t = 0; t < nt; t += 2) {
            const bool last = (t == nt - 2);
            const char* a1 = cA + (size_t)(t + 1) * kstep;
            const char* a2 = last ? nA : cA + (size_t)(t + 2) * kstep; const char* b2 = last ? nB : cB + (size_t)(t + 2) * kstep;
            const char* a3 = a2 + kstep; const char* b3 = b2 + kstep;
            if (last && has_next) S.a_ready(nxt);
            if constexpr (SP2) {
            PG8_LDB(B0, 0, 0); PG8_LDB(B1, 0, 1); PG8_SCHED; PG8_LDA(At, 0, 0); PG8_STAGE(PG8_SA(1, 1), a1 + hstep, voffA);
            PG8_WAIT_V(8); PG8_WAIT_L(0); PG8_BAR; PG8_MMA(0, 0, At, B0); PG8_MMA(0, 1, At, B1); PG8_BAR; PG8_SCHED;
            PG8_LDA(At, 0, 1); PG8_STAGE(PG8_SB(0, 0), b2, voffB); PG8_STAGE(PG8_SB(0, 1), b2 + hstep, voffB); PG8_STAGE(PG8_SA(0, 0), a2, voffA);
            PG8_WAIT_V(8); PG8_WAIT_L(0); PG8_BAR; PG8_MMA(1, 0, At, B0); PG8_MMA(1, 1, At, B1); PG8_BAR; PG8_SCHED;
            PG8_LDB(B0, 1, 0); PG8_LDB(B1, 1, 1); PG8_SCHED; PG8_LDA(At, 1, 0); PG8_STAGE(PG8_SA(0, 1), a2 + hstep, voffA);
            PG8_WAIT_V(8); PG8_WAIT_L(0); PG8_BAR; PG8_MMA(0, 0, At, B0); PG8_MMA(0, 1, At, B1); PG8_BAR; PG8_SCHED;
            PG8_LDA(At, 1, 1); PG8_STAGE(PG8_SB(1, 0), b3, voffB); PG8_STAGE(PG8_SB(1, 1), b3 + hstep, voffB); PG8_STAGE(PG8_SA(1, 0), a3, voffA);
            PG8_WAIT_V(8); PG8_WAIT_L(0); PG8_BAR; PG8_MMA(1, 0, At, B0); PG8_MMA(1, 1, At, B1); PG8_BAR; PG8_SCHED;
            } else {
            PG8_LDB(B0, 0, 0); PG8_SCHED; PG8_LDA(At, 0, 0); PG8_STAGE(PG8_SA(1, 1), a1 + hstep, voffA);
            PG8_WAIT_L(8); PG8_BAR; PG8_WAIT_L(0); PG8_MMA(0, 0, At, B0); PG8_BAR; PG8_SCHED;
            PG8_LDB(B1, 0, 1); PG8_STAGE(PG8_SB(0, 0), b2, voffB);
            PG8_BAR; PG8_WAIT_L(0); PG8_MMA(0, 1, At, B1); PG8_BAR;
            PG8_LDA(At, 0, 1); PG8_STAGE(PG8_SA(0, 0), a2, voffA);
            PG8_BAR; PG8_WAIT_L(0); PG8_MMA(1, 0, At, B0); PG8_BAR; PG8_SCHED;
            PG8_STAGE(PG8_SB(0, 1), b2 + hstep, voffB);
            PG8_WAIT_V(6); PG8_BAR; PG8_MMA(1, 1, At, B1); PG8_BAR;
            PG8_LDB(B0, 1, 0); PG8_SCHED; PG8_LDA(At, 1, 0); PG8_STAGE(PG8_SA(0, 1), a2 + hstep, voffA);
            PG8_WAIT_L(8); PG8_BAR; PG8_WAIT_L(0); PG8_MMA(0, 0, At, B0); PG8_BAR; PG8_SCHED;
            PG8_LDB(B1, 1, 1); PG8_STAGE(PG8_SB(1, 0), b3, voffB);
            PG8_BAR; PG8_WAIT_L(0); PG8_MMA(0, 1, At, B1); PG8_BAR;
            PG8_LDA(At, 1, 1); PG8_STAGE(PG8_SA(1, 0), a3, voffA);
            PG8_BAR; PG8_WAIT_L(0); PG8_MMA(1, 0, At, B0); PG8_BAR; PG8_SCHED;
            PG8_STAGE(PG8_SB(1, 1), b3 + hstep, voffB);
            PG8_WAIT_V(6); PG8_BAR; PG8_MMA(1, 1, At, B1); PG8_BAR;
            }
        }
        if constexpr (ALIGN_EPI) { if (wr == 0) PG8_BAR; }
        if constexpr (!Epi::AFTER_DRAIN) { E(acc, cur, wr, wc, fr, fq, ui); S.done(cur); }
        if (!has_next) break;
#pragma unroll
        for (int a = 0; a < 2; ++a)
#pragma unroll
            for (int b = 0; b < 2; ++b)
#pragma unroll
                for (int m = 0; m < 4; ++m)
#pragma unroll
                    for (int n = 0; n < 2; ++n) acc[a][b][m][n] = (f32x4){0.f, 0.f, 0.f, 0.f};
        cur = nxt; cA = nA; cB = nB; ++ui;
        if constexpr (ALIGN_EPI) { if (wr == 1) PG8_BAR; }
    }
    PG8_WAIT_V(0);
    if constexpr (!ALIGN_EPI) { if (wr == 0) PG8_BAR; }
    PG8_BAR;
    if constexpr (Epi::AFTER_DRAIN) { E.fused(acc, cur, wr, wc, fr, fq, lds, wid, lane); S.done(cur); }
#undef PG8_SA
#undef PG8_SB
#undef PG8_STAGE
#undef PG8_LDA
#undef PG8_LDB
#undef PG8_MMA
#undef PG8_WAIT_V
#undef PG8_WAIT_L
#undef PG8_BAR
#undef PG8_SCHED
}
}

constexpr int BATCH = 16, T = 2048, D = 1024, M = BATCH * T, NIN = 3072, FF = 4096;
constexpr size_t MiB = 1u << 20;
constexpr size_t WS_WB = 1 * MiB;
constexpr size_t WB_LAYER = 24 * MiB, WB_IN = 0, WB_OUT = 6 * MiB, WB_W1 = 8 * MiB, WB_W2 = 16 * MiB;
constexpr size_t WS_MOD = 49 * MiB;
constexpr size_t WS_LORA = 50 * MiB;
constexpr size_t LORA_LAYER = 131072, LORA_W2 = 0, LORA_A2 = 32768, LORA_G2 = 65536;
constexpr size_t WS_SCAL = 51 * MiB;
constexpr size_t WS_XN = 53 * MiB;
constexpr size_t WS_SW = WS_XN, WS_YR = WS_XN + 32 * MiB;
constexpr size_t WS_Y = 117 * MiB;
constexpr size_t WS_P = 181 * MiB;
constexpr size_t WS_S16 = 373 * MiB;
constexpr size_t S16_ARR = 16 * MiB;
constexpr size_t WS_G = 453 * MiB;
constexpr size_t WS_H = WS_P;
constexpr size_t WS_VT = 469 * MiB;
constexpr size_t WS_SSQA = 501 * MiB, WS_SSQB = 503 * MiB;
constexpr size_t WS_BIAS = 505 * MiB;
constexpr size_t WS_END = 506 * MiB;
constexpr int LDS_BYTES = 147456;
constexpr size_t WS_BAR = 16384;
constexpr int LDS_CTL = LDS_BYTES - 64;

#define LAS __attribute__((address_space(3)))
typedef unsigned short bf16;
typedef _Float16 h16;
typedef float f32x4 __attribute__((ext_vector_type(4)));
typedef float f32x2 __attribute__((ext_vector_type(2)));
typedef short bf16x8 __attribute__((ext_vector_type(8)));
typedef unsigned u32x4 __attribute__((ext_vector_type(4)));
typedef unsigned u32x2 __attribute__((ext_vector_type(2)));
typedef h16 h16x4 __attribute__((ext_vector_type(4)));
typedef h16 h16x8 __attribute__((ext_vector_type(8)));

__device__ __forceinline__ unsigned pk2(float lo, float hi) { return pg8::cvt_pk_bf16(lo, hi); }
__device__ __forceinline__ unsigned f2bf(float f) { return pg8::cvt_pk_bf16(f, 0.f) & 0xffffu; }
__device__ __forceinline__ float bf2f(unsigned h) { return __builtin_bit_cast(float, h << 16); }
__device__ __forceinline__ float bflo(unsigned w) { return __builtin_bit_cast(float, w << 16); }
__device__ __forceinline__ float bfhi(unsigned w) { return __builtin_bit_cast(float, w & 0xffff0000u); }
__device__ __forceinline__ float shx(float v, int m) { int l = __builtin_amdgcn_mbcnt_hi(~0u, __builtin_amdgcn_mbcnt_lo(~0u, 0u)); asm volatile("" : "+v"(l));
    return __builtin_bit_cast(float, __builtin_amdgcn_ds_bpermute((l ^ m) << 2, __builtin_bit_cast(int, v))); }
__device__ __forceinline__ float wave_sum(float v) {
#pragma unroll
    for (int o = 1; o < 64; o <<= 1) v += shx(v, o);
    return v;
}
__device__ __forceinline__ float sum16(float v) {
    v += shx(v, 1); v += shx(v, 2); v += shx(v, 4); v += shx(v, 8); return v;
}
__device__ __forceinline__ float sigmoidf_(float x) { return 1.f / (1.f + __expf(-x)); }
#define LDS_WAIT() asm volatile("s_waitcnt lgkmcnt(0)" ::: "memory")

struct Args { const float* in[32]; float* out; unsigned char* ws; int ph_lo, ph_hi; };

__device__ __forceinline__ const float* inp(const Args& a, int i) { asm volatile("" : "+s"(i)); return a.in[i]; }
__device__ __forceinline__ void p0_transpose_item(const float* W, int K, int N, bf16* WT, float* scr, int item, int lane) {
    const int nblk = N / 32, kb = item / nblk, nb = item % nblk, k0 = 64 * kb, n0 = 32 * nb;
#pragma unroll 8
    for (int i = 0; i < 32; ++i) { const int kk = 2 * i + (lane >> 5); scr[kk * 33 + (lane & 31)] = W[(size_t)(k0 + kk) * N + n0 + (lane & 31)]; }
    LDS_WAIT(); asm volatile("" ::: "memory");
    const int c = lane & 7;
#pragma unroll
    for (int j = 0; j < 4; ++j) { const int n = (lane >> 3) + 8 * j; const float* s = scr + (8 * c) * 33 + n;
        u32x4 o; o.x = pk2(s[0 * 33], s[1 * 33]); o.y = pk2(s[2 * 33], s[3 * 33]); o.z = pk2(s[4 * 33], s[5 * 33]); o.w = pk2(s[6 * 33], s[7 * 33]);
        *(u32x4*)(WT + (size_t)(n0 + n) * K + k0 + 8 * c) = o; }
    LDS_WAIT(); asm volatile("" ::: "memory");
}
__device__ __forceinline__ void phase_weights(const Args& a, unsigned char* lds, int wave, int lane) {
    float* scr = (float*)(lds + wave * 16384);
    const int gw = blockIdx.x * 8 + wave, NGW = gridDim.x * 8;
    constexpr int I_IN = 16 * 96, I_OUT = 16 * 32, I_W1 = 16 * 128, I_W2 = 64 * 32, I_L2 = 8, I_G2 = 16;
    constexpr int PER = I_IN + I_OUT + I_W1 + I_W2 + 2 * I_L2 + I_G2;
    for (int it = gw; it < 2 * PER; it += NGW) {
        const int l = it / PER; int r = it % PER;
        unsigned char* wb = a.ws + WS_WB + (size_t)l * WB_LAYER; unsigned char* lo = a.ws + WS_LORA + (size_t)l * LORA_LAYER;
        if (r < I_IN) { p0_transpose_item(inp(a, 5) + (size_t)l * D * NIN, D, NIN, (bf16*)(wb + WB_IN), scr, r, lane); continue; } r -= I_IN;
        if (r < I_OUT) { p0_transpose_item(inp(a, 28) + (size_t)l * D * D, D, D, (bf16*)(wb + WB_OUT), scr, r, lane); continue; } r -= I_OUT;
        if (r < I_W1) { p0_transpose_item(inp(a, 30) + (size_t)l * D * FF, D, FF, (bf16*)(wb + WB_W1), scr, r, lane); continue; } r -= I_W1;
        if (r < I_W2) { p0_transpose_item(inp(a, 31) + (size_t)l * FF * D, FF, D, (bf16*)(wb + WB_W2), scr, r, lane); continue; } r -= I_W2;
        if (r < I_L2) { p0_transpose_item(inp(a, 8) + (size_t)l * 64 * 256, 64, 256, (bf16*)(lo + LORA_W2), scr, r, lane); continue; } r -= I_L2;
        if (r < I_L2) { p0_transpose_item(inp(a, 10) + (size_t)l * 64 * 256, 64, 256, (bf16*)(lo + LORA_A2), scr, r, lane); continue; } r -= I_L2;
        p0_transpose_item(inp(a, 11) + (size_t)l * 128 * 256, 128, 256, (bf16*)(lo + LORA_G2), scr, r, lane);
    }
}
__device__ __forceinline__ void phase_ada(const Args& a, unsigned char* lds, int tid, int wave, int lane) {
    float* cond = (float*)lds; float* red = cond + 16384;
    const float* c = inp(a, 1); float* mod = (float*)(a.ws + WS_MOD);
    for (int i = tid; i < 16384; i += 512) { const float v = c[i]; cond[i] = v / (1.f + __expf(-v)); }
    __syncthreads();
    for (int item = blockIdx.x; item < 192; item += gridDim.x) {
        const int l = item / 96, n0 = (item % 96) * 64;
        const float* W = inp(a, 2) + (size_t)l * 1024 * 6144 + n0 + lane;
        float acc[16];
#pragma unroll
        for (int b = 0; b < 16; ++b) acc[b] = 0.f;
        const int k0 = wave * 128;
#pragma unroll 2
        for (int k = k0; k < k0 + 128; k += 4) {
            const float w0 = W[(size_t)k * 6144], w1 = W[(size_t)(k + 1) * 6144], w2 = W[(size_t)(k + 2) * 6144], w3 = W[(size_t)(k + 3) * 6144];
#pragma unroll
            for (int b = 0; b < 16; ++b) { const f32x4 cv = *(const f32x4*)(cond + b * 1024 + k); acc[b] += cv[0] * w0 + cv[1] * w1 + cv[2] * w2 + cv[3] * w3; }
        }
#pragma unroll
        for (int b = 0; b < 16; ++b) red[(wave * 16 + b) * 64 + lane] = acc[b];
        __syncthreads();
        for (int o = tid; o < 1024; o += 512) { const int b = o >> 6, n = o & 63; float s = 0.f;
#pragma unroll
            for (int w = 0; w < 8; ++w) s += red[(w * 16 + b) * 64 + n];
            mod[(size_t)(l * 16 + b) * 6144 + n0 + n] = s + inp(a, 3)[(size_t)l * 6144 + n0 + n]; }
        __syncthreads();
    }
}
__device__ __forceinline__ void phase_xn(const float* x, const float* g, const float* modl, int sh_off, int sc_off, bf16* XN, int wave, int lane) {
    const int gw = blockIdx.x * 8 + wave, NGW = gridDim.x * 8;
    for (int m = gw; m < M; m += NGW) {
        const int b = m >> 11;
        const f32x4* xr = (const f32x4*)(x + (size_t)m * D) + lane;
        f32x4 v[4]; float ss = 0.f;
#pragma unroll
        for (int j = 0; j < 4; ++j) { v[j] = xr[64 * j]; ss += (v[j][0] * v[j][0] + v[j][1] * v[j][1]) + (v[j][2] * v[j][2] + v[j][3] * v[j][3]); }
        const float rstd = rsqrtf(wave_sum(ss) * (1.f / D) + 1e-6f);
        const float* mb = modl + (size_t)b * 6144;
#pragma unroll
        for (int j = 0; j < 4; ++j) { const int col = 4 * lane + 256 * j;
            const f32x4 gg = *(const f32x4*)(g + col), sc = *(const f32x4*)(mb + sc_off + col), sh = *(const f32x4*)(mb + sh_off + col);
            const f32x4 y = (v[j] * rstd) * gg * (sc + 1.f) + sh;
            u32x2 w; w.x = pk2(y[0], y[1]); w.y = pk2(y[2], y[3]);
            *(u32x2*)(XN + (size_t)m * D + col) = w; }
    }
}

__device__ __forceinline__ f32x4 mfma16(bf16x8 A, bf16x8 B, f32x4 C) { return __builtin_amdgcn_mfma_f32_16x16x32_bf16(A, B, C, 0, 0, 0); }
__device__ __forceinline__ void phase_bias(const Args& a, int wave, int lane) {
    const int gw = blockIdx.x * 8 + wave, NGW = gridDim.x * 8;
    const int r = lane & 15, g = lane >> 4;
    float* BIAS = (float*)(a.ws + WS_BIAS);
    for (int t = gw; t < 704; t += NGW) {
        int idx, tile; if (t < 192) { idx = 0; tile = t; } else if (t < 448) { idx = 1; tile = t - 192; } else { idx = 2; tile = t - 448; }
        const int lsel = idx == 1 ? 0 : 1, N = idx == 0 ? NIN : FF;
        const float* sh = (const float*)(a.ws + WS_MOD) + (size_t)lsel * 16 * 6144 + (idx == 0 ? 0 : 3072) + (size_t)r * 6144 + g * 8;
        const bf16* Bt = (const bf16*)(a.ws + WS_WB + (size_t)lsel * WB_LAYER + (idx == 0 ? WB_IN : WB_W1)) + (size_t)(tile * 16 + r) * 1024 + g * 8;
        float* outp = BIAS + (idx == 0 ? 0 : (idx == 1 ? 16 * NIN : 16 * NIN + 16 * FF));
        f32x4 acc = {0.f, 0.f, 0.f, 0.f};
#pragma unroll 4
        for (int ks = 0; ks < 32; ++ks) {
            const f32x4 x0 = *(const f32x4*)(sh + ks * 32), x1 = *(const f32x4*)(sh + ks * 32 + 4);
            u32x4 hi, lo;
            hi.x = pk2(x0[0], x0[1]); hi.y = pk2(x0[2], x0[3]); hi.z = pk2(x1[0], x1[1]); hi.w = pk2(x1[2], x1[3]);
            lo.x = pk2(x0[0] - bflo(hi.x), x0[1] - bfhi(hi.x)); lo.y = pk2(x0[2] - bflo(hi.y), x0[3] - bfhi(hi.y));
            lo.z = pk2(x1[0] - bflo(hi.z), x1[1] - bfhi(hi.z)); lo.w = pk2(x1[2] - bflo(hi.w), x1[3] - bfhi(hi.w));
            const bf16x8 B = *(const bf16x8*)(Bt + ks * 32);
            acc = mfma16(__builtin_bit_cast(bf16x8, hi), B, acc); acc = mfma16(__builtin_bit_cast(bf16x8, lo), B, acc);
        }
#pragma unroll
        for (int j = 0; j < 4; ++j) outp[(size_t)(4 * g + j) * N + tile * 16 + r] = acc[j];
    }
}

template <int CTRL> __device__ __forceinline__ float dppf(float x) { return __builtin_bit_cast(float, __builtin_amdgcn_update_dpp(0, __builtin_bit_cast(int, x), CTRL, 0xf, 0xf, true)); }
__device__ __forceinline__ float rowsum16(float x) { x += dppf<0xB1>(x); x += dppf<0x4E>(x); x += dppf<0x124>(x); x += dppf<0x128>(x); return x; }
__device__ __forceinline__ float softplusf_(float x) { return x > 0.f ? x + log1pf(__expf(-x)) : log1pf(__expf(x)); }
__device__ __forceinline__ float sel4(f32x4 v, int j) { return j == 0 ? v[0] : (j == 1 ? v[1] : (j == 2 ? v[2] : v[3])); }
__device__ __forceinline__ float tanhf_(float x) { return 1.f - 2.f / (1.f + __expf(2.f * x)); }
__device__ __forceinline__ void phase_premix(const Args& a, int l, unsigned char* lds, int tid, int wave, int lane) {
    bf16* P = (bf16*)(a.ws + WS_P);
    const bf16* w2t = (const bf16*)(a.ws + WS_LORA + (size_t)l * LORA_LAYER + LORA_W2);
    const bf16* a2t = (const bf16*)(a.ws + WS_LORA + (size_t)l * LORA_LAYER + LORA_A2);
    const bf16* g2t = (const bf16*)(a.ws + WS_LORA + (size_t)l * LORA_LAYER + LORA_G2);
    h16* S16 = (h16*)(a.ws + WS_S16); float* SW = (float*)(a.ws + WS_SW); bf16* G = (bf16*)(a.ws + WS_G); float* SCAL = (float*)(a.ws + WS_SCAL);
    constexpr size_t ARR = (size_t)M * 256;
    bf16* praw = (bf16*)lds;
    bf16* act = (bf16*)(lds + 33 * 2048);
    bf16* vbuf = (bf16*)(lds + 33 * 2048 + 32 * 264 * 2);
    float* par = (float*)(lds + 33 * 2048 + 32 * 264 * 2 + 32 * 520 * 2);
    bf16* VT = (bf16*)(a.ws + WS_VT);
    if (tid < 256) { const float* mu = inp(a, 6) + l * 1024;
        par[tid] = mu[tid]; par[256 + tid] = mu[256 + tid]; par[512 + tid] = mu[512 + tid]; par[768 + tid] = mu[768 + tid];
        par[1024 + tid] = inp(a, 7)[l * 256 + tid]; par[1280 + tid] = inp(a, 9)[l * 256 + tid]; par[1536 + tid] = inp(a, 12)[l * 256 + tid];
        par[1792 + tid] = inp(a, 13)[l * 256 + tid]; par[2048 + tid] = inp(a, 14)[l * 256 + tid]; }
    else if (tid < 320) par[2304 + tid - 256] = inp(a, 17)[l * 64 + tid - 256];
    else if (tid < 384) par[2368 + tid - 320] = inp(a, 18)[l * 64 + tid - 320];
    __syncthreads();
    for (int tile = blockIdx.x; tile < M / 32; tile += gridDim.x) {
        int ln_ = lane; asm volatile("" : "+v"(ln_)); const int r = ln_ & 15, g = ln_ >> 4;
        const int b = tile >> 6, t0 = (tile & 63) * 32; const size_t row0 = (size_t)b * T + t0;
        const int tt = wave >> 2, h = wave & 3;
        u32x4 pr_[9], vv_[4], q0_[4], q1_[4]; u32x2 ga_[4], gb_[4];
#pragma unroll
        for (int i = 0; i < 9; ++i) { const int ch = tid + 512 * i, rr = ch >> 7, cc = ch & 127; pr_[i] = (u32x4){0u, 0u, 0u, 0u};
            if (ch < 33 * 128 && (rr > 0 || t0 > 0)) pr_[i] = *(const u32x4*)(P + (row0 + rr - 1) * NIN + cc * 8); }
#pragma unroll
        for (int i = 0; i < 4; ++i) { const int ch = tid + 512 * i, rr = ch >> 6, cc = ch & 63; vv_[i] = *(const u32x4*)(P + (row0 + rr) * NIN + 2048 + cc * 8);
            const bf16* prow = P + (row0 + wave * 4 + i) * NIN;
            q0_[i] = *(const u32x4*)(prow + 1024 + ln_ * 16); q1_[i] = *(const u32x4*)(prow + 1024 + ln_ * 16 + 8);
            ga_[i] = *(const u32x2*)(prow + 2560 + ln_ * 4); gb_[i] = *(const u32x2*)(prow + 2816 + ln_ * 4); }
#pragma unroll
        for (int i = 0; i < 9; ++i) { const int ch = tid + 512 * i, rr = ch >> 7, cc = ch & 127; if (ch < 33 * 128) *(u32x4*)(praw + rr * 1024 + cc * 8) = pr_[i]; }
#pragma unroll
        for (int i = 0; i < 4; ++i) { const int ch = tid + 512 * i, rr = ch >> 6, cc = ch & 63; *(u32x4*)(vbuf + rr * 520 + cc * 8) = vv_[i]; }
        {
            const float* gam = par + (ln_ < 32 ? 2304 : 2368) + (ln_ & 3) * 16;
            const float qs_ = ln_ < 32 ? 0.125f * 1.4426950408889634f : 1.f;
#pragma unroll
            for (int i = 0; i < 4; ++i) { bf16* prow = P + (row0 + wave * 4 + i) * NIN;
                float f[16];
#pragma unroll
                for (int e = 0; e < 4; ++e) { f[2 * e] = bflo(q0_[i][e]); f[2 * e + 1] = bfhi(q0_[i][e]); f[8 + 2 * e] = bflo(q1_[i][e]); f[8 + 2 * e + 1] = bfhi(q1_[i][e]); }
                float ss = 0.f;
#pragma unroll
                for (int e = 0; e < 16; ++e) ss += f[e] * f[e];
                ss += dppf<0xB1>(ss); ss += dppf<0x4E>(ss);
                const float sc = rsqrtf(ss * (1.f / 64.f) + 1e-6f) * qs_;
                u32x4 o0, o1;
#pragma unroll
                for (int e = 0; e < 4; ++e) { o0[e] = pk2(f[2 * e] * sc * gam[2 * e], f[2 * e + 1] * sc * gam[2 * e + 1]); o1[e] = pk2(f[8 + 2 * e] * sc * gam[8 + 2 * e], f[8 + 2 * e + 1] * sc * gam[8 + 2 * e + 1]); }
                *(u32x4*)(prow + 1024 + ln_ * 16) = o0; *(u32x4*)(prow + 1024 + ln_ * 16 + 8) = o1;
                u32x2 hv;
                hv.x = pk2(bflo(ga_[i].x) * sigmoidf_(bflo(gb_[i].x)), bfhi(ga_[i].x) * sigmoidf_(bfhi(gb_[i].x)));
                hv.y = pk2(bflo(ga_[i].y) * sigmoidf_(bflo(gb_[i].y)), bfhi(ga_[i].y) * sigmoidf_(bfhi(gb_[i].y)));
                *(u32x2*)(prow + 2560 + ln_ * 4) = hv; }
        }
        __syncthreads();
        bf16x8 Bw[2][4], Ba[2][4], Bg[4][4];
#pragma unroll
        for (int ct = 0; ct < 4; ++ct) {
#pragma unroll
            for (int ks = 0; ks < 2; ++ks) { const size_t wo = (size_t)(h * 64 + ct * 16 + r) * 64 + ks * 32 + g * 8; Bw[ks][ct] = *(const bf16x8*)(w2t + wo); Ba[ks][ct] = *(const bf16x8*)(a2t + wo); }
#pragma unroll
            for (int ks = 0; ks < 4; ++ks) Bg[ks][ct] = *(const bf16x8*)(g2t + (size_t)(h * 64 + ct * 16 + r) * 128 + ks * 32 + g * 8); }
        {
            bf16* dst = VT + ((size_t)b * 512 + tid) * T + t0;
#pragma unroll
            for (int q = 0; q < 4; ++q) { u32x4 o;
#pragma unroll
                for (int e = 0; e < 4; ++e) { const int k0_ = (e >> 1) * 16 + q * 4 + (e & 1) * 2; o[e] = (unsigned)vbuf[k0_ * 520 + tid] | ((unsigned)vbuf[(k0_ + 1) * 520 + tid] << 16); }
                *(u32x4*)(dst + q * 8) = o; } }
#pragma unroll 4
        for (int idx = tid; idx < 32 * 256; idx += 512) { const int tok = idx >> 8, c = idx & 255, col = 768 + c;
            const float cur = bf2f(praw[(tok + 1) * 1024 + col]), prev = bf2f(praw[tok * 1024 + col]);
            const float pa = cur + par[768 + c] * (prev - cur);
            const float o = c < 64 ? tanhf_(pa) : (c < 128 ? pa : sigmoidf_(pa));
            act[tok * 264 + c] = (bf16)f2bf(o); }
        __syncthreads();
        f32x4 aw[4], aa[4], ag[4];
#pragma unroll
        for (int ct = 0; ct < 4; ++ct) { aw[ct] = (f32x4){0.f, 0.f, 0.f, 0.f}; aa[ct] = aw[ct]; ag[ct] = aw[ct]; }
        const bf16* arow = act + (tt * 16 + r) * 264 + g * 8;
#pragma unroll
        for (int ks = 0; ks < 2; ++ks) { const bf16x8 A = *(const bf16x8*)(arow + ks * 32), A2 = *(const bf16x8*)(arow + 64 + ks * 32);
#pragma unroll
            for (int ct = 0; ct < 4; ++ct) { aw[ct] = mfma16(A, Bw[ks][ct], aw[ct]); aa[ct] = mfma16(A2, Ba[ks][ct], aa[ct]); } }
#pragma unroll
        for (int ks = 0; ks < 4; ++ks) { const bf16x8 A = *(const bf16x8*)(arow + 128 + ks * 32);
#pragma unroll
            for (int ct = 0; ct < 4; ++ct) ag[ct] = mfma16(A, Bg[ks][ct], ag[ct]); }
#pragma unroll 1
        for (int j = 0; j < 4; ++j) {
            const int tok = tt * 16 + 4 * g + j; const size_t token = row0 + tok;
            float kkv[4], k2v[4], rv[4], av[4], vv[4], dv[4]; float ss = 0.f;
#pragma unroll
            for (int ct = 0; ct < 4; ++ct) { const int c = h * 64 + ct * 16 + r;
                const bf16* pc = praw + (tok + 1) * 1024; const bf16* pp = praw + tok * 1024;
                float x0 = bf2f(pc[c]), x1 = bf2f(pc[256 + c]), x2 = bf2f(pc[512 + c]);
                x0 += par[c] * (bf2f(pp[c]) - x0); x1 += par[256 + c] * (bf2f(pp[256 + c]) - x1); x2 += par[512 + c] * (bf2f(pp[512 + c]) - x2);
                const float wl = par[1024 + c] + sel4(aw[ct], j);
                const float wlog = -__logf(1.f + __expf(-wl)) - 0.5f;
                dv[ct] = __expf(-__expf(wlog));
                av[ct] = sigmoidf_(par[1280 + c] + sel4(aa[ct], j));
                rv[ct] = x0; vv[ct] = x2;
                kkv[ct] = x1 * par[1536 + c]; ss += kkv[ct] * kkv[ct];
                k2v[ct] = x1 * (1.f + (av[ct] - 1.f) * par[1792 + c]); }
            ss = rowsum16(ss);
            const float inv = 1.f / fmaxf(sqrtf(ss), 1e-12f);
            float c1 = 0.f, c2 = 0.f, bn = 0.f;
#pragma unroll
            for (int ct = 0; ct < 4; ++ct) { const int c = h * 64 + ct * 16 + r; const size_t o = token * 256 + c;
                const float kkn = kkv[ct] * inv, ka = kkn * av[ct];
                c1 += ka * rv[ct]; c2 += k2v[ct] * rv[ct]; bn += rv[ct] * k2v[ct] * par[2048 + c];
                S16[o] = (h16)(-kkn); S16[ARR + o] = (h16)(dv[ct] * rv[ct]); S16[2 * ARR + o] = (h16)ka; S16[3 * ARR + o] = (h16)k2v[ct]; S16[4 * ARR + o] = (h16)vv[ct];
                SW[o] = dv[ct]; G[o] = (bf16)f2bf(sel4(ag[ct], j)); }
            c1 = rowsum16(c1); c2 = rowsum16(c2); bn = rowsum16(bn);
            if (r == 0) { float* sp = SCAL + (token * 4 + h) * 4; sp[0] = c1; sp[1] = c2; sp[2] = bn; sp[3] = 0.f; }
            asm volatile("" ::: "memory");
        }
        __syncthreads();
    }
}

__device__ __forceinline__ void st8(float* d, h16x8 v) {
    *(f32x4*)d = (f32x4){(float)v[0], (float)v[1], (float)v[2], (float)v[3]}; *(f32x4*)(d + 4) = (f32x4){(float)v[4], (float)v[5], (float)v[6], (float)v[7]}; }
constexpr int SC_REC = 384, SC_CH = 32, SC_NCH = T / SC_CH;
__device__ __forceinline__ void scan_load(const h16* S16, const float* SW, const float* SCAL, size_t tok0, int h, int rg, float* dst, int ltid) {
    constexpr size_t ARR = (size_t)M * 256;
    { const int s = ltid >> 3, q = ltid & 7; const h16* p = S16 + (tok0 + s) * 256 + h * 64 + q * 8; float* rec = dst + s * SC_REC + q * 8;
      const h16x8 v0 = *(const h16x8*)p, v1 = *(const h16x8*)(p + ARR), v2 = *(const h16x8*)(p + 2 * ARR), v3 = *(const h16x8*)(p + 3 * ARR);
      st8(rec, v0); st8(rec + 64, v1); st8(rec + 192, v2); st8(rec + 256, v3); }
#pragma unroll
    for (int i = 0; i < 2; ++i) { const int id = ltid + 256 * i, s = id >> 4, q = id & 15;
        *(f32x4*)(dst + s * SC_REC + 128 + q * 4) = *(const f32x4*)(SW + (tok0 + s) * 256 + h * 64 + q * 4); }
    if (ltid < 64) { const int s = ltid >> 1, q = ltid & 1; st8(dst + s * SC_REC + 320 + q * 8, *(const h16x8*)(S16 + 4 * ARR + (tok0 + s) * 256 + h * 64 + rg * 16 + q * 8)); }
    else if (ltid < 128) { const int s = (ltid - 64) >> 1, wh = ltid & 1; dst[s * SC_REC + 336 + wh] = SCAL[((tok0 + s) * 4 + h) * 4 + wh]; }
}
struct ScanOps { f32x4 nkk, wr, w, ka, k2; f32x2 c; float vi; };
__device__ __forceinline__ void scan_ld(ScanOps& o, const float* rec, int jq, int rowl) {
    o.nkk = *(const f32x4*)(rec + 4 * jq); o.wr = *(const f32x4*)(rec + 64 + 4 * jq); o.w = *(const f32x4*)(rec + 128 + 4 * jq);
    o.ka = *(const f32x4*)(rec + 192 + 4 * jq); o.k2 = *(const f32x4*)(rec + 256 + 4 * jq); o.vi = rec[320 + rowl]; o.c = *(const f32x2*)(rec + 336);
}
__device__ __forceinline__ void scan_step(f32x4& S, float& yk, const ScanOps& o, int jq, int sidx) {
    float sa = (S[0] * o.nkk[0] + S[1] * o.nkk[1]) + (S[2] * o.nkk[2] + S[3] * o.nkk[3]);
    float ys = (S[0] * o.wr[0] + S[1] * o.wr[1]) + (S[2] * o.wr[2] + S[3] * o.wr[3]);
    sa = rowsum16(sa); ys = rowsum16(ys);
    const float y = ys + sa * o.c[0] + o.vi * o.c[1];
    yk = (jq == (sidx & 15)) ? y : yk;
    S = S * o.w + o.ka * sa + o.k2 * o.vi;
}
__device__ __forceinline__ void phase_scan(const Args& a, unsigned char* lds, int tid, int wave, int lane) {
    const h16* S16 = (const h16*)(a.ws + WS_S16); const float* SW = (const float*)(a.ws + WS_SW); const float* SCAL = (const float*)(a.ws + WS_SCAL); float* YR = (float*)(a.ws + WS_YR);
    float* buf = (float*)lds;
    for (int it = blockIdx.x; it < 256; it += gridDim.x) {
        asm volatile("" : "+v"(tid), "+v"(lane));
        const int bh = it >> 2, rg = it & 3, b = bh >> 2, h = bh & 3;
        const size_t tokb = (size_t)b * T;
        if (wave >= 4) scan_load(S16, SW, SCAL, tokb, h, rg, buf, tid - 256);
        __syncthreads();
        const int rowl = (wave & 3) * 4 + (lane >> 4), jq = lane & 15;
        f32x4 S = {0.f, 0.f, 0.f, 0.f}; float yk = 0.f;
        float* yout = YR + (tokb + jq) * 256 + h * 64 + rg * 16 + rowl;
        for (int ch = 0; ch < SC_NCH; ++ch) {
            if (wave >= 4) { if (ch + 1 < SC_NCH) scan_load(S16, SW, SCAL, tokb + (size_t)(ch + 1) * SC_CH, h, rg, buf + ((ch + 1) & 1) * SC_CH * SC_REC, tid - 256); }
            else {
                const float* src = buf + (ch & 1) * SC_CH * SC_REC;
                ScanOps A, B;
                scan_ld(A, src, jq, rowl);
#pragma unroll
                for (int s = 0; s < SC_CH; s += 2) {
                    scan_ld(B, src + (s + 1) * SC_REC, jq, rowl);
                    scan_step(S, yk, A, jq, s);
                    if (s + 2 < SC_CH) scan_ld(A, src + (s + 2) * SC_REC, jq, rowl);
                    scan_step(S, yk, B, jq, s + 1);
                    if ((s & 15) == 14) yout[(size_t)(ch * SC_CH + (s & 16)) * 256] = yk;
                }
            }
            __syncthreads();
        }
    }
}

constexpr int AT_KP = 72;
__device__ __forceinline__ void attn_issue(const bf16* P, const bf16* VT, size_t rowk0, size_t vtb, int h, int tid, u32x4 (&kr)[2], u32x4 (&vr)[2]) {
#pragma unroll
    for (int i = 0; i < 2; ++i) {
        kr[i] = *(const u32x4*)(P + (rowk0 + ((tid >> 3) & 63)) * NIN + 1536 + (h * 2 + i) * 64 + (tid & 7) * 8);
        vr[i] = *(const u32x4*)(VT + vtb + (size_t)((tid >> 3) + 64 * i) * T + (tid & 7) * 8); }
}
__device__ __forceinline__ void attn_store(bf16* Kl, int tid, const u32x4 (&kr)[2], const u32x4 (&vr)[2]) {
#pragma unroll
    for (int i = 0; i < 2; ++i) {
        *(u32x4*)(Kl + i * 64 * AT_KP + ((tid >> 3) & 63) * AT_KP + (tid & 7) * 8) = kr[i];
        *(u32x4*)(Kl + 2 * 64 * AT_KP + ((tid >> 3) + 64 * i) * AT_KP + (tid & 7) * 8) = vr[i]; }
}
constexpr int AT_BUF = (2 * 64 + 128) * AT_KP;
__device__ __forceinline__ void attn_tile(const bf16* Lb, int kt, bool diag, int r, int g, int tq, float slope2, float bsh, const bf16x8* qb, f32x4 (&O)[2][8], float (&lsum)[2]) {
    const bf16* K0 = Lb; const bf16* K1 = Lb + 64 * AT_KP; const bf16* Vt = Lb + 2 * 64 * AT_KP;
    bf16x8 kf0[4][2], kf1[4][2];
#pragma unroll
    for (int k4 = 0; k4 < 4; ++k4)
#pragma unroll
        for (int ks = 0; ks < 2; ++ks) { kf0[k4][ks] = *(const bf16x8*)(K0 + (k4 * 16 + r) * AT_KP + ks * 32 + g * 8); kf1[k4][ks] = *(const bf16x8*)(K1 + (k4 * 16 + r) * AT_KP + ks * 32 + g * 8); }
    bf16x8 qf[2][2];
#pragma unroll
    for (int c = 0; c < 2; ++c)
#pragma unroll
        for (int ks = 0; ks < 2; ++ks) qf[c][ks] = qb[(c * 2 + ks) * 64];
    f32x4 init[4];
    if (diag) {
#pragma unroll
        for (int k4 = 0; k4 < 4; ++k4)
#pragma unroll
            for (int j = 0; j < 4; ++j) init[k4][j] = -slope2 * fabsf((float)(tq - (kt * 64 + k4 * 16 + 4 * g + j))) - bsh;
    } else {
        const float base = slope2 * (float)(kt * 64 + 4 * g - tq) - bsh;
#pragma unroll
        for (int k4 = 0; k4 < 4; ++k4)
#pragma unroll
            for (int j = 0; j < 4; ++j) init[k4][j] = fmaf(slope2, (float)(k4 * 16 + j), base);
    }
    __builtin_amdgcn_sched_barrier(0);
    f32x4 s0[4], s1[4];
#pragma unroll
    for (int k4 = 0; k4 < 4; ++k4) { s0[k4] = mfma16(kf0[k4][0], qf[0][0], init[k4]); s1[k4] = mfma16(kf1[k4][0], qf[1][0], init[k4]); }
#pragma unroll
    for (int k4 = 0; k4 < 4; ++k4) { s0[k4] = mfma16(kf0[k4][1], qf[0][1], s0[k4]); s1[k4] = mfma16(kf1[k4][1], qf[1][1], s1[k4]); }
    bf16x8 vf0[8], vf1[8];
#pragma unroll
    for (int nt = 0; nt < 8; ++nt) { vf0[nt] = *(const bf16x8*)(Vt + (nt * 16 + r) * AT_KP + g * 8); vf1[nt] = *(const bf16x8*)(Vt + (nt * 16 + r) * AT_KP + 32 + g * 8); }
    __builtin_amdgcn_sched_barrier(0);
    float p0 = 0.f, p1 = 0.f;
#pragma unroll
    for (int k4 = 0; k4 < 4; ++k4)
#pragma unroll
        for (int j = 0; j < 4; ++j) { s0[k4][j] = __builtin_amdgcn_exp2f(s0[k4][j]); p0 += s0[k4][j]; s1[k4][j] = __builtin_amdgcn_exp2f(s1[k4][j]); p1 += s1[k4][j]; }
    lsum[0] += p0; lsum[1] += p1;
    u32x4 a0, a1, b0, b1;
    a0.x = pg8::cvt_pk_bf16(s0[0][0], s0[0][1]); a0.y = pg8::cvt_pk_bf16(s0[0][2], s0[0][3]); a0.z = pg8::cvt_pk_bf16(s0[1][0], s0[1][1]); a0.w = pg8::cvt_pk_bf16(s0[1][2], s0[1][3]);
    a1.x = pg8::cvt_pk_bf16(s0[2][0], s0[2][1]); a1.y = pg8::cvt_pk_bf16(s0[2][2], s0[2][3]); a1.z = pg8::cvt_pk_bf16(s0[3][0], s0[3][1]); a1.w = pg8::cvt_pk_bf16(s0[3][2], s0[3][3]);
    b0.x = pg8::cvt_pk_bf16(s1[0][0], s1[0][1]); b0.y = pg8::cvt_pk_bf16(s1[0][2], s1[0][3]); b0.z = pg8::cvt_pk_bf16(s1[1][0], s1[1][1]); b0.w = pg8::cvt_pk_bf16(s1[1][2], s1[1][3]);
    b1.x = pg8::cvt_pk_bf16(s1[2][0], s1[2][1]); b1.y = pg8::cvt_pk_bf16(s1[2][2], s1[2][3]); b1.z = pg8::cvt_pk_bf16(s1[3][0], s1[3][1]); b1.w = pg8::cvt_pk_bf16(s1[3][2], s1[3][3]);
    const bf16x8 A0 = __builtin_bit_cast(bf16x8, a0), A1 = __builtin_bit_cast(bf16x8, a1), B0 = __builtin_bit_cast(bf16x8, b0), B1 = __builtin_bit_cast(bf16x8, b1);
#pragma unroll
    for (int nt = 0; nt < 8; ++nt) { O[0][nt] = mfma16(vf0[nt], A0, O[0][nt]); O[1][nt] = mfma16(vf0[nt], B0, O[1][nt]); }
#pragma unroll
    for (int nt = 0; nt < 8; ++nt) { O[0][nt] = mfma16(vf1[nt], A1, O[0][nt]); O[1][nt] = mfma16(vf1[nt], B1, O[1][nt]); }
}
__device__ __forceinline__ void attn_unit(const Args& a, int l, float lam, float one_m_li, float bsh, int b, int h, int p, unsigned char* lds, int tid, int wave, int lane) {
    asm volatile("" : "+v"(tid), "+v"(lane));
    const bf16* P = (const bf16*)(a.ws + WS_P); const bf16* VT = (const bf16*)(a.ws + WS_VT); bf16* Y = (bf16*)(a.ws + WS_Y);
    bf16* L0 = (bf16*)lds;
    const int r = lane & 15, g = lane >> 4;
    const int qc = 2 * p + (wave >> 2), nt_all = 2 * p + 2;
    const int tq = 128 * p + 16 * wave + r; const size_t rowb = (size_t)b * T; const size_t vtb = ((size_t)b * 4 + h) * 128 * T;
    const float slope2 = exp2f(-2.f * (float)(h + 1)) * 1.4426950408889634f;
    bf16x8* qb = (bf16x8*)(lds + 2 * AT_BUF * 2) + wave * 256 + lane;
#pragma unroll
    for (int c = 0; c < 2; ++c)
#pragma unroll
        for (int ks = 0; ks < 2; ++ks) qb[(c * 2 + ks) * 64] = *(const bf16x8*)(P + (rowb + tq) * NIN + 1024 + (h * 2 + c) * 64 + ks * 32 + g * 8);
    float lsum[2] = {0.f, 0.f};
    f32x4 O[2][8];
#pragma unroll
    for (int nt = 0; nt < 8; ++nt) { O[0][nt] = (f32x4){0.f, 0.f, 0.f, 0.f}; O[1][nt] = O[0][nt]; }
    u32x4 kr[2], vr[2];
    attn_issue(P, VT, rowb, vtb, h, tid, kr, vr);
    attn_store(L0, tid, kr, vr);
    attn_issue(P, VT, rowb + 64, vtb + 64, h, tid, kr, vr);
    __syncthreads();
    for (int kt = 0; kt < nt_all; ++kt) {
        if (kt + 1 < nt_all) { attn_store(L0 + ((kt + 1) & 1) * AT_BUF, tid, kr, vr);
            if (kt + 2 < nt_all) attn_issue(P, VT, rowb + (size_t)(kt + 2) * 64, vtb + (size_t)(kt + 2) * 64, h, tid, kr, vr); }
        if (kt <= qc) attn_tile(L0 + (kt & 1) * AT_BUF, kt, kt == qc, r, g, tq, slope2, bsh, qb, O, lsum);
        __syncthreads();
    }
    float l0 = lsum[0], l1 = lsum[1];
    l0 += shx(l0, 16); l0 += shx(l0, 32); l1 += shx(l1, 16); l1 += shx(l1, 32);
    const float i0 = 1.f / l0, i1 = lam / l1;
    float ss = 0.f;
#pragma unroll
    for (int nt = 0; nt < 8; ++nt)
#pragma unroll
        for (int j = 0; j < 4; ++j) { const float o = O[0][nt][j] * i0 - O[1][nt][j] * i1; O[0][nt][j] = o; ss += o * o; }
    ss += shx(ss, 16); ss += shx(ss, 32);
    const float sc = rsqrtf(ss * (1.f / 128.f) + 1e-6f) * one_m_li;
    const float* sg = inp(a, 23) + l * 128;
    bf16* yp = Y + (rowb + tq) * 1024 + 256 + h * 128;
#pragma unroll
    for (int nt = 0; nt < 8; ++nt) { const int v0 = nt * 16 + 4 * g; const f32x4 gg = *(const f32x4*)(sg + v0);
        u32x2 w; w.x = pk2(O[0][nt][0] * sc * gg[0], O[0][nt][1] * sc * gg[1]); w.y = pk2(O[0][nt][2] * sc * gg[2], O[0][nt][3] * sc * gg[3]);
        *(u32x2*)(yp + v0) = w; }
}
constexpr int SA_CH = 16, SA_NCH = T / SA_CH, SA_TICKS = 132;
constexpr int SA_SCB = 0, SA_KV = 2 * SA_CH * SC_REC * 4, SA_STAGE = 32768, SA_QB = SA_KV + 2 * SA_STAGE;
static_assert(SA_QB + 4 * 4096 <= LDS_CTL, "LDS map of the fused scan/attention phase");
#define SA_BAR() do { asm volatile("s_waitcnt vmcnt(0) lgkmcnt(0)" ::: "memory"); __builtin_amdgcn_s_barrier(); asm volatile("" ::: "memory"); } while (0)
#define SA_BAR_L() do { asm volatile("s_waitcnt lgkmcnt(0)" ::: "memory"); __builtin_amdgcn_s_barrier(); asm volatile("" ::: "memory"); } while (0)
__device__ __forceinline__ void role_bar(volatile LAS unsigned* cnt, unsigned& target, int lane, bool drain_vm) {
    if (drain_vm) asm volatile("s_waitcnt vmcnt(0) lgkmcnt(0)" ::: "memory"); else asm volatile("s_waitcnt lgkmcnt(0)" ::: "memory");
    target += 4u;
    if (lane == 0) __hip_atomic_fetch_add((LAS unsigned*)cnt, 1u, __ATOMIC_RELAXED, __HIP_MEMORY_SCOPE_WORKGROUP);
    unsigned spins = 0u;
    for (;;) { const unsigned v = (unsigned)__builtin_amdgcn_readfirstlane((int)*cnt); if (v >= target || ++spins > (1u << 18)) break; __builtin_amdgcn_s_sleep(1); }
    asm volatile("s_waitcnt lgkmcnt(0)" ::: "memory");
}
struct ScanPre { h16x8 a0, a1, v; f32x4 w; float sc; };
__device__ __forceinline__ void scanpre_issue(ScanPre& p, const h16* S16, const float* SW, const float* SCAL, size_t tok0, int h, int rg, int stid) {
    constexpr size_t ARR = (size_t)M * 256;
    const int ps = stid >> 7, sq = stid & 127, s = sq >> 3, q = sq & 7;
    const h16* bp = S16 + (size_t)(2 * ps) * ARR + (tok0 + s) * 256 + h * 64 + q * 8;
    p.a0 = *(const h16x8*)bp; p.a1 = *(const h16x8*)(bp + ARR);
    p.w = *(const f32x4*)(SW + (tok0 + (stid >> 4)) * 256 + h * 64 + (stid & 15) * 4);
    if (stid < 32) p.v = *(const h16x8*)(S16 + 4 * ARR + (tok0 + (stid >> 1)) * 256 + h * 64 + rg * 16 + (stid & 1) * 8);
    else if (stid < 64) p.sc = SCAL[((tok0 + ((stid - 32) >> 1)) * 4 + h) * 4 + (stid & 1)];
}
__device__ __forceinline__ void scanpre_store(const ScanPre& p, float* dst, int stid) {
    const int ps = stid >> 7, sq = stid & 127, s = sq >> 3, q = sq & 7;
    float* rec = dst + s * SC_REC + q * 8 + (ps ? 192 : 0);
    st8(rec, p.a0); st8(rec + 64, p.a1);
    *(f32x4*)(dst + (stid >> 4) * SC_REC + 128 + (stid & 15) * 4) = p.w;
    if (stid < 32) st8(dst + (stid >> 1) * SC_REC + 320 + (stid & 1) * 8, p.v);
    else if (stid < 64) dst[((stid - 32) >> 1) * SC_REC + 336 + (stid & 1)] = p.sc;
}
__device__ __forceinline__ void attn_dma(const bf16* P, const bf16* VT, size_t rowk, size_t vtk, int h, int aw, int lane, LAS unsigned char* stage) {
    const int q = (lane & 7) ^ ((lane >> 3) & 7);
    const char* ub; unsigned voff, kstride;
    if (aw < 2) { ub = (const char*)(P + rowk * NIN + 1536 + (h * 2 + aw) * 64); voff = (unsigned)(((lane >> 3) * NIN + q * 8) * 2); kstride = 8u * NIN * 2u; }
    else { ub = (const char*)(VT + vtk + (size_t)(aw - 2) * 64 * T); voff = (unsigned)(((lane >> 3) * T + q * 8) * 2); kstride = 8u * T * 2u; }
#pragma unroll
    for (int k = 0; k < 8; ++k)
        __builtin_amdgcn_global_load_lds((const unsigned*)(ub + (size_t)k * kstride + voff), (LAS unsigned*)(stage + aw * 8192 + k * 1024), 16, 0, 0);
}
__device__ __forceinline__ void attn_tile_sw(const unsigned char* Lb, int kt, bool diag, int r, int g, int tq, float slope2, float bsh, const bf16x8* qb, f32x4 (&O)[2][8], float (&lsum)[2]) {
    const int r7 = r & 7;
    bf16x8 kf0[4][2], kf1[4][2];
#pragma unroll
    for (int k4 = 0; k4 < 4; ++k4)
#pragma unroll
        for (int ks = 0; ks < 2; ++ks) { const int off = ((k4 * 16 + r) * 8 + ((ks * 4 + g) ^ r7)) * 16; kf0[k4][ks] = *(const bf16x8*)(Lb + off); kf1[k4][ks] = *(const bf16x8*)(Lb + 8192 + off); }
    bf16x8 qf[2][2];
#pragma unroll
    for (int c = 0; c < 2; ++c)
#pragma unroll
        for (int ks = 0; ks < 2; ++ks) if (c * 2 + ks < 3) qf[c][ks] = qb[(c * 2 + ks) * 64];
    f32x4 init[4];
    if (diag) {
#pragma unroll
        for (int k4 = 0; k4 < 4; ++k4)
#pragma unroll
            for (int j = 0; j < 4; ++j) init[k4][j] = -slope2 * fabsf((float)(tq - (kt * 64 + k4 * 16 + 4 * g + j))) - bsh;
    } else {
        const float base = slope2 * (float)(kt * 64 + 4 * g - tq) - bsh;
#pragma unroll
        for (int k4 = 0; k4 < 4; ++k4)
#pragma unroll
            for (int j = 0; j < 4; ++j) init[k4][j] = fmaf(slope2, (float)(k4 * 16 + j), base);
    }
    __builtin_amdgcn_sched_barrier(0);
    f32x4 s0[4], s1[4];
#pragma unroll
    for (int k4 = 0; k4 < 4; ++k4) { s0[k4] = mfma16(kf0[k4][0], qf[0][0], init[k4]); s1[k4] = mfma16(kf1[k4][0], qf[1][0], init[k4]); s0[k4] = mfma16(kf0[k4][1], qf[0][1], s0[k4]); }
    __builtin_amdgcn_sched_barrier(0);
    bf16x8 vf0[8], vf1[8];
#pragma unroll
    for (int nt = 0; nt < 8; ++nt) vf0[nt] = *(const bf16x8*)(Lb + 16384 + (nt * 16 + r) * 128 + ((g ^ r7) * 16));
    __builtin_amdgcn_sched_barrier(0);
    qf[1][1] = qb[3 * 64];
    float p0 = 0.f, p1 = 0.f;
    unsigned pa[8], pbk[8];
#pragma unroll
    for (int k4 = 0; k4 < 4; ++k4) {
        s1[k4] = mfma16(kf1[k4][1], qf[1][1], s1[k4]);
#pragma unroll
        for (int j = 0; j < 4; ++j) { s0[k4][j] = __builtin_amdgcn_exp2f(s0[k4][j]); p0 += s0[k4][j]; }
        pa[2 * k4] = pg8::cvt_pk_bf16(s0[k4][0], s0[k4][1]); pa[2 * k4 + 1] = pg8::cvt_pk_bf16(s0[k4][2], s0[k4][3]);
        __builtin_amdgcn_sched_barrier(0);
    }
    const bf16x8 A0 = __builtin_bit_cast(bf16x8, (u32x4){pa[0], pa[1], pa[2], pa[3]}), A1 = __builtin_bit_cast(bf16x8, (u32x4){pa[4], pa[5], pa[6], pa[7]});
#pragma unroll
    for (int nt = 0; nt < 8; ++nt) vf1[nt] = *(const bf16x8*)(Lb + 16384 + (nt * 16 + r) * 128 + (((4 + g) ^ r7) * 16));
    __builtin_amdgcn_sched_barrier(0);
#pragma unroll
    for (int k4 = 0; k4 < 4; ++k4) {
#pragma unroll
        for (int q = 0; q < 4; ++q) { const int nt = (4 * k4 + q) & 7; if (k4 < 2) O[0][nt] = mfma16(vf0[nt], A0, O[0][nt]); else O[0][nt] = mfma16(vf1[nt], A1, O[0][nt]); }
#pragma unroll
        for (int j = 0; j < 4; ++j) { s1[k4][j] = __builtin_amdgcn_exp2f(s1[k4][j]); p1 += s1[k4][j]; }
        pbk[2 * k4] = pg8::cvt_pk_bf16(s1[k4][0], s1[k4][1]); pbk[2 * k4 + 1] = pg8::cvt_pk_bf16(s1[k4][2], s1[k4][3]);
        __builtin_amdgcn_sched_barrier(0);
    }
    lsum[0] += p0; lsum[1] += p1;
    const bf16x8 B0 = __builtin_bit_cast(bf16x8, (u32x4){pbk[0], pbk[1], pbk[2], pbk[3]}), B1 = __builtin_bit_cast(bf16x8, (u32x4){pbk[4], pbk[5], pbk[6], pbk[7]});
#pragma unroll
    for (int nt = 0; nt < 8; ++nt) { O[1][nt] = mfma16(vf0[nt], B0, O[1][nt]); O[1][nt] = mfma16(vf1[nt], B1, O[1][nt]); }
}
__device__ __forceinline__ void phase_scan_attn(const Args& a, int l, unsigned char* lds, int tid, int wave, int lane) {
    for (int w0 = blockIdx.x; w0 < 256; w0 += gridDim.x) {
        asm volatile("" : "+v"(tid), "+v"(lane));
        const int w = (gridDim.x == 256) ? ((w0 & 7) * 32 + (w0 >> 3)) : w0;
        const int bh = w >> 2, sub = w & 3, b = bh >> 2, h = bh & 3;
        const size_t tokb = (size_t)b * T;
        volatile LAS unsigned* rcnt = (volatile LAS unsigned*)((LAS unsigned char*)lds + LDS_CTL - 64);
        if (tid < 8) rcnt[tid] = 0u;
        __syncthreads();
        unsigned rtarget = 0u;
        if (wave < 4) {
            const h16* S16 = (const h16*)(a.ws + WS_S16); const float* SW = (const float*)(a.ws + WS_SW); const float* SCAL = (const float*)(a.ws + WS_SCAL); float* YR = (float*)(a.ws + WS_YR);
            float* scb = (float*)(lds + SA_SCB);
            const int rg = sub, rowl = wave * 4 + (lane >> 4), jq = lane & 15;
            ScanPre pre; pre.a0 = (h16x8)(h16)0.f; pre.a1 = pre.a0; pre.v = pre.a0; pre.w = (f32x4){0.f, 0.f, 0.f, 0.f}; pre.sc = 0.f;
            scanpre_issue(pre, S16, SW, SCAL, tokb, h, rg, tid); scanpre_store(pre, scb, tid);
            role_bar(rcnt, rtarget, lane, false);
            f32x4 S = {0.f, 0.f, 0.f, 0.f}; float yk = 0.f;
            float* yout = YR + (tokb + jq) * 256 + h * 64 + rg * 16 + rowl;
#pragma unroll 1
            for (int i = 0; i < SA_TICKS; ++i) {
                if (i < SA_NCH) {
                    if (i + 1 < SA_NCH) scanpre_issue(pre, S16, SW, SCAL, tokb + (size_t)(i + 1) * SA_CH, h, rg, tid);
                    const float* src = scb + (i & 1) * SA_CH * SC_REC;
                    ScanOps A, B;
                    scan_ld(A, src, jq, rowl);
#pragma unroll
                    for (int s_ = 0; s_ < SA_CH; s_ += 2) {
                        scan_ld(B, src + (s_ + 1) * SC_REC, jq, rowl);
                        scan_step(S, yk, A, jq, s_);
                        if (s_ + 2 < SA_CH) scan_ld(A, src + (s_ + 2) * SC_REC, jq, rowl);
                        scan_step(S, yk, B, jq, s_ + 1);
                    }
                    yout[(size_t)(i * SA_CH) * 256] = yk;
                    if (i + 1 < SA_NCH) scanpre_store(pre, scb + ((i + 1) & 1) * SA_CH * SC_REC, tid);
                }
                role_bar(rcnt, rtarget, lane, false);
            }
        } else {
            const bf16* P = (const bf16*)(a.ws + WS_P); const bf16* VT = (const bf16*)(a.ws + WS_VT); bf16* Y = (bf16*)(a.ws + WS_Y);
            float s1 = 0.f, s2 = 0.f, mq = 0.f, mk = 0.f;
            for (int i = 0; i < 64; ++i) { s1 += inp(a, 19)[l * 64 + i] * inp(a, 20)[l * 64 + i]; s2 += inp(a, 21)[l * 64 + i] * inp(a, 22)[l * 64 + i];
                mq = fmaxf(mq, fabsf(inp(a, 17)[l * 64 + i])); mk = fmaxf(mk, fabsf(inp(a, 18)[l * 64 + i])); }
            const float li = __builtin_bit_cast(float, __builtin_amdgcn_readfirstlane(l == 0 ? 0x3e4ccccd : 0x3eb60549));
            const float lam = __builtin_bit_cast(float, __builtin_amdgcn_readfirstlane(__builtin_bit_cast(int, expf(s1) - expf(s2) + li))), one_m_li = 1.f - li;
            const float bsh = __builtin_bit_cast(float, __builtin_amdgcn_readfirstlane(__builtin_bit_cast(int, 8.f * mq * mk * 1.4426950408889634f)));
            const int aw = wave - 4, r = lane & 15, g = lane >> 4;
            const size_t vtb = ((size_t)b * 4 + h) * 128 * T;
            const float slope2 = exp2f(-2.f * (float)(h + 1)) * 1.4426950408889634f;
            LAS unsigned char* kv = (LAS unsigned char*)lds + SA_KV;
            bf16x8* qb = (bf16x8*)(lds + SA_QB) + aw * 256 + lane;
            const float* sg = inp(a, 23) + l * 128;
            attn_dma(P, VT, tokb, vtb, h, aw, lane, kv);
            role_bar(rcnt + 4, rtarget, lane, true);
            int ti = 0;
#pragma unroll 1
            for (int u = 0; u < 8; ++u) {
                const int pq = sub * 4 + (u >> 1), qc = (u & 1) ? 31 - pq : pq;
                const int pqn = sub * 4 + ((u + 1) >> 1);
                const int tq = qc * 64 + aw * 16 + r;
#pragma unroll
                for (int c = 0; c < 2; ++c)
#pragma unroll
                    for (int ks = 0; ks < 2; ++ks) qb[(c * 2 + ks) * 64] = *(const bf16x8*)(P + (tokb + tq) * NIN + 1024 + (h * 2 + c) * 64 + ks * 32 + g * 8);
                float lsum[2] = {0.f, 0.f};
                f32x4 O[2][8];
#pragma unroll
                for (int nt = 0; nt < 8; ++nt) { O[0][nt] = (f32x4){0.f, 0.f, 0.f, 0.f}; O[1][nt] = O[0][nt]; }
#pragma unroll 1
                for (int kt = 0; kt <= qc; ++kt) {
                    const int ktn = kt < qc ? kt + 1 : 0;
                    if (kt < qc || u < 7) attn_dma(P, VT, tokb + (size_t)ktn * 64, vtb + (size_t)ktn * 64, h, aw, lane, kv + ((ti + 1) & 1) * SA_STAGE);
                    attn_tile_sw((const unsigned char*)lds + SA_KV + (ti & 1) * SA_STAGE, kt, kt == qc, r, g, tq, slope2, bsh, qb, O, lsum);
                    if (kt == qc) {
                        float l0 = lsum[0], l1 = lsum[1];
                        l0 += shx(l0, 16); l0 += shx(l0, 32); l1 += shx(l1, 16); l1 += shx(l1, 32);
                        const float i0 = 1.f / l0, i1 = lam / l1;
                        float ss = 0.f;
#pragma unroll
                        for (int nt = 0; nt < 8; ++nt)
#pragma unroll
                            for (int j = 0; j < 4; ++j) { const float o = O[0][nt][j] * i0 - O[1][nt][j] * i1; O[0][nt][j] = o; ss += o * o; }
                        ss += shx(ss, 16); ss += shx(ss, 32);
                        const float sc = rsqrtf(ss * (1.f / 128.f) + 1e-6f) * one_m_li;
                        bf16* yp = Y + (tokb + tq) * 1024 + 256 + h * 128;
#pragma unroll
                        for (int nt = 0; nt < 8; ++nt) { const int v0 = nt * 16 + 4 * g; const f32x4 gg = *(const f32x4*)(sg + v0);
                            u32x2 wv; wv.x = pk2(O[0][nt][0] * sc * gg[0], O[0][nt][1] * sc * gg[1]); wv.y = pk2(O[0][nt][2] * sc * gg[2], O[0][nt][3] * sc * gg[3]);
                            *(u32x2*)(yp + v0) = wv; }
                    }
                    role_bar(rcnt + 4, rtarget, lane, true); ++ti;
                }
                (void)pqn;
            }
        }
        __syncthreads();
    }
}
__device__ __forceinline__ void conv_unit(const Args& a, int l, int b, int t0, unsigned char* lds, int tid, int wave, int lane) {
    const bf16* P = (const bf16*)(a.ws + WS_P); bf16* Y = (bf16*)(a.ws + WS_Y);
    constexpr int HP = 264, OP = 260;
    bf16* hb = (bf16*)lds;
    float* ob = (float*)(lds + 94 * HP * 2);
    asm volatile("" : "+v"(tid), "+v"(lane));
    const size_t rowb = (size_t)b * T;
    for (int ch = tid; ch < 94 * 32; ch += 512) { const int rr = ch >> 5, cc = ch & 31; const int t = t0 - 30 + rr;
        u32x4 v = {0u, 0u, 0u, 0u};
        if (t >= 0) v = *(const u32x4*)(P + (rowb + t) * NIN + 2560 + cc * 8);
        *(u32x4*)(hb + rr * HP + cc * 8) = v; }
    __syncthreads();
    const int cp = tid & 127, tg = tid >> 7;
    const float* cw = inp(a, 24) + (size_t)l * 31 * 256 + 2 * cp;
    const f32x2 cb = *(const f32x2*)(inp(a, 25) + l * 256 + 2 * cp);
    float acc0[16], acc1[16];
#pragma unroll
    for (int i = 0; i < 16; ++i) { acc0[i] = cb[0]; acc1[i] = cb[1]; }
    f32x2 wv[31];
#pragma unroll
    for (int w = 0; w < 31; ++w) wv[w] = *(const f32x2*)(cw + w * 256);
#pragma unroll
    for (int rho = 0; rho < 46; ++rho) { const unsigned hv = *(const unsigned*)(hb + (tg * 16 + rho) * HP + 2 * cp); const float h0 = bflo(hv), h1 = bfhi(hv);
#pragma unroll
        for (int i = 0; i < 16; ++i) { const int w = rho - i; if (w >= 0 && w < 31) { acc0[i] += h0 * wv[w][0]; acc1[i] += h1 * wv[w][1]; } } }
#pragma unroll
    for (int i = 0; i < 16; ++i) *(f32x2*)(ob + (tg * 16 + i) * OP + 2 * cp) = (f32x2){acc0[i], acc1[i]};
    __syncthreads();
    const f32x4 lw = *(const f32x4*)(inp(a, 26) + l * 256 + 4 * lane), lb = *(const f32x4*)(inp(a, 27) + l * 256 + 4 * lane);
    for (int i = 0; i < 8; ++i) { const int tok = wave * 8 + i;
        const f32x4 x = *(const f32x4*)(ob + tok * OP + 4 * lane);
        const float mu = wave_sum((x[0] + x[1]) + (x[2] + x[3])) * (1.f / 256.f);
        const f32x4 d = x - mu;
        const float var = wave_sum((d[0] * d[0] + d[1] * d[1]) + (d[2] * d[2] + d[3] * d[3])) * (1.f / 256.f);
        const f32x4 y = d * rsqrtf(var + 1e-5f) * lw + lb;
        u32x2 w; w.x = pk2(y[0] * sigmoidf_(y[0]), y[1] * sigmoidf_(y[1])); w.y = pk2(y[2] * sigmoidf_(y[2]), y[3] * sigmoidf_(y[3]));
        *(u32x2*)(Y + (rowb + t0 + tok) * 1024 + 768 + 4 * lane) = w; }
    __syncthreads();
}
__device__ __forceinline__ void phase_mix(const Args& a, int l, unsigned char* lds, int tid, int wave, int lane) {
    for (int u = blockIdx.x; u < 512; u += gridDim.x) conv_unit(a, l, u >> 5, (u & 31) * 64, lds, tid, wave, lane);
    const float* YR = (const float*)(a.ws + WS_YR); const h16* SV = (const h16*)(a.ws + WS_S16) + 4 * (size_t)M * 256; const bf16* G = (const bf16*)(a.ws + WS_G);
    const float* SCAL = (const float*)(a.ws + WS_SCAL); bf16* Y = (bf16*)(a.ws + WS_Y);
    const f32x4 lw = *(const f32x4*)(inp(a, 15) + l * 256 + 4 * lane), lb = *(const f32x4*)(inp(a, 16) + l * 256 + 4 * lane);
    const int gw = blockIdx.x * 8 + wave, NGW = gridDim.x * 8;
#pragma unroll 4
    for (int tok = gw; tok < M; tok += NGW) {
        const f32x4 y = *(const f32x4*)(YR + (size_t)tok * 256 + 4 * lane);
        const float mu = rowsum16((y[0] + y[1]) + (y[2] + y[3])) * (1.f / 64.f);
        const f32x4 d = y - mu;
        const float var = rowsum16((d[0] * d[0] + d[1] * d[1]) + (d[2] * d[2] + d[3] * d[3])) * (1.f / 64.f);
        const f32x4 yn = d * rsqrtf(var + 64e-5f) * lw + lb;
        const float bn = SCAL[((size_t)tok * 4 + (lane >> 4)) * 4 + 2];
        const h16x4 v = *(const h16x4*)(SV + (size_t)tok * 256 + 4 * lane);
        const u32x2 gv = *(const u32x2*)(G + (size_t)tok * 256 + 4 * lane);
        u32x2 w; w.x = pk2((yn[0] + bn * (float)v[0]) * bflo(gv.x), (yn[1] + bn * (float)v[1]) * bfhi(gv.x));
        w.y = pk2((yn[2] + bn * (float)v[2]) * bflo(gv.y), (yn[3] + bn * (float)v[3]) * bfhi(gv.y));
        *(u32x2*)(Y + (size_t)tok * 1024 + 4 * lane) = w;
    }
}

#define XB_TMO      128
#define XB_XCNT(j)  (256  + 64 * (j))
#define XB_XSUB(j)  (1280 + 64 * (j))
#define XB_XGEN(j)  (2304 + 64 * (j))
#define XB_TOP      3328
#define XB_TOPGEN   3392
#define XCD_BAR_WORDS 3456
#define XB_SPIN_CAP (1u << 18)

__device__ __forceinline__ unsigned xb_ld(unsigned* p)              { return __hip_atomic_load(p, __ATOMIC_RELAXED, __HIP_MEMORY_SCOPE_AGENT); }
__device__ __forceinline__ unsigned xb_add(unsigned* p, unsigned v) { return __hip_atomic_fetch_add(p, v, __ATOMIC_RELAXED, __HIP_MEMORY_SCOPE_AGENT); }
__device__ __forceinline__ unsigned xb_xcc_id() { return (unsigned)__builtin_amdgcn_s_getreg((3 << 11) | 20) & 0xFu; }
#define XB_SPIN(cond, bar) do { unsigned _sp = 0; while (cond) { __builtin_amdgcn_s_sleep(1); \
    if ((++_sp & 255u) == 0u) { if (xb_ld(&(bar)[XB_TMO])) break; if (_sp > XB_SPIN_CAP) { atomicAdd(&(bar)[XB_TMO], 1u); break; } } } } while (0)

struct XcdBarrier {
    unsigned* bar; unsigned x;
    volatile LAS unsigned* st;
};

__device__ __forceinline__ XcdBarrier xcd_barrier_post(unsigned* bar, volatile LAS unsigned* st) {
    XcdBarrier b; b.bar = bar; b.x = xb_xcc_id(); b.st = st;
    if (threadIdx.x == 0) (void)xb_add(&bar[XB_XCNT(b.x)], 1u);
    return b;
}
__device__ __forceinline__ void xcd_barrier_complete(unsigned* bar, unsigned x, unsigned& nloc, unsigned& nx) {
    const unsigned G = gridDim.x * gridDim.y * gridDim.z;
    unsigned sum, cnt, mine, sp = 0u;
    for (;;) {
        sum = 0u; cnt = 0u; mine = 0u;
#pragma unroll
        for (unsigned j = 0; j < 16; ++j) { const unsigned c = xb_ld(&bar[XB_XCNT(j)]); sum += c; cnt += (c > 0u) ? 1u : 0u; mine = (j == x) ? c : mine; }
        if (sum == G) break;
        __builtin_amdgcn_s_sleep(1);
        if ((++sp & 255u) == 0u) { if (xb_ld(&bar[XB_TMO])) break; if (sp > XB_SPIN_CAP) { atomicAdd(&bar[XB_TMO], 1u); break; } }
    }
    nloc = mine > 0u ? mine : 1u; nx = cnt > 0u ? cnt : 1u;
}

__device__ __forceinline__ void xcd_barrier(const XcdBarrier& b) {
    asm volatile("s_waitcnt vmcnt(0)" ::: "memory");
    __syncthreads();
    if (threadIdx.x == 0) {
        unsigned* bar = b.bar;
        __builtin_amdgcn_s_waitcnt(0);
        unsigned nloc = b.st[0], nx = b.st[1];
        if (nloc == 0u) { xcd_barrier_complete(bar, b.x, nloc, nx); b.st[0] = nloc; b.st[1] = nx; }
        const unsigned old = xb_add(&bar[XB_XSUB(b.x)], 1u);
        const unsigned gen = old / nloc;
        if (old + 1u == (gen + 1u) * nloc) {
            __builtin_amdgcn_fence(__ATOMIC_RELEASE, "agent");
            asm volatile("s_waitcnt vmcnt(0)" ::: "memory");
            const unsigned og = xb_add(&bar[XB_TOP], 1u);
            const unsigned tg = og / nx;
            if (og + 1u == (tg + 1u) * nx) xb_add(&bar[XB_TOPGEN], 1u);
            else XB_SPIN(xb_ld(&bar[XB_TOPGEN]) == tg, bar);
            __builtin_amdgcn_fence(__ATOMIC_ACQUIRE, "agent");
            xb_add(&bar[XB_XGEN(b.x)], 1u);
            asm volatile("s_waitcnt vmcnt(0)" ::: "memory");
        } else {
            XB_SPIN(xb_ld(&bar[XB_XGEN(b.x)]) == gen, bar);
            __builtin_amdgcn_fence(__ATOMIC_ACQUIRE, "agent");
            asm volatile("s_waitcnt vmcnt(0)" ::: "memory");
        }
    }
    __syncthreads();
}

__global__ void __launch_bounds__(512, 2) mk_fwd(Args a) {
    extern __shared__ __attribute__((aligned(16))) unsigned char lds[];
    cg::grid_group grid = cg::this_grid();
    const int wave_s = __builtin_amdgcn_readfirstlane((int)threadIdx.x >> 6);
#define TIDS int lane_ = __builtin_amdgcn_mbcnt_hi(~0u, __builtin_amdgcn_mbcnt_lo(~0u, 0u)); asm volatile("" : "+v"(lane_)); const int lane = lane_, wave = wave_s; int tid = wave * 64 + lane; (void)lane; (void)wave; (void)tid
    unsigned* barw = (unsigned*)(a.ws + WS_BAR);
    if (a.ph_lo == 0 && blockIdx.x == 0) for (int i = threadIdx.x; i < XCD_BAR_WORDS; i += 512) barw[i] = 0u;
    if (threadIdx.x < 2) ((volatile LAS unsigned*)(lds + LDS_CTL))[threadIdx.x] = 0u;
    __syncthreads();
    XcdBarrier xbar; xbar.bar = barw; xbar.x = 0; xbar.st = (volatile LAS unsigned*)(lds + LDS_CTL);
    bool posted = false;
    if (a.ph_lo == 0 && a.ph_hi > 1) { grid.sync(); xbar = xcd_barrier_post(barw, (volatile LAS unsigned*)(lds + LDS_CTL)); posted = true; }
#pragma unroll 1
    for (int ph = a.ph_lo; ph < a.ph_hi; ++ph) {
        if (ph == 0) { { TIDS; phase_weights(a, lds, wave, lane); } __syncthreads(); { TIDS; phase_ada(a, lds, tid, wave, lane); } }
        else {
            const int l = (ph - 1) / 9, k = (ph - 1) % 9;
            const float* modl = (const float*)(a.ws + WS_MOD) + (size_t)l * 16 * 6144;
            if (k == 6 || (k == 0 && l == 1)) continue;
            if (k == 1 || k == 5 || k == 7 || k == 8) {
                const unsigned char* wb = a.ws + WS_WB + (size_t)l * WB_LAYER;
                pg8::Gemm g; pg8::EpiDyn E; E.O = nullptr; E.ldc = 0; E.base = nullptr; E.out = nullptr; E.gate = nullptr;
                E.ssq_in = nullptr; E.bias = nullptr; E.bstride = 0; E.rtab = nullptr; E.XS = nullptr; E.ssq_out = nullptr; E.gn = nullptr; E.scv = nullptr;
                const float* BIAS = (const float*)(a.ws + WS_BIAS);
                if (k == 1) { g.A = (const bf16*)(a.ws + WS_XN); g.Bt = (const bf16*)(wb + WB_IN); g.N = NIN; g.K = D; E.kind = 0; E.O = (bf16*)(a.ws + WS_P); E.ldc = NIN;
                    if (l == 1) { E.ssq_in = (const float*)(a.ws + WS_SSQA); E.bias = BIAS; E.bstride = NIN; } }
                else if (k == 5) { g.A = (const bf16*)(a.ws + WS_Y); g.Bt = (const bf16*)(wb + WB_OUT); g.N = D; g.K = D; E.kind = 2; E.base = l == 0 ? inp(a, 0) : a.out; E.out = a.out; E.gate = modl + 2048;
                    E.XS = (bf16*)(a.ws + WS_XN); E.ssq_out = (float*)(a.ws + WS_SSQB); E.gn = inp(a, 29) + l * 1024; E.scv = modl + 4096; }
                else if (k == 7) { g.A = (const bf16*)(a.ws + WS_XN); g.Bt = (const bf16*)(wb + WB_W1); g.N = FF; g.K = D; E.kind = 1; E.O = (bf16*)(a.ws + WS_H); E.ldc = FF;
                    E.ssq_in = (const float*)(a.ws + WS_SSQB); E.bias = BIAS + 16 * NIN + (size_t)l * 16 * FF; E.bstride = FF; }
                else { g.A = (const bf16*)(a.ws + WS_H); g.Bt = (const bf16*)(wb + WB_W2); g.N = D; g.K = FF; E.kind = 2; E.base = a.out; E.out = a.out; E.gate = modl + 5120;
                    if (l == 0) { E.XS = (bf16*)(a.ws + WS_XN); E.ssq_out = (float*)(a.ws + WS_SSQA); E.gn = inp(a, 4) + 1024; E.scv = (const float*)(a.ws + WS_MOD) + (size_t)16 * 6144 + 1024; } }
                g.M = M;
                pg8::StaticOrder S; S.init(M, g.N, gridDim.x, blockIdx.x);
                E.rtab = (const LAS float*)((LAS unsigned char*)lds + 131072);
                if (E.ssq_in) { TIDS;
                    LAS float* rt = (LAS float*)((LAS unsigned char*)lds + 131072);
                    for (int idx = tid; idx < 8 * 256; idx += 512) { pg8::Unit u_; if (!S.next(idx >> 8, u_)) break;
                        const f32x4* sp = (const f32x4*)(E.ssq_in + (size_t)(u_.pm * 256 + (idx & 255)) * 16); const f32x4 t = (sp[0] + sp[1]) + (sp[2] + sp[3]);
                        rt[idx] = rsqrtf(((t[0] + t[1]) + (t[2] + t[3])) * (1.f / 1024.f) + 1e-6f); }
                    __syncthreads(); }
                { TIDS; pg8::gemm_phase<pg8::EpiDyn, pg8::StaticOrder, true, true>((LAS unsigned char*)lds, g, S, E, tid); }
            }
            else if (k == 0) { TIDS; phase_xn(inp(a, 0), inp(a, 4), modl, 0, 1024, (bf16*)(a.ws + WS_XN), wave, lane); phase_bias(a, wave, lane); }
            else if (k == 2) { TIDS; phase_premix(a, l, lds, tid, wave, lane); }
            else if (k == 3) { TIDS; phase_scan_attn(a, l, lds, tid, wave, lane); }
            else { TIDS; phase_mix(a, l, lds, tid, wave, lane); }
        }
        if (ph + 1 < a.ph_hi) {
            if (!posted) { grid.sync(); xbar = xcd_barrier_post(barw, (volatile LAS unsigned*)(lds + LDS_CTL)); posted = true; }
            else xcd_barrier(xbar);
        }
    }
}

#ifndef MK_MULTI
#define MK_MULTI 0
#endif
extern "C" void kernel_launch(void* const* d_in, const int* in_sizes, int n_in, void* d_out, int out_size, void* d_ws, size_t ws_size, hipStream_t stream) {
    static int grid = 0;
    if (grid == 0) {
        if (n_in != 32 || out_size != M * D || ws_size < WS_END) { fprintf(stderr, "kernel_launch: unexpected shapes (n_in %d out %d ws %zu)\n", n_in, out_size, ws_size); grid = -1; return; }
        int dev = 0, cus = 0, per_cu = 0;
        (void)hipGetDevice(&dev); (void)hipDeviceGetAttribute(&cus, hipDeviceAttributeMultiprocessorCount, dev);
        (void)hipFuncSetAttribute((const void*)mk_fwd, hipFuncAttributeMaxDynamicSharedMemorySize, LDS_BYTES);
        (void)hipOccupancyMaxActiveBlocksPerMultiprocessor(&per_cu, (const void*)mk_fwd, 512, LDS_BYTES);
        if (per_cu < 1) { fprintf(stderr, "kernel_launch: occupancy query says %d blocks per CU\n", per_cu); per_cu = 1; }
        grid = cus * per_cu;
        (void)hipGetLastError();
    }
    if (grid < 0) return;
    Args a{};
    for (int i = 0; i < 32; ++i) a.in[i] = (const float*)d_in[i];
    a.out = (float*)d_out; a.ws = (unsigned char*)d_ws;
#if MK_MULTI
    for (int p = 0; p < 19; ++p) { a.ph_lo = p; a.ph_hi = p + 1; hipLaunchKernelGGL(mk_fwd, dim3(grid), dim3(512), LDS_BYTES, stream, a); }
#else
    a.ph_lo = 0; a.ph_hi = 19;
    void* args[] = {&a};
    hipError_t e = hipLaunchCooperativeKernel((const void*)mk_fwd, dim3(grid), dim3(512), args, LDS_BYTES, stream);
    if (e != hipSuccess) fprintf(stderr, "cooperative launch failed: %s (grid %d)\n", hipGetErrorString(e), grid);
#endif
}
```

```cpp
#include <hip/hip_runtime.h>
#include <hip/hip_cooperative_groups.h>
#include <hip/hip_fp16.h>
#include <cstdio>
#include <cstdint>
namespace cg = cooperative_groups;
namespace pg8 {
#define PG8_LAS __attribute__((address_space(3)))
typedef unsigned short bf16_t;
typedef short bf16x8 __attribute__((ext_vector_type(8)));
typedef float f32x4 __attribute__((ext_vector_type(4)));
typedef unsigned u32x4 __attribute__((ext_vector_type(4)));
constexpr int BM = 256, BK = 64, HALF = 128, HTB = HALF * BK * 2  , STAGE_BYTES = 8 * HTB, NXCD = 8, WGM = 8;

__host__ __device__ __forceinline__ int lds_byte(int r, int c) { const int st = (r >> 4) * 2 + (c >> 5), rr = r & 15, cc = c & 31, ob = rr * 64 + cc * 2; return st * 1024 + (ob ^ (((ob >> 9) & 1) << 5)); }
__host__ __device__ __forceinline__ void stage_rc(int b, int& R, int& C) { const int st = b / 1024, sb = b % 1024, swz = sb ^ (((sb >> 9) & 1) << 5); R = (st >> 1) * 16 + swz / 64; C = (st & 1) * 32 + (swz % 64) / 2; }
__host__ __device__ __forceinline__ int perm32(int rho) { const int n = rho >> 4, i = rho & 15; return 8 * (i >> 2) + 4 * n + (i & 3); }

struct Unit { int pm, pn; };
struct Gemm { const bf16_t* A; const bf16_t* Bt; int M, N, K; };

struct StaticOrder {
    int nM, nN, nwg, G, c;
    __host__ __device__ void init(int M, int N, int G_, int c_) { nM = M / BM; nN = N / BM; nwg = nM * nN; G = G_; c = c_; }
    __host__ __device__ bool next(int i, Unit& u) const {
        const long L = (long)i * G + c; if (L >= nwg) return false;
        int wgid = (int)L; { const int q = nwg / NXCD, r = nwg % NXCD, xcd = wgid % NXCD, off = wgid / NXCD; wgid = (xcd < r ? xcd * (q + 1) : r * (q + 1) + (xcd - r) * q) + off; }
        const int nig = WGM * nN, gid = wgid / nig, fm = gid * WGM, gsz = (nM - fm) < WGM ? (nM - fm) : WGM;
        u.pm = fm + ((wgid % nig) % gsz); u.pn = (wgid % nig) / gsz; return true;
    }
    __device__ __forceinline__ void a_ready(const Unit&) const {}
    __device__ __forceinline__ void done(const Unit&) const {}
};

typedef __bf16 bf16x2_t __attribute__((ext_vector_type(2)));
typedef float f32x2_t __attribute__((ext_vector_type(2)));
__device__ __forceinline__ unsigned cvt_pk_bf16(float lo, float hi) { const f32x2_t v = {lo, hi}; return __builtin_bit_cast(unsigned, __builtin_convertvector(v, bf16x2_t)); }
template <int ACT  > struct EpiAct {
    static constexpr bool PERM = true, AFTER_DRAIN = false;
    bf16_t* O; int ldc;
    __device__ __forceinline__ void operator()(const f32x4 (&acc)[2][2][4][2], const Unit& u, int wr, int wc, int fr, int fq) const {
        const int row0 = u.pm * BM + wr * 64 + fr; const int col0 = u.pn * BM + wc * 32 + 8 * fq;
#pragma unroll
        for (int ai = 0; ai < 2; ++ai)
#pragma unroll
            for (int m = 0; m < 4; ++m) { bf16_t* rowp = O + (size_t)(row0 + ai * HALF + m * 16) * ldc + col0;
#pragma unroll
                for (int bj = 0; bj < 2; ++bj) { f32x4 v0 = acc[ai][bj][m][0], v1 = acc[ai][bj][m][1];
                    if (ACT == 1) {
#pragma unroll
                        for (int e = 0; e < 4; ++e) { float a = fmaxf(v0[e], 0.f), b = fmaxf(v1[e], 0.f); v0[e] = a * a; v1[e] = b * b; } }
                    u32x4 w; w.x = cvt_pk_bf16(v0[0], v0[1]); w.y = cvt_pk_bf16(v0[2], v0[3]); w.z = cvt_pk_bf16(v1[0], v1[1]); w.w = cvt_pk_bf16(v1[2], v1[3]);
                    *(u32x4*)(rowp + bj * HALF) = w; } }
    }
};
struct EpiRes {
    static constexpr bool PERM = false, AFTER_DRAIN = false;
    const float* base; float* out; const float* gate;
    __device__ __forceinline__ void operator()(const f32x4 (&acc)[2][2][4][2], const Unit& u, int wr, int wc, int fr, int fq) const {
        const int col0 = u.pn * BM + wc * 32 + 4 * fq;
        const float* gp = gate + (size_t)((u.pm * BM) >> 11) * 6144 + col0;
        f32x4 gv[2][2];
#pragma unroll
        for (int bj = 0; bj < 2; ++bj)
#pragma unroll
            for (int n = 0; n < 2; ++n) gv[bj][n] = *(const f32x4*)(gp + bj * HALF + n * 16);
#pragma unroll
        for (int ai = 0; ai < 2; ++ai)
#pragma unroll
            for (int m = 0; m < 4; ++m) { const size_t off = (size_t)(u.pm * BM + ai * HALF + wr * 64 + m * 16 + fr) * 1024 + col0;
#pragma unroll
                for (int bj = 0; bj < 2; ++bj)
#pragma unroll
                    for (int n = 0; n < 2; ++n) { const f32x4 bs = *(const f32x4*)(base + off + bj * HALF + n * 16);
                        *(f32x4*)(out + off + bj * HALF + n * 16) = bs + gv[bj][n] * acc[ai][bj][m][n]; } }
    }
};
typedef unsigned u32x2_ __attribute__((ext_vector_type(2)));
__device__ __forceinline__ float shx_(float v, int m) { int l = __builtin_amdgcn_mbcnt_hi(~0u, __builtin_amdgcn_mbcnt_lo(~0u, 0u)); asm volatile("" : "+v"(l));
    return __builtin_bit_cast(float, __builtin_amdgcn_ds_bpermute((l ^ m) << 2, __builtin_bit_cast(int, v))); }
struct EpiDyn {
    static constexpr bool PERM = true, AFTER_DRAIN = false;
    int kind; bf16_t* O; int ldc; const float* base; float* out; const float* gate;
    const float* ssq_in; const float* bias; int bstride; const PG8_LAS float* rtab;
    bf16_t* XS; float* ssq_out; const float* gn; const float* scv;
    __device__ __forceinline__ void operator()(const f32x4 (&acc)[2][2][4][2], const Unit& u, int wr, int wc, int fr, int fq, int ui) const {
        const int row0 = u.pm * BM + wr * 64 + fr; const int col0 = u.pn * BM + wc * 32 + 8 * fq; const int b = (u.pm * BM) >> 11;
        if (kind < 2) {
            f32x4 bv[2][2];
#pragma unroll
            for (int bj = 0; bj < 2; ++bj)
#pragma unroll
                for (int n = 0; n < 2; ++n) bv[bj][n] = ssq_in ? *(const f32x4*)(bias + (size_t)b * bstride + col0 + bj * HALF + n * 4) : (f32x4){0.f, 0.f, 0.f, 0.f};
#pragma unroll
            for (int ai = 0; ai < 2; ++ai)
#pragma unroll
                for (int m = 0; m < 4; ++m) { const int row = row0 + ai * HALF + m * 16; bf16_t* rowp = O + (size_t)row * ldc + col0;
                    float rstd = 1.f;
                    if (ssq_in) rstd = rtab[ui * 256 + wr * 64 + fr + ai * HALF + m * 16];
#pragma unroll
                    for (int bj = 0; bj < 2; ++bj) { f32x4 v0 = acc[ai][bj][m][0] * rstd + bv[bj][0], v1 = acc[ai][bj][m][1] * rstd + bv[bj][1];
                        if (kind == 1) {
#pragma unroll
                            for (int e = 0; e < 4; ++e) { float a = fmaxf(v0[e], 0.f), c = fmaxf(v1[e], 0.f); v0[e] = a * a; v1[e] = c * c; } }
                        u32x4 w; w.x = cvt_pk_bf16(v0[0], v0[1]); w.y = cvt_pk_bf16(v0[2], v0[3]); w.z = cvt_pk_bf16(v1[0], v1[1]); w.w = cvt_pk_bf16(v1[2], v1[3]);
                        *(u32x4*)(rowp + bj * HALF) = w; } }
        } else {
            const float* gp = gate + (size_t)b * 6144 + col0;
            f32x4 gv[2][2], gm[2][2];
#pragma unroll
            for (int bj = 0; bj < 2; ++bj)
#pragma unroll
                for (int n = 0; n < 2; ++n) { gv[bj][n] = *(const f32x4*)(gp + bj * HALF + n * 4);
                    gm[bj][n] = XS ? *(const f32x4*)(gn + col0 + bj * HALF + n * 4) * (*(const f32x4*)(scv + (size_t)b * 6144 + col0 + bj * HALF + n * 4) + 1.f) : (f32x4){0.f, 0.f, 0.f, 0.f}; }
#pragma unroll
            for (int aim = 0; aim < 4; ++aim) { const int ai = aim >> 1, m0 = (aim & 1) * 2;
                f32x4 bs[4][2][2];
#pragma unroll
                for (int m = m0; m < m0 + 2; ++m) { const size_t off = (size_t)(row0 + ai * HALF + m * 16) * 1024 + col0;
#pragma unroll
                    for (int bj = 0; bj < 2; ++bj)
#pragma unroll
                        for (int n = 0; n < 2; ++n) bs[m][bj][n] = *(const f32x4*)(base + off + bj * HALF + n * 4); }
                asm volatile("" ::: "memory");
#pragma unroll
                for (int m = m0; m < m0 + 2; ++m) { const int row = row0 + ai * HALF + m * 16; const size_t off = (size_t)row * 1024 + col0; float sq = 0.f;
#pragma unroll
                    for (int bj = 0; bj < 2; ++bj)
#pragma unroll
                        for (int n = 0; n < 2; ++n) {
                            const f32x4 o = bs[m][bj][n] + gv[bj][n] * acc[ai][bj][m][n];
                            *(f32x4*)(out + off + bj * HALF + n * 4) = o;
                            if (XS) { sq += (o[0] * o[0] + o[1] * o[1]) + (o[2] * o[2] + o[3] * o[3]); const f32x4 x = o * gm[bj][n];
                                u32x2_ w; w.x = cvt_pk_bf16(x[0], x[1]); w.y = cvt_pk_bf16(x[2], x[3]); *(u32x2_*)(XS + off + bj * HALF + n * 4) = w; } }
                    if (XS) { sq += shx_(sq, 16); sq += shx_(sq, 32); if (fq == 0) ssq_out[(size_t)row * 16 + u.pn * 4 + wc] = sq; } }
                asm volatile("" ::: "memory");
            }
        }
    }
};
template <class Epi, class Sched, bool ALIGN_EPI = false, bool SP2 = false>
__device__ __forceinline__ void gemm_phase(PG8_LAS unsigned char* lds, const Gemm g, const Sched& S, const Epi& E, const int tid_in) {
    int tid = tid_in; asm volatile("" : "+v"(tid));
    const int wid = __builtin_amdgcn_readfirstlane(tid >> 6), lane = tid & 63, wr = wid >> 2, wc = wid & 3, fr = lane & 15, fq = lane >> 4;
    const int K = g.K, nt = K / BK;
    unsigned voffA[2], voffB[2];
#pragma unroll
    for (int i = 0; i < 2; ++i) { int R, C; stage_rc(tid * 16 + i * 8192, R, C); const int Rb = Epi::PERM ? ((R & ~31) + perm32(R & 31)) : R;
        voffA[i] = (unsigned)(R * K + C) * 2u; voffB[i] = (unsigned)(Rb * K + C) * 2u; }
    const size_t kstep = (size_t)(BK * 2);
    const size_t hstep = (size_t)HALF * K * 2;
    const size_t tstep = 2 * hstep;
    const unsigned ldsw = (unsigned)wid * 1024u;
    const int aoff = lds_byte(wr * 64 + fr, fq * 8), boff = lds_byte(wc * 32 + fr, fq * 8);
#define PG8_SA(b, h) (((b) * 2 + (h)) * HTB)
#define PG8_SB(b, h) ((4 + (b) * 2 + (h)) * HTB)
#define PG8_STAGE(bufoff, gbase, voff) do { _Pragma("unroll") for (int _i = 0; _i < 2; ++_i) \
        __builtin_amdgcn_global_load_lds((const unsigned*)((const char*)(gbase) + (voff)[_i]), (PG8_LAS unsigned*)(lds + (bufoff) + ldsw + _i * 8192), 16, 0, 0); } while (0)
#define PG8_LDA(dst, b, h) do { _Pragma("unroll") for (int m = 0; m < 4; ++m) _Pragma("unroll") for (int k = 0; k < 2; ++k) dst[m][k] = *(const PG8_LAS bf16x8*)(lds + PG8_SA(b, h) + aoff + m * 2048 + k * 1024); } while (0)
#define PG8_LDB(dst, b, h) do { _Pragma("unroll") for (int n = 0; n < 2; ++n) _Pragma("unroll") for (int k = 0; k < 2; ++k) dst[n][k] = *(const PG8_LAS bf16x8*)(lds + PG8_SB(b, h) + boff + n * 2048 + k * 1024); } while (0)
#define PG8_MMA(ai, bj, At, Bt) do { __builtin_amdgcn_s_setprio(1); _Pragma("unroll") for (int m = 0; m < 4; ++m) _Pragma("unroll") for (int n = 0; n < 2; ++n) _Pragma("unroll") for (int k = 0; k < 2; ++k) \
        acc[ai][bj][m][n] = __builtin_amdgcn_mfma_f32_16x16x32_bf16(Bt[n][k], At[m][k], acc[ai][bj][m][n], 0, 0, 0); __builtin_amdgcn_s_setprio(0); } while (0)
#define PG8_WAIT_V(n) asm volatile("s_waitcnt vmcnt(" #n ")" ::: "memory")
#define PG8_WAIT_L(n) asm volatile("s_waitcnt lgkmcnt(" #n ")" ::: "memory")
#define PG8_BAR __builtin_amdgcn_s_barrier()
#define PG8_SCHED __builtin_amdgcn_sched_barrier(0)
    Unit cur, nxt; int ui = 0;
    if (!S.next(0, cur)) return;
    f32x4 acc[2][2][4][2];
#pragma unroll
    for (int a = 0; a < 2; ++a)
#pragma unroll
        for (int b = 0; b < 2; ++b)
#pragma unroll
            for (int m = 0; m < 4; ++m)
#pragma unroll
                for (int n = 0; n < 2; ++n) acc[a][b][m][n] = (f32x4){0.f, 0.f, 0.f, 0.f};
    bf16x8 At[4][2], B0[2][2], B1[2][2];
    const char* cA = (const char*)g.A + (size_t)cur.pm * tstep; const char* cB = (const char*)g.Bt + (size_t)cur.pn * tstep;
    S.a_ready(cur);
    if constexpr (SP2) {
        PG8_STAGE(PG8_SB(0, 0), cB, voffB); PG8_STAGE(PG8_SB(0, 1), cB + hstep, voffB); PG8_STAGE(PG8_SA(0, 0), cA, voffA); PG8_STAGE(PG8_SA(0, 1), cA + hstep, voffA);
        if (wr == 1) PG8_BAR;
        PG8_WAIT_V(2); PG8_BAR;
        PG8_STAGE(PG8_SB(1, 0), cB + kstep, voffB); PG8_STAGE(PG8_SA(1, 0), cA + kstep, voffA); PG8_STAGE(PG8_SB(1, 1), cB + hstep + kstep, voffB);
        PG8_WAIT_V(6); PG8_BAR;
    } else {
        PG8_STAGE(PG8_SB(0, 0), cB, voffB); PG8_STAGE(PG8_SA(0, 0), cA, voffA); PG8_STAGE(PG8_SB(0, 1), cB + hstep, voffB); PG8_STAGE(PG8_SA(0, 1), cA + hstep, voffA);
        if (wr == 1) PG8_BAR;
        PG8_WAIT_V(4); PG8_BAR;
        PG8_STAGE(PG8_SB(1, 0), cB + kstep, voffB); PG8_STAGE(PG8_SA(1, 0), cA + kstep, voffA); PG8_STAGE(PG8_SB(1, 1), cB + hstep + kstep, voffB);
        PG8_WAIT_V(6); PG8_BAR;
    }
    for (;;) {
        const bool has_next = S.next(ui + 1, nxt);
        const char* nA = has_next ? (const char*)g.A + (size_t)nxt.pm * tstep : cA; const char* nB = has_next ? (const char*)g.Bt + (size_t)nxt.pn * tstep : cB;
        for (int t = 0; t < nt; t += 2) {
            const bool last = (t == nt - 2);
            const char* a1 = cA + (size_t)(t + 1) * kstep;
            const char* a2 = last ? nA : cA + (size_t)(t + 2) * kstep; const char* b2 = last ? nB : cB + (size_t)(t + 2) * kstep;
            const char* a3 = a2 + kstep; const char* b3 = b2 + kstep;
            if (last && has_next) S.a_ready(nxt);
            if constexpr (SP2) {
            PG8_LDB(B0, 0, 0); PG8_LDB(B1, 0, 1); PG8_SCHED; PG8_LDA(At, 0, 0); PG8_STAGE(PG8_SA(1, 1), a1 + hstep, voffA);
            PG8_WAIT_V(8); PG8_WAIT_L(0); PG8_BAR; PG8_MMA(0, 0, At, B0); PG8_MMA(0, 1, At, B1); PG8_BAR; PG8_SCHED;
            PG8_LDA(At, 0, 1); PG8_STAGE(PG8_SB(0, 0), b2, voffB); PG8_STAGE(PG8_SB(0, 1), b2 + hstep, voffB); PG8_STAGE(PG8_SA(0, 0), a2, voffA);
            PG8_WAIT_V(8); PG8_WAIT_L(0); PG8_BAR; PG8_MMA(1, 0, At, B0); PG8_MMA(1, 1, At, B1); PG8_BAR; PG8_SCHED;
            PG8_LDB(B0, 1, 0); PG8_LDB(B1, 1, 1); PG8_SCHED; PG8_LDA(At, 1, 0); PG8_STAGE(PG8_SA(0, 1), a2 + hstep, voffA);
            PG8_WAIT_V(8); PG8_WAIT_L(0); PG8_BAR; PG8_MMA(0, 0, At, B0); PG8_MMA(0, 1, At, B1); PG8_BAR; PG8_SCHED;
            PG8_LDA(At, 1, 1); PG8_STAGE(PG8_SB(1, 0), b3, voffB); PG8_STAGE(PG8_SB(1, 1), b3 + hstep, voffB); PG8_STAGE(PG8_SA(1, 0), a3, voffA);
            PG8_WAIT_V(8); PG8_WAIT_L(0); PG8_BAR; PG8_MMA(1, 0, At, B0); PG8_MMA(1, 1, At, B1); PG8_BAR; PG8_SCHED;
            } else {
            PG8_LDB(B0, 0, 0); PG8_SCHED; PG8_LDA(At, 0, 0); PG8_STAGE(PG8_SA(1, 1), a1 + hstep, voffA);
            PG8_WAIT_L(8); PG8_BAR; PG8_WAIT_L(0); PG8_MMA(0, 0, At, B0); PG8_BAR; PG8_SCHED;
            PG8_LDB(B1, 0, 1); PG8_STAGE(PG8_SB(0, 0), b2, voffB);
            PG8_BAR; PG8_WAIT_L(0); PG8_MMA(0, 1, At, B1); PG8_BAR;
            PG8_LDA(At, 0, 1); PG8_STAGE(PG8_SA(0, 0), a2, voffA);
            PG8_BAR; PG8_WAIT_L(0); PG8_MMA(1, 0, At, B0); PG8_BAR; PG8_SCHED;
            PG8_STAGE(PG8_SB(0, 1), b2 + hstep, voffB);
            PG8_WAIT_V(6); PG8_BAR; PG8_MMA(1, 1, At, B1); PG8_BAR;
            PG8_LDB(B0, 1, 0); PG8_SCHED; PG8_LDA(At, 1, 0); PG8_STAGE(PG8_SA(0, 1), a2 + hstep, voffA);
            PG8_WAIT_L(8); PG8_BAR; PG8_WAIT_L(0); PG8_MMA(0, 0, At, B0); PG8_BAR; PG8_SCHED;
            PG8_LDB(B1, 1, 1); PG8_STAGE(PG8_SB(1, 0), b3, voffB);
            PG8_BAR; PG8_WAIT_L(0); PG8_MMA(0, 1, At, B1); PG8_BAR;
            PG8_LDA(At, 1, 1); PG8_STAGE(PG8_SA(1, 0), a3, voffA);
            PG8_BAR; PG8_WAIT_L(0); PG8_MMA(1, 0, At, B0); PG8_BAR; PG8_SCHED;
            PG8_STAGE(PG8_SB(1, 1), b3 + hstep, voffB);
            PG8_WAIT_V(6); PG8_BAR; PG8_MMA(1, 1, At, B1); PG8_BAR;
            }
        }
        if constexpr (ALIGN_EPI) { if (wr == 0) PG8_BAR; }
        if constexpr (!Epi::AFTER_DRAIN) { E(acc, cur, wr, wc, fr, fq, ui); S.done(cur); }
        if (!has_next) break;
#pragma unroll
        for (int a = 0; a < 2; ++a)
#pragma unroll
            for (int b = 0; b < 2; ++b)
#pragma unroll
                for (int m = 0; m < 4; ++m)
#pragma unroll
                    for (int n = 0; n < 2; ++n) acc[a][b][m][n] = (f32x4){0.f, 0.f, 0.f, 0.f};
        cur = nxt; cA = nA; cB = nB; ++ui;
        if constexpr (ALIGN_EPI) { if (wr == 1) PG8_BAR; }
    }
    PG8_WAIT_V(0);
    if constexpr (!ALIGN_EPI) { if (wr == 0) PG8_BAR; }
    PG8_BAR;
    if constexpr (Epi::AFTER_DRAIN) { E.fused(acc, cur, wr, wc, fr, fq, lds, wid, lane); S.done(cur); }
#undef PG8_SA
#undef PG8_SB
#undef PG8_STAGE
#undef PG8_LDA
#undef PG8_LDB
#undef PG8_MMA
#undef PG8_WAIT_V
#undef PG8_WAIT_L
#undef PG8_BAR
#undef PG8_SCHED
}
}

constexpr int BATCH = 16, T = 2048, D = 1024, M = BATCH * T, NIN = 3072, FF = 4096;
constexpr size_t MiB = 1u << 20;
constexpr size_t WS_WB = 1 * MiB;
constexpr size_t WB_LAYER = 24 * MiB, WB_IN = 0, WB_OUT = 6 * MiB, WB_W1 = 8 * MiB, WB_W2 = 16 * MiB;
constexpr size_t WS_MOD = 49 * MiB;
constexpr size_t WS_LORA = 50 * MiB;
constexpr size_t LORA_LAYER = 131072, LORA_W2 = 0, LORA_A2 = 32768, LORA_G2 = 65536;
constexpr size_t WS_SCAL = 51 * MiB;
constexpr size_t WS_XN = 53 * MiB;
constexpr size_t WS_SW = WS_XN, WS_YR = WS_XN + 32 * MiB;
constexpr size_t WS_Y = 117 * MiB;
constexpr size_t WS_P = 181 * MiB;
constexpr size_t WS_S16 = 373 * MiB;
constexpr size_t S16_ARR = 16 * MiB;
constexpr size_t WS_G = 453 * MiB;
constexpr size_t WS_H = WS_P;
constexpr size_t WS_VT = 469 * MiB;
constexpr size_t WS_SSQA = 501 * MiB, WS_SSQB = 503 * MiB;
constexpr size_t WS_BIAS = 505 * MiB;
constexpr size_t WS_END = 506 * MiB;
constexpr int LDS_BYTES = 147456;
constexpr size_t WS_BAR = 16384;
constexpr int LDS_CTL = LDS_BYTES - 64;

#define LAS __attribute__((address_space(3)))
typedef unsigned short bf16;
typedef _Float16 h16;
typedef float f32x4 __attribute__((ext_vector_type(4)));
typedef float f32x2 __attribute__((ext_vector_type(2)));
typedef short bf16x8 __attribute__((ext_vector_type(8)));
typedef unsigned u32x4 __attribute__((ext_vector_type(4)));
typedef unsigned u32x2 __attribute__((ext_vector_type(2)));
typedef h16 h16x4 __attribute__((ext_vector_type(4)));
typedef h16 h16x8 __attribute__((ext_vector_type(8)));

__device__ __forceinline__ unsigned pk2(float lo, float hi) { return pg8::cvt_pk_bf16(lo, hi); }
__device__ __forceinline__ unsigned f2bf(float f) { return pg8::cvt_pk_bf16(f, 0.f) & 0xffffu; }
__device__ __forceinline__ float bf2f(unsigned h) { return __builtin_bit_cast(float, h << 16); }
__device__ __forceinline__ float bflo(unsigned w) { return __builtin_bit_cast(float, w << 16); }
__device__ __forceinline__ float bfhi(unsigned w) { return __builtin_bit_cast(float, w & 0xffff0000u); }
__device__ __forceinline__ float shx(float v, int m) { int l = __builtin_amdgcn_mbcnt_hi(~0u, __builtin_amdgcn_mbcnt_lo(~0u, 0u)); asm volatile("" : "+v"(l));
    return __builtin_bit_cast(float, __builtin_amdgcn_ds_bpermute((l ^ m) << 2, __builtin_bit_cast(int, v))); }
__device__ __forceinline__ float wave_sum(float v) {
#pragma unroll
    for (int o = 1; o < 64; o <<= 1) v += shx(v, o);
    return v;
}
__device__ __forceinline__ float sum16(float v) {
    v += shx(v, 1); v += shx(v, 2); v += shx(v, 4); v += shx(v, 8); return v;
}
__device__ __forceinline__ float sigmoidf_(float x) { return 1.f / (1.f + __expf(-x)); }
#define LDS_WAIT() asm volatile("s_waitcnt lgkmcnt(0)" ::: "memory")

struct Args { const float* in[32]; float* out; unsigned char* ws; int ph_lo, ph_hi; };

__device__ __forceinline__ const float* inp(const Args& a, int i) { asm volatile("" : "+s"(i)); return a.in[i]; }
__device__ __forceinline__ void p0_transpose_item(const float* W, int K, int N, bf16* WT, float* scr, int item, int lane) {
    const int nblk = N / 32, kb = item / nblk, nb = item % nblk, k0 = 64 * kb, n0 = 32 * nb;
    float wv_[32];
#pragma unroll
    for (int i = 0; i < 32; ++i) wv_[i] = W[(size_t)(k0 + 2 * i + (lane >> 5)) * N + n0 + (lane & 31)];
#pragma unroll
    for (int i = 0; i < 32; ++i) scr[(2 * i + (lane >> 5)) * 33 + (lane & 31)] = wv_[i];
    LDS_WAIT(); asm volatile("" ::: "memory");
    const int c = lane & 7;
#pragma unroll
    for (int j = 0; j < 4; ++j) { const int n = (lane >> 3) + 8 * j; const float* s = scr + (8 * c) * 33 + n;
        u32x4 o; o.x = pk2(s[0 * 33], s[1 * 33]); o.y = pk2(s[2 * 33], s[3 * 33]); o.z = pk2(s[4 * 33], s[5 * 33]); o.w = pk2(s[6 * 33], s[7 * 33]);
        *(u32x4*)(WT + (size_t)(n0 + n) * K + k0 + 8 * c) = o; }
    LDS_WAIT(); asm volatile("" ::: "memory");
}
__device__ __forceinline__ void phase_weights(const Args& a, unsigned char* lds, int wave, int lane) {
    float* scr = (float*)(lds + wave * 16384);
    const int gw = blockIdx.x * 8 + wave, NGW = gridDim.x * 8;
    constexpr int I_IN = 16 * 96, I_OUT = 16 * 32, I_W1 = 16 * 128, I_W2 = 64 * 32, I_L2 = 8, I_G2 = 16;
    constexpr int PER = I_IN + I_OUT + I_W1 + I_W2 + 2 * I_L2 + I_G2;
    for (int it = gw; it < 2 * PER; it += NGW) {
        const int l = it / PER; int r = it % PER;
        unsigned char* wb = a.ws + WS_WB + (size_t)l * WB_LAYER; unsigned char* lo = a.ws + WS_LORA + (size_t)l * LORA_LAYER;
        if (r < I_IN) { p0_transpose_item(inp(a, 5) + (size_t)l * D * NIN, D, NIN, (bf16*)(wb + WB_IN), scr, r, lane); continue; } r -= I_IN;
        if (r < I_OUT) { p0_transpose_item(inp(a, 28) + (size_t)l * D * D, D, D, (bf16*)(wb + WB_OUT), scr, r, lane); continue; } r -= I_OUT;
        if (r < I_W1) { p0_transpose_item(inp(a, 30) + (size_t)l * D * FF, D, FF, (bf16*)(wb + WB_W1), scr, r, lane); continue; } r -= I_W1;
        if (r < I_W2) { p0_transpose_item(inp(a, 31) + (size_t)l * FF * D, FF, D, (bf16*)(wb + WB_W2), scr, r, lane); continue; } r -= I_W2;
        if (r < I_L2) { p0_transpose_item(inp(a, 8) + (size_t)l * 64 * 256, 64, 256, (bf16*)(lo + LORA_W2), scr, r, lane); continue; } r -= I_L2;
        if (r < I_L2) { p0_transpose_item(inp(a, 10) + (size_t)l * 64 * 256, 64, 256, (bf16*)(lo + LORA_A2), scr, r, lane); continue; } r -= I_L2;
        p0_transpose_item(inp(a, 11) + (size_t)l * 128 * 256, 128, 256, (bf16*)(lo + LORA_G2), scr, r, lane);
    }
}
__device__ __forceinline__ void phase_ada(const Args& a, unsigned char* lds, int tid, int wave, int lane) {
    float* cond = (float*)lds; float* red = cond + 16384;
    const float* c = inp(a, 1); float* mod = (float*)(a.ws + WS_MOD);
    for (int i = tid; i < 16384; i += 512) { const float v = c[i]; cond[i] = v / (1.f + __expf(-v)); }
    __syncthreads();
    for (int item = blockIdx.x; item < 192; item += gridDim.x) {
        const int l = item / 96, n0 = (item % 96) * 64;
        const float* W = inp(a, 2) + (size_t)l * 1024 * 6144 + n0 + lane;
        float acc[16];
#pragma unroll
        for (int b = 0; b < 16; ++b) acc[b] = 0.f;
        const int k0 = wave * 128;
#pragma unroll 1
        for (int k = k0; k < k0 + 128; k += 16) {
            float wq[16];
#pragma unroll
            for (int i = 0; i < 16; ++i) wq[i] = W[(size_t)(k + i) * 6144];
#pragma unroll
            for (int i = 0; i < 16; i += 4)
#pragma unroll
                for (int b = 0; b < 16; ++b) { const f32x4 cv = *(const f32x4*)(cond + b * 1024 + k + i); acc[b] += cv[0] * wq[i] + cv[1] * wq[i + 1] + cv[2] * wq[i + 2] + cv[3] * wq[i + 3]; }
        }
#pragma unroll
        for (int b = 0; b < 16; ++b) red[(wave * 16 + b) * 64 + lane] = acc[b];
        __syncthreads();
        for (int o = tid; o < 1024; o += 512) { const int b = o >> 6, n = o & 63; float s = 0.f;
#pragma unroll
            for (int w = 0; w < 8; ++w) s += red[(w * 16 + b) * 64 + n];
            mod[(size_t)(l * 16 + b) * 6144 + n0 + n] = s + inp(a, 3)[(size_t)l * 6144 + n0 + n]; }
        __syncthreads();
    }
}
__device__ __forceinline__ void phase_xn(const float* x, const float* g, const float* modl, int sh_off, int sc_off, bf16* XN, int wave, int lane) {
    const int gw = blockIdx.x * 8 + wave, NGW = gridDim.x * 8, rpw = ((M + NGW - 1) / NGW + 3) & ~3;
    const int mend = (gw + 1) * rpw < M ? (gw + 1) * rpw : M;
    for (int m = gw * rpw; m < mend; m += 4) {
        const int b = m >> 11;
        f32x4 v[4][4];
#pragma unroll
        for (int i = 0; i < 4; ++i) { const f32x4* xr = (const f32x4*)(x + (size_t)(m + i) * D) + lane;
#pragma unroll
            for (int j = 0; j < 4; ++j) v[i][j] = xr[64 * j]; }
        const float* mb = modl + (size_t)b * 6144;
        f32x4 ga[4], sh[4];
#pragma unroll
        for (int j = 0; j < 4; ++j) { const int col = 4 * lane + 256 * j; ga[j] = *(const f32x4*)(g + col) * (*(const f32x4*)(mb + sc_off + col) + 1.f); sh[j] = *(const f32x4*)(mb + sh_off + col); }
#pragma unroll
        for (int i = 0; i < 4; ++i) { float ss = 0.f;
#pragma unroll
            for (int j = 0; j < 4; ++j) ss += (v[i][j][0] * v[i][j][0] + v[i][j][1] * v[i][j][1]) + (v[i][j][2] * v[i][j][2] + v[i][j][3] * v[i][j][3]);
            const float rstd = rsqrtf(wave_sum(ss) * (1.f / D) + 1e-6f);
#pragma unroll
            for (int j = 0; j < 4; ++j) { const int col = 4 * lane + 256 * j; const f32x4 y = (v[i][j] * rstd) * ga[j] + sh[j];
                u32x2 w; w.x = pk2(y[0], y[1]); w.y = pk2(y[2], y[3]);
                *(u32x2*)(XN + (size_t)(m + i) * D + col) = w; } }
    }
}

__device__ __forceinline__ f32x4 mfma16(bf16x8 A, bf16x8 B, f32x4 C) { return __builtin_amdgcn_mfma_f32_16x16x32_bf16(A, B, C, 0, 0, 0); }
__device__ __forceinline__ void phase_bias(const Args& a, int wave, int lane) {
    const int gw = blockIdx.x * 8 + wave, NGW = gridDim.x * 8;
    const int r = lane & 15, g = lane >> 4;
    float* BIAS = (float*)(a.ws + WS_BIAS);
    for (int t = gw; t < 704; t += NGW) {
        int idx, tile; if (t < 192) { idx = 0; tile = t; } else if (t < 448) { idx = 1; tile = t - 192; } else { idx = 2; tile = t - 448; }
        const int lsel = idx == 1 ? 0 : 1, N = idx == 0 ? NIN : FF;
        const float* sh = (const float*)(a.ws + WS_MOD) + (size_t)lsel * 16 * 6144 + (idx == 0 ? 0 : 3072) + (size_t)r * 6144 + g * 8;
        const bf16* Bt = (const bf16*)(a.ws + WS_WB + (size_t)lsel * WB_LAYER + (idx == 0 ? WB_IN : WB_W1)) + (size_t)(tile * 16 + r) * 1024 + g * 8;
        float* outp = BIAS + (idx == 0 ? 0 : (idx == 1 ? 16 * NIN : 16 * NIN + 16 * FF));
        f32x4 acc = {0.f, 0.f, 0.f, 0.f};
#pragma unroll 4
        for (int ks = 0; ks < 32; ++ks) {
            const f32x4 x0 = *(const f32x4*)(sh + ks * 32), x1 = *(const f32x4*)(sh + ks * 32 + 4);
            u32x4 hi, lo;
            hi.x = pk2(x0[0], x0[1]); hi.y = pk2(x0[2], x0[3]); hi.z = pk2(x1[0], x1[1]); hi.w = pk2(x1[2], x1[3]);
            lo.x = pk2(x0[0] - bflo(hi.x), x0[1] - bfhi(hi.x)); lo.y = pk2(x0[2] - bflo(hi.y), x0[3] - bfhi(hi.y));
            lo.z = pk2(x1[0] - bflo(hi.z), x1[1] - bfhi(hi.z)); lo.w = pk2(x1[2] - bflo(hi.w), x1[3] - bfhi(hi.w));
            const bf16x8 B = *(const bf16x8*)(Bt + ks * 32);
            acc = mfma16(__builtin_bit_cast(bf16x8, hi), B, acc); acc = mfma16(__builtin_bit_cast(bf16x8, lo), B, acc);
        }
#pragma unroll
        for (int j = 0; j < 4; ++j) outp[(size_t)(4 * g + j) * N + tile * 16 + r] = acc[j];
    }
}

template <int CTRL> __device__ __forceinline__ float dppf(float x) { return __builtin_bit_cast(float, __builtin_amdgcn_update_dpp(0, __builtin_bit_cast(int, x), CTRL, 0xf, 0xf, true)); }
__device__ __forceinline__ float rowsum16(float x) { x += dppf<0xB1>(x); x += dppf<0x4E>(x); x += dppf<0x124>(x); x += dppf<0x128>(x); return x; }
__device__ __forceinline__ float softplusf_(float x) { return x > 0.f ? x + log1pf(__expf(-x)) : log1pf(__expf(x)); }
__device__ __forceinline__ float sel4(f32x4 v, int j) { return j == 0 ? v[0] : (j == 1 ? v[1] : (j == 2 ? v[2] : v[3])); }
__device__ __forceinline__ float tanhf_(float x) { return 1.f - 2.f / (1.f + __expf(2.f * x)); }
__device__ __forceinline__ void phase_premix(const Args& a, int l, unsigned char* lds, int tid, int wave, int lane) {
    bf16* P = (bf16*)(a.ws + WS_P);
    const bf16* w2t = (const bf16*)(a.ws + WS_LORA + (size_t)l * LORA_LAYER + LORA_W2);
    const bf16* a2t = (const bf16*)(a.ws + WS_LORA + (size_t)l * LORA_LAYER + LORA_A2);
    const bf16* g2t = (const bf16*)(a.ws + WS_LORA + (size_t)l * LORA_LAYER + LORA_G2);
    h16* S16 = (h16*)(a.ws + WS_S16); float* SW = (float*)(a.ws + WS_SW); bf16* G = (bf16*)(a.ws + WS_G); float* SCAL = (float*)(a.ws + WS_SCAL);
    constexpr size_t ARR = (size_t)M * 256;
    bf16* praw = (bf16*)lds;
    bf16* act = (bf16*)(lds + 33 * 2048);
    bf16* vbuf = (bf16*)(lds + 33 * 2048 + 32 * 264 * 2);
    float* par = (float*)(lds + 33 * 2048 + 32 * 264 * 2 + 32 * 520 * 2);
    bf16* VT = (bf16*)(a.ws + WS_VT);
    if (tid < 256) { const float* mu = inp(a, 6) + l * 1024;
        par[tid] = mu[tid]; par[256 + tid] = mu[256 + tid]; par[512 + tid] = mu[512 + tid]; par[768 + tid] = mu[768 + tid];
        par[1024 + tid] = inp(a, 7)[l * 256 + tid]; par[1280 + tid] = inp(a, 9)[l * 256 + tid]; par[1536 + tid] = inp(a, 12)[l * 256 + tid];
        par[1792 + tid] = inp(a, 13)[l * 256 + tid]; par[2048 + tid] = inp(a, 14)[l * 256 + tid]; }
    else if (tid < 320) par[2304 + tid - 256] = inp(a, 17)[l * 64 + tid - 256];
    else if (tid < 384) par[2368 + tid - 320] = inp(a, 18)[l * 64 + tid - 320];
    __syncthreads();
    for (int tile = blockIdx.x; tile < M / 32; tile += gridDim.x) {
        int ln_ = lane; asm volatile("" : "+v"(ln_)); const int r = ln_ & 15, g = ln_ >> 4;
        const int b = tile >> 6, t0 = (tile & 63) * 32; const size_t row0 = (size_t)b * T + t0;
        const int tt = wave >> 2, h = wave & 3;
        u32x4 pr_[9], vv_[4], q0_[4], q1_[4]; u32x2 ga_[4], gb_[4];
#pragma unroll
        for (int i = 0; i < 9; ++i) { const int ch = tid + 512 * i, rr = ch >> 7, cc = ch & 127; pr_[i] = (u32x4){0u, 0u, 0u, 0u};
            if (ch < 33 * 128 && (rr > 0 || t0 > 0)) pr_[i] = *(const u32x4*)(P + (row0 + rr - 1) * NIN + cc * 8); }
#pragma unroll
        for (int i = 0; i < 4; ++i) { const int ch = tid + 512 * i, rr = ch >> 6, cc = ch & 63; vv_[i] = *(const u32x4*)(P + (row0 + rr) * NIN + 2048 + cc * 8);
            const bf16* prow = P + (row0 + wave * 4 + i) * NIN;
            q0_[i] = *(const u32x4*)(prow + 1024 + ln_ * 16); q1_[i] = *(const u32x4*)(prow + 1024 + ln_ * 16 + 8);
            ga_[i] = *(const u32x2*)(prow + 2560 + ln_ * 4); gb_[i] = *(const u32x2*)(prow + 2816 + ln_ * 4); }
#pragma unroll
        for (int i = 0; i < 9; ++i) { const int ch = tid + 512 * i, rr = ch >> 7, cc = ch & 127; if (ch < 33 * 128) *(u32x4*)(praw + rr * 1024 + cc * 8) = pr_[i]; }
#pragma unroll
        for (int i = 0; i < 4; ++i) { const int ch = tid + 512 * i, rr = ch >> 6, cc = ch & 63; *(u32x4*)(vbuf + rr * 520 + cc * 8) = vv_[i]; }
        {
            const float* gam = par + (ln_ < 32 ? 2304 : 2368) + (ln_ & 3) * 16;
            const float qs_ = ln_ < 32 ? 0.125f * 1.4426950408889634f : 1.f;
#pragma unroll
            for (int i = 0; i < 4; ++i) { bf16* prow = P + (row0 + wave * 4 + i) * NIN;
                float f[16];
#pragma unroll
                for (int e = 0; e < 4; ++e) { f[2 * e] = bflo(q0_[i][e]); f[2 * e + 1] = bfhi(q0_[i][e]); f[8 + 2 * e] = bflo(q1_[i][e]); f[8 + 2 * e + 1] = bfhi(q1_[i][e]); }
                float ss = 0.f;
#pragma unroll
                for (int e = 0; e < 16; ++e) ss += f[e] * f[e];
                ss += dppf<0xB1>(ss); ss += dppf<0x4E>(ss);
                const float sc = rsqrtf(ss * (1.f / 64.f) + 1e-6f) * qs_;
                u32x4 o0, o1;
#pragma unroll
                for (int e = 0; e < 4; ++e) { o0[e] = pk2(f[2 * e] * sc * gam[2 * e], f[2 * e + 1] * sc * gam[2 * e + 1]); o1[e] = pk2(f[8 + 2 * e] * sc * gam[8 + 2 * e], f[8 + 2 * e + 1] * sc * gam[8 + 2 * e + 1]); }
                *(u32x4*)(prow + 1024 + ln_ * 16) = o0; *(u32x4*)(prow + 1024 + ln_ * 16 + 8) = o1;
                u32x2 hv;
                hv.x = pk2(bflo(ga_[i].x) * sigmoidf_(bflo(gb_[i].x)), bfhi(ga_[i].x) * sigmoidf_(bfhi(gb_[i].x)));
                hv.y = pk2(bflo(ga_[i].y) * sigmoidf_(bflo(gb_[i].y)), bfhi(ga_[i].y) * sigmoidf_(bfhi(gb_[i].y)));
                *(u32x2*)(prow + 2560 + ln_ * 4) = hv; }
        }
        __syncthreads();
        bf16x8 Bw[2][4], Ba[2][4], Bg[4][4];
#pragma unroll
        for (int ct = 0; ct < 4; ++ct) {
#pragma unroll
            for (int ks = 0; ks < 2; ++ks) { const size_t wo = (size_t)(h * 64 + ct * 16 + r) * 64 + ks * 32 + g * 8; Bw[ks][ct] = *(const bf16x8*)(w2t + wo); Ba[ks][ct] = *(const bf16x8*)(a2t + wo); }
#pragma unroll
            for (int ks = 0; ks < 4; ++ks) Bg[ks][ct] = *(const bf16x8*)(g2t + (size_t)(h * 64 + ct * 16 + r) * 128 + ks * 32 + g * 8); }
        {
            bf16* dst = VT + ((size_t)b * 512 + tid) * T + t0;
#pragma unroll
            for (int q = 0; q < 4; ++q) { u32x4 o;
#pragma unroll
                for (int e = 0; e < 4; ++e) { const int k0_ = (e >> 1) * 16 + q * 4 + (e & 1) * 2; o[e] = (unsigned)vbuf[k0_ * 520 + tid] | ((unsigned)vbuf[(k0_ + 1) * 520 + tid] << 16); }
                *(u32x4*)(dst + q * 8) = o; } }
#pragma unroll 4
        for (int idx = tid; idx < 32 * 256; idx += 512) { const int tok = idx >> 8, c = idx & 255, col = 768 + c;
            const float cur = bf2f(praw[(tok + 1) * 1024 + col]), prev = bf2f(praw[tok * 1024 + col]);
            const float pa = cur + par[768 + c] * (prev - cur);
            const float o = c < 64 ? tanhf_(pa) : (c < 128 ? pa : sigmoidf_(pa));
            act[tok * 264 + c] = (bf16)f2bf(o); }
        __syncthreads();
        f32x4 aw[4], aa[4], ag[4];
#pragma unroll
        for (int ct = 0; ct < 4; ++ct) { aw[ct] = (f32x4){0.f, 0.f, 0.f, 0.f}; aa[ct] = aw[ct]; ag[ct] = aw[ct]; }
        const bf16* arow = act + (tt * 16 + r) * 264 + g * 8;
#pragma unroll
        for (int ks = 0; ks < 2; ++ks) { const bf16x8 A = *(const bf16x8*)(arow + ks * 32), A2 = *(const bf16x8*)(arow + 64 + ks * 32);
#pragma unroll
            for (int ct = 0; ct < 4; ++ct) { aw[ct] = mfma16(A, Bw[ks][ct], aw[ct]); aa[ct] = mfma16(A2, Ba[ks][ct], aa[ct]); } }
#pragma unroll
        for (int ks = 0; ks < 4; ++ks) { const bf16x8 A = *(const bf16x8*)(arow + 128 + ks * 32);
#pragma unroll
            for (int ct = 0; ct < 4; ++ct) ag[ct] = mfma16(A, Bg[ks][ct], ag[ct]); }
#pragma unroll 1
        for (int j = 0; j < 4; ++j) {
            const int tok = tt * 16 + 4 * g + j; const size_t token = row0 + tok;
            float kkv[4], k2v[4], rv[4], av[4], vv[4], dv[4]; float ss = 0.f;
#pragma unroll
            for (int ct = 0; ct < 4; ++ct) { const int c = h * 64 + ct * 16 + r;
                const bf16* pc = praw + (tok + 1) * 1024; const bf16* pp = praw + tok * 1024;
                float x0 = bf2f(pc[c]), x1 = bf2f(pc[256 + c]), x2 = bf2f(pc[512 + c]);
                x0 += par[c] * (bf2f(pp[c]) - x0); x1 += par[256 + c] * (bf2f(pp[256 + c]) - x1); x2 += par[512 + c] * (bf2f(pp[512 + c]) - x2);
                const float wl = par[1024 + c] + sel4(aw[ct], j);
                const float wlog = -__logf(1.f + __expf(-wl)) - 0.5f;
                dv[ct] = __expf(-__expf(wlog));
                av[ct] = sigmoidf_(par[1280 + c] + sel4(aa[ct], j));
                rv[ct] = x0; vv[ct] = x2;
                kkv[ct] = x1 * par[1536 + c]; ss += kkv[ct] * kkv[ct];
                k2v[ct] = x1 * (1.f + (av[ct] - 1.f) * par[1792 + c]); }
            ss = rowsum16(ss);
            const float inv = 1.f / fmaxf(sqrtf(ss), 1e-12f);
            float c1 = 0.f, c2 = 0.f, bn = 0.f;
#pragma unroll
            for (int ct = 0; ct < 4; ++ct) { const int c = h * 64 + ct * 16 + r; const size_t o = token * 256 + c;
                const float kkn = kkv[ct] * inv, ka = kkn * av[ct];
                c1 += ka * rv[ct]; c2 += k2v[ct] * rv[ct]; bn += rv[ct] * k2v[ct] * par[2048 + c];
                S16[o] = (h16)(-kkn); S16[ARR + o] = (h16)(dv[ct] * rv[ct]); S16[2 * ARR + o] = (h16)ka; S16[3 * ARR + o] = (h16)k2v[ct]; S16[4 * ARR + o] = (h16)vv[ct];
                SW[o] = dv[ct]; G[o] = (bf16)f2bf(sel4(ag[ct], j)); }
            c1 = rowsum16(c1); c2 = rowsum16(c2); bn = rowsum16(bn);
            if (r == 0) { float* sp = SCAL + (token * 4 + h) * 4; sp[0] = c1; sp[1] = c2; sp[2] = bn; sp[3] = 0.f; }
            asm volatile("" ::: "memory");
        }
        __syncthreads();
    }
}

__device__ __forceinline__ void st8(float* d, h16x8 v) {
    *(f32x4*)d = (f32x4){(float)v[0], (float)v[1], (float)v[2], (float)v[3]}; *(f32x4*)(d + 4) = (f32x4){(float)v[4], (float)v[5], (float)v[6], (float)v[7]}; }
constexpr int SC_REC = 384, SC_CH = 32, SC_NCH = T / SC_CH;
__device__ __forceinline__ void scan_load(const h16* S16, const float* SW, const float* SCAL, size_t tok0, int h, int rg, float* dst, int ltid) {
    constexpr size_t ARR = (size_t)M * 256;
    { const int s = ltid >> 3, q = ltid & 7; const h16* p = S16 + (tok0 + s) * 256 + h * 64 + q * 8; float* rec = dst + s * SC_REC + q * 8;
      const h16x8 v0 = *(const h16x8*)p, v1 = *(const h16x8*)(p + ARR), v2 = *(const h16x8*)(p + 2 * ARR), v3 = *(const h16x8*)(p + 3 * ARR);
      st8(rec, v0); st8(rec + 64, v1); st8(rec + 192, v2); st8(rec + 256, v3); }
#pragma unroll
    for (int i = 0; i < 2; ++i) { const int id = ltid + 256 * i, s = id >> 4, q = id & 15;
        *(f32x4*)(dst + s * SC_REC + 128 + q * 4) = *(const f32x4*)(SW + (tok0 + s) * 256 + h * 64 + q * 4); }
    if (ltid < 64) { const int s = ltid >> 1, q = ltid & 1; st8(dst + s * SC_REC + 320 + q * 8, *(const h16x8*)(S16 + 4 * ARR + (tok0 + s) * 256 + h * 64 + rg * 16 + q * 8)); }
    else if (ltid < 128) { const int s = (ltid - 64) >> 1, wh = ltid & 1; dst[s * SC_REC + 336 + wh] = SCAL[((tok0 + s) * 4 + h) * 4 + wh]; }
}
struct ScanOps { f32x4 nkk, wr, w, ka, k2; f32x2 c; float vi; };
__device__ __forceinline__ void scan_ld(ScanOps& o, const float* rec, int jq, int rowl) {
    o.nkk = *(const f32x4*)(rec + 4 * jq); o.wr = *(const f32x4*)(rec + 64 + 4 * jq); o.w = *(const f32x4*)(rec + 128 + 4 * jq);
    o.ka = *(const f32x4*)(rec + 192 + 4 * jq); o.k2 = *(const f32x4*)(rec + 256 + 4 * jq); o.vi = rec[320 + rowl]; o.c = *(const f32x2*)(rec + 336);
}
__device__ __forceinline__ void scan_step(f32x4& S, float& yk, const ScanOps& o, int jq, int sidx) {
    float sa = (S[0] * o.nkk[0] + S[1] * o.nkk[1]) + (S[2] * o.nkk[2] + S[3] * o.nkk[3]);
    float ys = (S[0] * o.wr[0] + S[1] * o.wr[1]) + (S[2] * o.wr[2] + S[3] * o.wr[3]);
    sa = rowsum16(sa); ys = rowsum16(ys);
    const float y = ys + sa * o.c[0] + o.vi * o.c[1];
    yk = (jq == (sidx & 15)) ? y : yk;
    S = S * o.w + o.ka * sa + o.k2 * o.vi;
}
__device__ __forceinline__ void phase_scan(const Args& a, unsigned char* lds, int tid, int wave, int lane) {
    const h16* S16 = (const h16*)(a.ws + WS_S16); const float* SW = (const float*)(a.ws + WS_SW); const float* SCAL = (const float*)(a.ws + WS_SCAL); float* YR = (float*)(a.ws + WS_YR);
    float* buf = (float*)lds;
    for (int it = blockIdx.x; it < 256; it += gridDim.x) {
        asm volatile("" : "+v"(tid), "+v"(lane));
        const int bh = it >> 2, rg = it & 3, b = bh >> 2, h = bh & 3;
        const size_t tokb = (size_t)b * T;
        if (wave >= 4) scan_load(S16, SW, SCAL, tokb, h, rg, buf, tid - 256);
        __syncthreads();
        const int rowl = (wave & 3) * 4 + (lane >> 4), jq = lane & 15;
        f32x4 S = {0.f, 0.f, 0.f, 0.f}; float yk = 0.f;
        float* yout = YR + (tokb + jq) * 256 + h * 64 + rg * 16 + rowl;
        for (int ch = 0; ch < SC_NCH; ++ch) {
            if (wave >= 4) { if (ch + 1 < SC_NCH) scan_load(S16, SW, SCAL, tokb + (size_t)(ch + 1) * SC_CH, h, rg, buf + ((ch + 1) & 1) * SC_CH * SC_REC, tid - 256); }
            else {
                const float* src = buf + (ch & 1) * SC_CH * SC_REC;
                ScanOps A, B;
                scan_ld(A, src, jq, rowl);
#pragma unroll
                for (int s = 0; s < SC_CH; s += 2) {
                    scan_ld(B, src + (s + 1) * SC_REC, jq, rowl);
                    scan_step(S, yk, A, jq, s);
                    if (s + 2 < SC_CH) scan_ld(A, src + (s + 2) * SC_REC, jq, rowl);
                    scan_step(S, yk, B, jq, s + 1);
                    if ((s & 15) == 14) yout[(size_t)(ch * SC_CH + (s & 16)) * 256] = yk;
                }
            }
            __syncthreads();
        }
    }
}

constexpr int AT_KP = 72;
__device__ __forceinline__ void attn_issue(const bf16* P, const bf16* VT, size_t rowk0, size_t vtb, int h, int tid, u32x4 (&kr)[2], u32x4 (&vr)[2]) {
#pragma unroll
    for (int i = 0; i < 2; ++i) {
        kr[i] = *(const u32x4*)(P + (rowk0 + ((tid >> 3) & 63)) * NIN + 1536 + (h * 2 + i) * 64 + (tid & 7) * 8);
        vr[i] = *(const u32x4*)(VT + vtb + (size_t)((tid >> 3) + 64 * i) * T + (tid & 7) * 8); }
}
__device__ __forceinline__ void attn_store(bf16* Kl, int tid, const u32x4 (&kr)[2], const u32x4 (&vr)[2]) {
#pragma unroll
    for (int i = 0; i < 2; ++i) {
        *(u32x4*)(Kl + i * 64 * AT_KP + ((tid >> 3) & 63) * AT_KP + (tid & 7) * 8) = kr[i];
        *(u32x4*)(Kl + 2 * 64 * AT_KP + ((tid >> 3) + 64 * i) * AT_KP + (tid & 7) * 8) = vr[i]; }
}
constexpr int AT_BUF = (2 * 64 + 128) * AT_KP;
__device__ __forceinline__ void attn_tile(const bf16* Lb, int kt, bool diag, int r, int g, int tq, float slope2, float bsh, const bf16x8* qb, f32x4 (&O)[2][8], float (&lsum)[2]) {
    const bf16* K0 = Lb; const bf16* K1 = Lb + 64 * AT_KP; const bf16* Vt = Lb + 2 * 64 * AT_KP;
    bf16x8 kf0[4][2], kf1[4][2];
#pragma unroll
    for (int k4 = 0; k4 < 4; ++k4)
#pragma unroll
        for (int ks = 0; ks < 2; ++ks) { kf0[k4][ks] = *(const bf16x8*)(K0 + (k4 * 16 + r) * AT_KP + ks * 32 + g * 8); kf1[k4][ks] = *(const bf16x8*)(K1 + (k4 * 16 + r) * AT_KP + ks * 32 + g * 8); }
    bf16x8 qf[2][2];
#pragma unroll
    for (int c = 0; c < 2; ++c)
#pragma unroll
        for (int ks = 0; ks < 2; ++ks) qf[c][ks] = qb[(c * 2 + ks) * 64];
    f32x4 init[4];
    if (diag) {
#pragma unroll
        for (int k4 = 0; k4 < 4; ++k4)
#pragma unroll
            for (int j = 0; j < 4; ++j) init[k4][j] = -slope2 * fabsf((float)(tq - (kt * 64 + k4 * 16 + 4 * g + j))) - bsh;
    } else {
        const float base = slope2 * (float)(kt * 64 + 4 * g - tq) - bsh;
#pragma unroll
        for (int k4 = 0; k4 < 4; ++k4)
#pragma unroll
            for (int j = 0; j < 4; ++j) init[k4][j] = fmaf(slope2, (float)(k4 * 16 + j), base);
    }
    __builtin_amdgcn_sched_barrier(0);
    f32x4 s0[4], s1[4];
#pragma unroll
    for (int k4 = 0; k4 < 4; ++k4) { s0[k4] = mfma16(kf0[k4][0], qf[0][0], init[k4]); s1[k4] = mfma16(kf1[k4][0], qf[1][0], init[k4]); }
#pragma unroll
    for (int k4 = 0; k4 < 4; ++k4) { s0[k4] = mfma16(kf0[k4][1], qf[0][1], s0[k4]); s1[k4] = mfma16(kf1[k4][1], qf[1][1], s1[k4]); }
    bf16x8 vf0[8], vf1[8];
#pragma unroll
    for (int nt = 0; nt < 8; ++nt) { vf0[nt] = *(const bf16x8*)(Vt + (nt * 16 + r) * AT_KP + g * 8); vf1[nt] = *(const bf16x8*)(Vt + (nt * 16 + r) * AT_KP + 32 + g * 8); }
    __builtin_amdgcn_sched_barrier(0);
    float p0 = 0.f, p1 = 0.f;
#pragma unroll
    for (int k4 = 0; k4 < 4; ++k4)
#pragma unroll
        for (int j = 0; j < 4; ++j) { s0[k4][j] = __builtin_amdgcn_exp2f(s0[k4][j]); p0 += s0[k4][j]; s1[k4][j] = __builtin_amdgcn_exp2f(s1[k4][j]); p1 += s1[k4][j]; }
    lsum[0] += p0; lsum[1] += p1;
    u32x4 a0, a1, b0, b1;
    a0.x = pg8::cvt_pk_bf16(s0[0][0], s0[0][1]); a0.y = pg8::cvt_pk_bf16(s0[0][2], s0[0][3]); a0.z = pg8::cvt_pk_bf16(s0[1][0], s0[1][1]); a0.w = pg8::cvt_pk_bf16(s0[1][2], s0[1][3]);
    a1.x = pg8::cvt_pk_bf16(s0[2][0], s0[2][1]); a1.y = pg8::cvt_pk_bf16(s0[2][2], s0[2][3]); a1.z = pg8::cvt_pk_bf16(s0[3][0], s0[3][1]); a1.w = pg8::cvt_pk_bf16(s0[3][2], s0[3][3]);
    b0.x = pg8::cvt_pk_bf16(s1[0][0], s1[0][1]); b0.y = pg8::cvt_pk_bf16(s1[0][2], s1[0][3]); b0.z = pg8::cvt_pk_bf16(s1[1][0], s1[1][1]); b0.w = pg8::cvt_pk_bf16(s1[1][2], s1[1][3]);
    b1.x = pg8::cvt_pk_bf16(s1[2][0], s1[2][1]); b1.y = pg8::cvt_pk_bf16(s1[2][2], s1[2][3]); b1.z = pg8::cvt_pk_bf16(s1[3][0], s1[3][1]); b1.w = pg8::cvt_pk_bf16(s1[3][2], s1[3][3]);
    const bf16x8 A0 = __builtin_bit_cast(bf16x8, a0), A1 = __builtin_bit_cast(bf16x8, a1), B0 = __builtin_bit_cast(bf16x8, b0), B1 = __builtin_bit_cast(bf16x8, b1);
#pragma unroll
    for (int nt = 0; nt < 8; ++nt) { O[0][nt] = mfma16(vf0[nt], A0, O[0][nt]); O[1][nt] = mfma16(vf0[nt], B0, O[1][nt]); }
#pragma unroll
    for (int nt = 0; nt < 8; ++nt) { O[0][nt] = mfma16(vf1[nt], A1, O[0][nt]); O[1][nt] = mfma16(vf1[nt], B1, O[1][nt]); }
}
__device__ __forceinline__ void attn_unit(const Args& a, int l, float lam, float one_m_li, float bsh, int b, int h, int p, unsigned char* lds, int tid, int wave, int lane) {
    asm volatile("" : "+v"(tid), "+v"(lane));
    const bf16* P = (const bf16*)(a.ws + WS_P); const bf16* VT = (const bf16*)(a.ws + WS_VT); bf16* Y = (bf16*)(a.ws + WS_Y);
    bf16* L0 = (bf16*)lds;
    const int r = lane & 15, g = lane >> 4;
    const int qc = 2 * p + (wave >> 2), nt_all = 2 * p + 2;
    const int tq = 128 * p + 16 * wave + r; const size_t rowb = (size_t)b * T; const size_t vtb = ((size_t)b * 4 + h) * 128 * T;
    const float slope2 = exp2f(-2.f * (float)(h + 1)) * 1.4426950408889634f;
    bf16x8* qb = (bf16x8*)(lds + 2 * AT_BUF * 2) + wave * 256 + lane;
#pragma unroll
    for (int c = 0; c < 2; ++c)
#pragma unroll
        for (int ks = 0; ks < 2; ++ks) qb[(c * 2 + ks) * 64] = *(const bf16x8*)(P + (rowb + tq) * NIN + 1024 + (h * 2 + c) * 64 + ks * 32 + g * 8);
    float lsum[2] = {0.f, 0.f};
    f32x4 O[2][8];
#pragma unroll
    for (int nt = 0; nt < 8; ++nt) { O[0][nt] = (f32x4){0.f, 0.f, 0.f, 0.f}; O[1][nt] = O[0][nt]; }
    u32x4 kr[2], vr[2];
    attn_issue(P, VT, rowb, vtb, h, tid, kr, vr);
    attn_store(L0, tid, kr, vr);
    attn_issue(P, VT, rowb + 64, vtb + 64, h, tid, kr, vr);
    __syncthreads();
    for (int kt = 0; kt < nt_all; ++kt) {
        if (kt + 1 < nt_all) { attn_store(L0 + ((kt + 1) & 1) * AT_BUF, tid, kr, vr);
            if (kt + 2 < nt_all) attn_issue(P, VT, rowb + (size_t)(kt + 2) * 64, vtb + (size_t)(kt + 2) * 64, h, tid, kr, vr); }
        if (kt <= qc) attn_tile(L0 + (kt & 1) * AT_BUF, kt, kt == qc, r, g, tq, slope2, bsh, qb, O, lsum);
        __syncthreads();
    }
    float l0 = lsum[0], l1 = lsum[1];
    l0 += shx(l0, 16); l0 += shx(l0, 32); l1 += shx(l1, 16); l1 += shx(l1, 32);
    const float i0 = 1.f / l0, i1 = lam / l1;
    float ss = 0.f;
#pragma unroll
    for (int nt = 0; nt < 8; ++nt)
#pragma unroll
        for (int j = 0; j < 4; ++j) { const float o = O[0][nt][j] * i0 - O[1][nt][j] * i1; O[0][nt][j] = o; ss += o * o; }
    ss += shx(ss, 16); ss += shx(ss, 32);
    const float sc = rsqrtf(ss * (1.f / 128.f) + 1e-6f) * one_m_li;
    const float* sg = inp(a, 23) + l * 128;
    bf16* yp = Y + (rowb + tq) * 1024 + 256 + h * 128;
#pragma unroll
    for (int nt = 0; nt < 8; ++nt) { const int v0 = nt * 16 + 4 * g; const f32x4 gg = *(const f32x4*)(sg + v0);
        u32x2 w; w.x = pk2(O[0][nt][0] * sc * gg[0], O[0][nt][1] * sc * gg[1]); w.y = pk2(O[0][nt][2] * sc * gg[2], O[0][nt][3] * sc * gg[3]);
        *(u32x2*)(yp + v0) = w; }
}
constexpr int SA_CH = 16, SA_NCH = T / SA_CH, SA_TICKS = 132;
constexpr int SA_SCB = 0, SA_KV = 2 * SA_CH * SC_REC * 4, SA_STAGE = 32768, SA_QB = SA_KV + 2 * SA_STAGE;
static_assert(SA_QB + 4 * 4096 <= LDS_CTL, "LDS map of the fused scan/attention phase");
#define SA_BAR() do { asm volatile("s_waitcnt vmcnt(0) lgkmcnt(0)" ::: "memory"); __builtin_amdgcn_s_barrier(); asm volatile("" ::: "memory"); } while (0)
#define SA_BAR_L() do { asm volatile("s_waitcnt lgkmcnt(0)" ::: "memory"); __builtin_amdgcn_s_barrier(); asm volatile("" ::: "memory"); } while (0)
__device__ __forceinline__ void role_bar(volatile LAS unsigned* cnt, unsigned& target, int lane, bool drain_vm) {
    if (drain_vm) asm volatile("s_waitcnt vmcnt(0) lgkmcnt(0)" ::: "memory"); else asm volatile("s_waitcnt lgkmcnt(0)" ::: "memory");
    target += 4u;
    if (lane == 0) __hip_atomic_fetch_add((LAS unsigned*)cnt, 1u, __ATOMIC_RELAXED, __HIP_MEMORY_SCOPE_WORKGROUP);
    unsigned spins = 0u;
    for (;;) { const unsigned v = (unsigned)__builtin_amdgcn_readfirstlane((int)*cnt); if (v >= target || ++spins > (1u << 18)) break; __builtin_amdgcn_s_sleep(1); }
    asm volatile("s_waitcnt lgkmcnt(0)" ::: "memory");
}
struct ScanPre { h16x8 a0, a1, v; f32x4 w; float sc; };
__device__ __forceinline__ void scanpre_issue(ScanPre& p, const h16* S16, const float* SW, const float* SCAL, size_t tok0, int h, int rg, int stid) {
    constexpr size_t ARR = (size_t)M * 256;
    const int ps = stid >> 7, sq = stid & 127, s = sq >> 3, q = sq & 7;
    const h16* bp = S16 + (size_t)(2 * ps) * ARR + (tok0 + s) * 256 + h * 64 + q * 8;
    p.a0 = *(const h16x8*)bp; p.a1 = *(const h16x8*)(bp + ARR);
    p.w = *(const f32x4*)(SW + (tok0 + (stid >> 4)) * 256 + h * 64 + (stid & 15) * 4);
    if (stid < 32) p.v = *(const h16x8*)(S16 + 4 * ARR + (tok0 + (stid >> 1)) * 256 + h * 64 + rg * 16 + (stid & 1) * 8);
    else if (stid < 64) p.sc = SCAL[((tok0 + ((stid - 32) >> 1)) * 4 + h) * 4 + (stid & 1)];
}
__device__ __forceinline__ void scanpre_store(const ScanPre& p, float* dst, int stid) {
    const int ps = stid >> 7, sq = stid & 127, s = sq >> 3, q = sq & 7;
    float* rec = dst + s * SC_REC + q * 8 + (ps ? 192 : 0);
    st8(rec, p.a0); st8(rec + 64, p.a1);
    *(f32x4*)(dst + (stid >> 4) * SC_REC + 128 + (stid & 15) * 4) = p.w;
    if (stid < 32) st8(dst + (stid >> 1) * SC_REC + 320 + (stid & 1) * 8, p.v);
    else if (stid < 64) dst[((stid - 32) >> 1) * SC_REC + 336 + (stid & 1)] = p.sc;
}
__device__ __forceinline__ void attn_dma(const bf16* P, const bf16* VT, size_t rowk, size_t vtk, int h, int aw, int lane, LAS unsigned char* stage) {
    const int q = (lane & 7) ^ ((lane >> 3) & 7);
    const char* ub; unsigned voff, kstride;
    if (aw < 2) { ub = (const char*)(P + rowk * NIN + 1536 + (h * 2 + aw) * 64); voff = (unsigned)(((lane >> 3) * NIN + q * 8) * 2); kstride = 8u * NIN * 2u; }
    else { ub = (const char*)(VT + vtk + (size_t)(aw - 2) * 64 * T); voff = (unsigned)(((lane >> 3) * T + q * 8) * 2); kstride = 8u * T * 2u; }
#pragma unroll
    for (int k = 0; k < 8; ++k)
        __builtin_amdgcn_global_load_lds((const unsigned*)(ub + (size_t)k * kstride + voff), (LAS unsigned*)(stage + aw * 8192 + k * 1024), 16, 0, 0);
}
__device__ __forceinline__ void attn_tile_sw(const unsigned char* Lb, int kt, bool diag, int r, int g, int tq, float slope2, float bsh, const bf16x8* qb, f32x4 (&O)[2][8], float (&lsum)[2]) {
    const int r7 = r & 7;
    bf16x8 kf0[4][2], kf1[4][2];
#pragma unroll
    for (int k4 = 0; k4 < 4; ++k4)
#pragma unroll
        for (int ks = 0; ks < 2; ++ks) { const int off = ((k4 * 16 + r) * 8 + ((ks * 4 + g) ^ r7)) * 16; kf0[k4][ks] = *(const bf16x8*)(Lb + off); kf1[k4][ks] = *(const bf16x8*)(Lb + 8192 + off); }
    bf16x8 qf[2][2];
#pragma unroll
    for (int c = 0; c < 2; ++c)
#pragma unroll
        for (int ks = 0; ks < 2; ++ks) if (c * 2 + ks < 3) qf[c][ks] = qb[(c * 2 + ks) * 64];
    f32x4 init[4];
    if (diag) {
#pragma unroll
        for (int k4 = 0; k4 < 4; ++k4)
#pragma unroll
            for (int j = 0; j < 4; ++j) init[k4][j] = -slope2 * fabsf((float)(tq - (kt * 64 + k4 * 16 + 4 * g + j))) - bsh;
    } else {
        const float base = slope2 * (float)(kt * 64 + 4 * g - tq) - bsh;
#pragma unroll
        for (int k4 = 0; k4 < 4; ++k4)
#pragma unroll
            for (int j = 0; j < 4; ++j) init[k4][j] = fmaf(slope2, (float)(k4 * 16 + j), base);
    }
    __builtin_amdgcn_sched_barrier(0);
    f32x4 s0[4], s1[4];
#pragma unroll
    for (int k4 = 0; k4 < 4; ++k4) { s0[k4] = mfma16(kf0[k4][0], qf[0][0], init[k4]); s1[k4] = mfma16(kf1[k4][0], qf[1][0], init[k4]); s0[k4] = mfma16(kf0[k4][1], qf[0][1], s0[k4]); }
    __builtin_amdgcn_sched_barrier(0);
    bf16x8 vf0[8], vf1[8];
#pragma unroll
    for (int nt = 0; nt < 8; ++nt) vf0[nt] = *(const bf16x8*)(Lb + 16384 + (nt * 16 + r) * 128 + ((g ^ r7) * 16));
    __builtin_amdgcn_sched_barrier(0);
    qf[1][1] = qb[3 * 64];
    float p0 = 0.f, p1 = 0.f;
    unsigned pa[8], pbk[8];
#pragma unroll
    for (int k4 = 0; k4 < 4; ++k4) {
        s1[k4] = mfma16(kf1[k4][1], qf[1][1], s1[k4]);
#pragma unroll
        for (int j = 0; j < 4; ++j) { s0[k4][j] = __builtin_amdgcn_exp2f(s0[k4][j]); p0 += s0[k4][j]; }
        pa[2 * k4] = pg8::cvt_pk_bf16(s0[k4][0], s0[k4][1]); pa[2 * k4 + 1] = pg8::cvt_pk_bf16(s0[k4][2], s0[k4][3]);
        __builtin_amdgcn_sched_barrier(0);
    }
    const bf16x8 A0 = __builtin_bit_cast(bf16x8, (u32x4){pa[0], pa[1], pa[2], pa[3]}), A1 = __builtin_bit_cast(bf16x8, (u32x4){pa[4], pa[5], pa[6], pa[7]});
#pragma unroll
    for (int nt = 0; nt < 8; ++nt) vf1[nt] = *(const bf16x8*)(Lb + 16384 + (nt * 16 + r) * 128 + (((4 + g) ^ r7) * 16));
    __builtin_amdgcn_sched_barrier(0);
#pragma unroll
    for (int k4 = 0; k4 < 4; ++k4) {
#pragma unroll
        for (int q = 0; q < 4; ++q) { const int nt = (4 * k4 + q) & 7; if (k4 < 2) O[0][nt] = mfma16(vf0[nt], A0, O[0][nt]); else O[0][nt] = mfma16(vf1[nt], A1, O[0][nt]); }
#pragma unroll
        for (int j = 0; j < 4; ++j) { s1[k4][j] = __builtin_amdgcn_exp2f(s1[k4][j]); p1 += s1[k4][j]; }
        pbk[2 * k4] = pg8::cvt_pk_bf16(s1[k4][0], s1[k4][1]); pbk[2 * k4 + 1] = pg8::cvt_pk_bf16(s1[k4][2], s1[k4][3]);
        __builtin_amdgcn_sched_barrier(0);
    }
    lsum[0] += p0; lsum[1] += p1;
    const bf16x8 B0 = __builtin_bit_cast(bf16x8, (u32x4){pbk[0], pbk[1], pbk[2], pbk[3]}), B1 = __builtin_bit_cast(bf16x8, (u32x4){pbk[4], pbk[5], pbk[6], pbk[7]});
#pragma unroll
    for (int nt = 0; nt < 8; ++nt) { O[1][nt] = mfma16(vf0[nt], B0, O[1][nt]); O[1][nt] = mfma16(vf1[nt], B1, O[1][nt]); }
}
__device__ __forceinline__ void phase_scan_attn(const Args& a, int l, unsigned char* lds, int tid, int wave, int lane) {
    for (int w0 = blockIdx.x; w0 < 256; w0 += gridDim.x) {
        asm volatile("" : "+v"(tid), "+v"(lane));
        const int w = (gridDim.x == 256) ? ((w0 & 7) * 32 + (w0 >> 3)) : w0;
        const int bh = w >> 2, sub = w & 3, b = bh >> 2, h = bh & 3;
        const size_t tokb = (size_t)b * T;
        volatile LAS unsigned* rcnt = (volatile LAS unsigned*)((LAS unsigned char*)lds + LDS_CTL - 64);
        if (tid < 8) rcnt[tid] = 0u;
        __syncthreads();
        unsigned rtarget = 0u;
        if (wave < 4) {
            const h16* S16 = (const h16*)(a.ws + WS_S16); const float* SW = (const float*)(a.ws + WS_SW); const float* SCAL = (const float*)(a.ws + WS_SCAL); float* YR = (float*)(a.ws + WS_YR);
            float* scb = (float*)(lds + SA_SCB);
            const int rg = sub, rowl = wave * 4 + (lane >> 4), jq = lane & 15;
            ScanPre pre; pre.a0 = (h16x8)(h16)0.f; pre.a1 = pre.a0; pre.v = pre.a0; pre.w = (f32x4){0.f, 0.f, 0.f, 0.f}; pre.sc = 0.f;
            scanpre_issue(pre, S16, SW, SCAL, tokb, h, rg, tid); scanpre_store(pre, scb, tid);
            role_bar(rcnt, rtarget, lane, false);
            f32x4 S = {0.f, 0.f, 0.f, 0.f}; float yk = 0.f;
            float* yout = YR + (tokb + jq) * 256 + h * 64 + rg * 16 + rowl;
#pragma unroll 1
            for (int i = 0; i < SA_TICKS; ++i) {
                if (i < SA_NCH) {
                    if (i + 1 < SA_NCH) scanpre_issue(pre, S16, SW, SCAL, tokb + (size_t)(i + 1) * SA_CH, h, rg, tid);
                    const float* src = scb + (i & 1) * SA_CH * SC_REC;
                    ScanOps A, B;
                    scan_ld(A, src, jq, rowl);
#pragma unroll
                    for (int s_ = 0; s_ < SA_CH; s_ += 2) {
                        scan_ld(B, src + (s_ + 1) * SC_REC, jq, rowl);
                        scan_step(S, yk, A, jq, s_);
                        if (s_ + 2 < SA_CH) scan_ld(A, src + (s_ + 2) * SC_REC, jq, rowl);
                        scan_step(S, yk, B, jq, s_ + 1);
                    }
                    yout[(size_t)(i * SA_CH) * 256] = yk;
                    if (i + 1 < SA_NCH) scanpre_store(pre, scb + ((i + 1) & 1) * SA_CH * SC_REC, tid);
                }
                role_bar(rcnt, rtarget, lane, false);
            }
        } else {
            const bf16* P = (const bf16*)(a.ws + WS_P); const bf16* VT = (const bf16*)(a.ws + WS_VT); bf16* Y = (bf16*)(a.ws + WS_Y);
            float s1 = 0.f, s2 = 0.f, mq = 0.f, mk = 0.f;
            for (int i = 0; i < 64; ++i) { s1 += inp(a, 19)[l * 64 + i] * inp(a, 20)[l * 64 + i]; s2 += inp(a, 21)[l * 64 + i] * inp(a, 22)[l * 64 + i];
                mq = fmaxf(mq, fabsf(inp(a, 17)[l * 64 + i])); mk = fmaxf(mk, fabsf(inp(a, 18)[l * 64 + i])); }
            const float li = __builtin_bit_cast(float, __builtin_amdgcn_readfirstlane(l == 0 ? 0x3e4ccccd : 0x3eb60549));
            const float lam = __builtin_bit_cast(float, __builtin_amdgcn_readfirstlane(__builtin_bit_cast(int, expf(s1) - expf(s2) + li))), one_m_li = 1.f - li;
            const float bsh = __builtin_bit_cast(float, __builtin_amdgcn_readfirstlane(__builtin_bit_cast(int, 8.f * mq * mk * 1.4426950408889634f)));
            const int aw = wave - 4, r = lane & 15, g = lane >> 4;
            const size_t vtb = ((size_t)b * 4 + h) * 128 * T;
            const float slope2 = exp2f(-2.f * (float)(h + 1)) * 1.4426950408889634f;
            LAS unsigned char* kv = (LAS unsigned char*)lds + SA_KV;
            bf16x8* qb = (bf16x8*)(lds + SA_QB) + aw * 256 + lane;
            const float* sg = inp(a, 23) + l * 128;
            attn_dma(P, VT, tokb, vtb, h, aw, lane, kv);
            role_bar(rcnt + 4, rtarget, lane, true);
            int ti = 0;
#pragma unroll 1
            for (int u = 0; u < 8; ++u) {
                const int pq = sub * 4 + (u >> 1), qc = (u & 1) ? 31 - pq : pq;
                const int pqn = sub * 4 + ((u + 1) >> 1);
                const int tq = qc * 64 + aw * 16 + r;
#pragma unroll
                for (int c = 0; c < 2; ++c)
#pragma unroll
                    for (int ks = 0; ks < 2; ++ks) qb[(c * 2 + ks) * 64] = *(const bf16x8*)(P + (tokb + tq) * NIN + 1024 + (h * 2 + c) * 64 + ks * 32 + g * 8);
                float lsum[2] = {0.f, 0.f};
                f32x4 O[2][8];
#pragma unroll
                for (int nt = 0; nt < 8; ++nt) { O[0][nt] = (f32x4){0.f, 0.f, 0.f, 0.f}; O[1][nt] = O[0][nt]; }
#pragma unroll 1
                for (int kt = 0; kt <= qc; ++kt) {
                    const int ktn = kt < qc ? kt + 1 : 0;
                    if (kt < qc || u < 7) attn_dma(P, VT, tokb + (size_t)ktn * 64, vtb + (size_t)ktn * 64, h, aw, lane, kv + ((ti + 1) & 1) * SA_STAGE);
                    attn_tile_sw((const unsigned char*)lds + SA_KV + (ti & 1) * SA_STAGE, kt, kt == qc, r, g, tq, slope2, bsh, qb, O, lsum);
                    if (kt == qc) {
                        float l0 = lsum[0], l1 = lsum[1];
                        l0 += shx(l0, 16); l0 += shx(l0, 32); l1 += shx(l1, 16); l1 += shx(l1, 32);
                        const float i0 = 1.f / l0, i1 = lam / l1;
                        float ss = 0.f;
#pragma unroll
                        for (int nt = 0; nt < 8; ++nt)
#pragma unroll
                            for (int j = 0; j < 4; ++j) { const float o = O[0][nt][j] * i0 - O[1][nt][j] * i1; O[0][nt][j] = o; ss += o * o; }
                        ss += shx(ss, 16); ss += shx(ss, 32);
                        const float sc = rsqrtf(ss * (1.f / 128.f) + 1e-6f) * one_m_li;
                        bf16* yp = Y + (tokb + tq) * 1024 + 256 + h * 128;
#pragma unroll
                        for (int nt = 0; nt < 8; ++nt) { const int v0 = nt * 16 + 4 * g; const f32x4 gg = *(const f32x4*)(sg + v0);
                            u32x2 wv; wv.x = pk2(O[0][nt][0] * sc * gg[0], O[0][nt][1] * sc * gg[1]); wv.y = pk2(O[0][nt][2] * sc * gg[2], O[0][nt][3] * sc * gg[3]);
                            *(u32x2*)(yp + v0) = wv; }
                    }
                    role_bar(rcnt + 4, rtarget, lane, true); ++ti;
                }
                (void)pqn;
            }
        }
        __syncthreads();
    }
}
__device__ __forceinline__ void conv_unit(const Args& a, int l, int b, int t0, unsigned char* lds, int tid, int wave, int lane) {
    const bf16* P = (const bf16*)(a.ws + WS_P); bf16* Y = (bf16*)(a.ws + WS_Y);
    constexpr int HP = 264, OP = 260;
    bf16* hb = (bf16*)lds;
    float* ob = (float*)(lds + 94 * HP * 2);
    asm volatile("" : "+v"(tid), "+v"(lane));
    const size_t rowb = (size_t)b * T;
    for (int ch = tid; ch < 94 * 32; ch += 512) { const int rr = ch >> 5, cc = ch & 31; const int t = t0 - 30 + rr;
        u32x4 v = {0u, 0u, 0u, 0u};
        if (t >= 0) v = *(const u32x4*)(P + (rowb + t) * NIN + 2560 + cc * 8);
        *(u32x4*)(hb + rr * HP + cc * 8) = v; }
    __syncthreads();
    const int cp = tid & 127, tg = tid >> 7;
    const float* cw = inp(a, 24) + (size_t)l * 31 * 256 + 2 * cp;
    const f32x2 cb = *(const f32x2*)(inp(a, 25) + l * 256 + 2 * cp);
    float acc0[16], acc1[16];
#pragma unroll
    for (int i = 0; i < 16; ++i) { acc0[i] = cb[0]; acc1[i] = cb[1]; }
    f32x2 wv[31];
#pragma unroll
    for (int w = 0; w < 31; ++w) wv[w] = *(const f32x2*)(cw + w * 256);
#pragma unroll
    for (int rho = 0; rho < 46; ++rho) { const unsigned hv = *(const unsigned*)(hb + (tg * 16 + rho) * HP + 2 * cp); const float h0 = bflo(hv), h1 = bfhi(hv);
#pragma unroll
        for (int i = 0; i < 16; ++i) { const int w = rho - i; if (w >= 0 && w < 31) { acc0[i] += h0 * wv[w][0]; acc1[i] += h1 * wv[w][1]; } } }
#pragma unroll
    for (int i = 0; i < 16; ++i) *(f32x2*)(ob + (tg * 16 + i) * OP + 2 * cp) = (f32x2){acc0[i], acc1[i]};
    __syncthreads();
    const f32x4 lw = *(const f32x4*)(inp(a, 26) + l * 256 + 4 * lane), lb = *(const f32x4*)(inp(a, 27) + l * 256 + 4 * lane);
    for (int i = 0; i < 8; ++i) { const int tok = wave * 8 + i;
        const f32x4 x = *(const f32x4*)(ob + tok * OP + 4 * lane);
        const float mu = wave_sum((x[0] + x[1]) + (x[2] + x[3])) * (1.f / 256.f);
        const f32x4 d = x - mu;
        const float var = wave_sum((d[0] * d[0] + d[1] * d[1]) + (d[2] * d[2] + d[3] * d[3])) * (1.f / 256.f);
        const f32x4 y = d * rsqrtf(var + 1e-5f) * lw + lb;
        u32x2 w; w.x = pk2(y[0] * sigmoidf_(y[0]), y[1] * sigmoidf_(y[1])); w.y = pk2(y[2] * sigmoidf_(y[2]), y[3] * sigmoidf_(y[3]));
        *(u32x2*)(Y + (rowb + t0 + tok) * 1024 + 768 + 4 * lane) = w; }
    __syncthreads();
}
__device__ __forceinline__ void phase_mix(const Args& a, int l, unsigned char* lds, int tid, int wave, int lane) {
    for (int u = blockIdx.x; u < 512; u += gridDim.x) conv_unit(a, l, u >> 5, (u & 31) * 64, lds, tid, wave, lane);
    const float* YR = (const float*)(a.ws + WS_YR); const h16* SV = (const h16*)(a.ws + WS_S16) + 4 * (size_t)M * 256; const bf16* G = (const bf16*)(a.ws + WS_G);
    const float* SCAL = (const float*)(a.ws + WS_SCAL); bf16* Y = (bf16*)(a.ws + WS_Y);
    const f32x4 lw = *(const f32x4*)(inp(a, 15) + l * 256 + 4 * lane), lb = *(const f32x4*)(inp(a, 16) + l * 256 + 4 * lane);
    const int gw = blockIdx.x * 8 + wave, NGW = gridDim.x * 8, tpw = ((M + NGW - 1) / NGW + 3) & ~3;
    const int tend = (gw + 1) * tpw < M ? (gw + 1) * tpw : M;
    for (int t0_ = gw * tpw; t0_ < tend; t0_ += 4) {
        f32x4 y[4]; h16x4 v[4]; u32x2 gv[4]; float bn[4];
#pragma unroll
        for (int i = 0; i < 4; ++i) { const size_t tok = (size_t)(t0_ + i);
            y[i] = *(const f32x4*)(YR + tok * 256 + 4 * lane); v[i] = *(const h16x4*)(SV + tok * 256 + 4 * lane); gv[i] = *(const u32x2*)(G + tok * 256 + 4 * lane);
            bn[i] = SCAL[(tok * 4 + (lane >> 4)) * 4 + 2]; }
#pragma unroll
        for (int i = 0; i < 4; ++i) {
            const float mu = rowsum16((y[i][0] + y[i][1]) + (y[i][2] + y[i][3])) * (1.f / 64.f);
            const f32x4 d = y[i] - mu;
            const float var = rowsum16((d[0] * d[0] + d[1] * d[1]) + (d[2] * d[2] + d[3] * d[3])) * (1.f / 64.f);
            const f32x4 yn = d * rsqrtf(var + 64e-5f) * lw + lb;
            u32x2 w; w.x = pk2((yn[0] + bn[i] * (float)v[i][0]) * bflo(gv[i].x), (yn[1] + bn[i] * (float)v[i][1]) * bfhi(gv[i].x));
            w.y = pk2((yn[2] + bn[i] * (float)v[i][2]) * bflo(gv[i].y), (yn[3] + bn[i] * (float)v[i][3]) * bfhi(gv[i].y));
            *(u32x2*)(Y + (size_t)(t0_ + i) * 1024 + 4 * lane) = w; }
    }
}

#define XB_TMO      128
#define XB_XCNT(j)  (256  + 64 * (j))
#define XB_XSUB(j)  (1280 + 64 * (j))
#define XB_XGEN(j)  (2304 + 64 * (j))
#define XB_TOP      3328
#define XB_TOPGEN   3392
#define XCD_BAR_WORDS 3456
#define XB_SPIN_CAP (1u << 18)

__device__ __forceinline__ unsigned xb_ld(unsigned* p)              { return __hip_atomic_load(p, __ATOMIC_RELAXED, __HIP_MEMORY_SCOPE_AGENT); }
__device__ __forceinline__ unsigned xb_add(unsigned* p, unsigned v) { return __hip_atomic_fetch_add(p, v, __ATOMIC_RELAXED, __HIP_MEMORY_SCOPE_AGENT); }
__device__ __forceinline__ unsigned xb_xcc_id() { return (unsigned)__builtin_amdgcn_s_getreg((3 << 11) | 20) & 0xFu; }
#define XB_SPIN(cond, bar) do { unsigned _sp = 0; while (cond) { __builtin_amdgcn_s_sleep(1); \
    if ((++_sp & 255u) == 0u) { if (xb_ld(&(bar)[XB_TMO])) break; if (_sp > XB_SPIN_CAP) { atomicAdd(&(bar)[XB_TMO], 1u); break; } } } } while (0)

struct XcdBarrier {
    unsigned* bar; unsigned x;
    volatile LAS unsigned* st;
};

__device__ __forceinline__ XcdBarrier xcd_barrier_post(unsigned* bar, volatile LAS unsigned* st) {
    XcdBarrier b; b.bar = bar; b.x = xb_xcc_id(); b.st = st;
    if (threadIdx.x == 0) (void)xb_add(&bar[XB_XCNT(b.x)], 1u);
    return b;
}
__device__ __forceinline__ void xcd_barrier_complete(unsigned* bar, unsigned x, unsigned& nloc, unsigned& nx) {
    const unsigned G = gridDim.x * gridDim.y * gridDim.z;
    unsigned sum, cnt, mine, sp = 0u;
    for (;;) {
        sum = 0u; cnt = 0u; mine = 0u;
#pragma unroll
        for (unsigned j = 0; j < 16; ++j) { const unsigned c = xb_ld(&bar[XB_XCNT(j)]); sum += c; cnt += (c > 0u) ? 1u : 0u; mine = (j == x) ? c : mine; }
        if (sum == G) break;
        __builtin_amdgcn_s_sleep(1);
        if ((++sp & 255u) == 0u) { if (xb_ld(&bar[XB_TMO])) break; if (sp > XB_SPIN_CAP) { atomicAdd(&bar[XB_TMO], 1u); break; } }
    }
    nloc = mine > 0u ? mine : 1u; nx = cnt > 0u ? cnt : 1u;
}

__device__ __forceinline__ void xcd_barrier(const XcdBarrier& b) {
    asm volatile("s_waitcnt vmcnt(0)" ::: "memory");
    __syncthreads();
    if (threadIdx.x == 0) {
        unsigned* bar = b.bar;
        __builtin_amdgcn_s_waitcnt(0);
        unsigned nloc = b.st[0], nx = b.st[1];
        if (nloc == 0u) { xcd_barrier_complete(bar, b.x, nloc, nx); b.st[0] = nloc; b.st[1] = nx; }
        const unsigned old = xb_add(&bar[XB_XSUB(b.x)], 1u);
        const unsigned gen = old / nloc;
        if (old + 1u == (gen + 1u) * nloc) {
            __builtin_amdgcn_fence(__ATOMIC_RELEASE, "agent");
            asm volatile("s_waitcnt vmcnt(0)" ::: "memory");
            const unsigned og = xb_add(&bar[XB_TOP], 1u);
            const unsigned tg = og / nx;
            if (og + 1u == (tg + 1u) * nx) xb_add(&bar[XB_TOPGEN], 1u);
            else XB_SPIN(xb_ld(&bar[XB_TOPGEN]) == tg, bar);
            __builtin_amdgcn_fence(__ATOMIC_ACQUIRE, "agent");
            xb_add(&bar[XB_XGEN(b.x)], 1u);
            asm volatile("s_waitcnt vmcnt(0)" ::: "memory");
        } else {
            XB_SPIN(xb_ld(&bar[XB_XGEN(b.x)]) == gen, bar);
            __builtin_amdgcn_fence(__ATOMIC_ACQUIRE, "agent");
            asm volatile("s_waitcnt vmcnt(0)" ::: "memory");
        }
    }
    __syncthreads();
}

__global__ void __launch_bounds__(512, 2) mk_fwd(Args a) {
    extern __shared__ __attribute__((aligned(16))) unsigned char lds[];
    cg::grid_group grid = cg::this_grid();
    const int wave_s = __builtin_amdgcn_readfirstlane((int)threadIdx.x >> 6);
#define TIDS int lane_ = __builtin_amdgcn_mbcnt_hi(~0u, __builtin_amdgcn_mbcnt_lo(~0u, 0u)); asm volatile("" : "+v"(lane_)); const int lane = lane_, wave = wave_s; int tid = wave * 64 + lane; (void)lane; (void)wave; (void)tid
    unsigned* barw = (unsigned*)(a.ws + WS_BAR);
    if (a.ph_lo == 0 && blockIdx.x == 0) for (int i = threadIdx.x; i < XCD_BAR_WORDS; i += 512) barw[i] = 0u;
    if (threadIdx.x < 2) ((volatile LAS unsigned*)(lds + LDS_CTL))[threadIdx.x] = 0u;
    __syncthreads();
    XcdBarrier xbar; xbar.bar = barw; xbar.x = 0; xbar.st = (volatile LAS unsigned*)(lds + LDS_CTL);
    bool posted = false;
    if (a.ph_lo == 0 && a.ph_hi > 1) { grid.sync(); xbar = xcd_barrier_post(barw, (volatile LAS unsigned*)(lds + LDS_CTL)); posted = true; }
#pragma unroll 1
    for (int ph = a.ph_lo; ph < a.ph_hi; ++ph) {
        if (ph == 0) { { TIDS; phase_weights(a, lds, wave, lane); } __syncthreads(); { TIDS; phase_ada(a, lds, tid, wave, lane); } }
        else {
            const int l = (ph - 1) / 9, k = (ph - 1) % 9;
            const float* modl = (const float*)(a.ws + WS_MOD) + (size_t)l * 16 * 6144;
            if (k == 6 || (k == 0 && l == 1)) continue;
            if (k == 1 || k == 5 || k == 7 || k == 8) {
                const unsigned char* wb = a.ws + WS_WB + (size_t)l * WB_LAYER;
                pg8::Gemm g; pg8::EpiDyn E; E.O = nullptr; E.ldc = 0; E.base = nullptr; E.out = nullptr; E.gate = nullptr;
                E.ssq_in = nullptr; E.bias = nullptr; E.bstride = 0; E.rtab = nullptr; E.XS = nullptr; E.ssq_out = nullptr; E.gn = nullptr; E.scv = nullptr;
                const float* BIAS = (const float*)(a.ws + WS_BIAS);
                if (k == 1) { g.A = (const bf16*)(a.ws + WS_XN); g.Bt = (const bf16*)(wb + WB_IN); g.N = NIN; g.K = D; E.kind = 0; E.O = (bf16*)(a.ws + WS_P); E.ldc = NIN;
                    if (l == 1) { E.ssq_in = (const float*)(a.ws + WS_SSQA); E.bias = BIAS; E.bstride = NIN; } }
                else if (k == 5) { g.A = (const bf16*)(a.ws + WS_Y); g.Bt = (const bf16*)(wb + WB_OUT); g.N = D; g.K = D; E.kind = 2; E.base = l == 0 ? inp(a, 0) : a.out; E.out = a.out; E.gate = modl + 2048;
                    E.XS = (bf16*)(a.ws + WS_XN); E.ssq_out = (float*)(a.ws + WS_SSQB); E.gn = inp(a, 29) + l * 1024; E.scv = modl + 4096; }
                else if (k == 7) { g.A = (const bf16*)(a.ws + WS_XN); g.Bt = (const bf16*)(wb + WB_W1); g.N = FF; g.K = D; E.kind = 1; E.O = (bf16*)(a.ws + WS_H); E.ldc = FF;
                    E.ssq_in = (const float*)(a.ws + WS_SSQB); E.bias = BIAS + 16 * NIN + (size_t)l * 16 * FF; E.bstride = FF; }
                else { g.A = (const bf16*)(a.ws + WS_H); g.Bt = (const bf16*)(wb + WB_W2); g.N = D; g.K = FF; E.kind = 2; E.base = a.out; E.out = a.out; E.gate = modl + 5120;
                    if (l == 0) { E.XS = (bf16*)(a.ws + WS_XN); E.ssq_out = (float*)(a.ws + WS_SSQA); E.gn = inp(a, 4) + 1024; E.scv = (const float*)(a.ws + WS_MOD) + (size_t)16 * 6144 + 1024; } }
                g.M = M;
                pg8::StaticOrder S; S.init(M, g.N, gridDim.x, blockIdx.x);
                E.rtab = (const LAS float*)((LAS unsigned char*)lds + 131072);
                if (E.ssq_in) { TIDS;
                    LAS float* rt = (LAS float*)((LAS unsigned char*)lds + 131072);
                    for (int idx = tid; idx < 8 * 256; idx += 512) { pg8::Unit u_; if (!S.next(idx >> 8, u_)) break;
                        const f32x4* sp = (const f32x4*)(E.ssq_in + (size_t)(u_.pm * 256 + (idx & 255)) * 16); const f32x4 t = (sp[0] + sp[1]) + (sp[2] + sp[3]);
                        rt[idx] = rsqrtf(((t[0] + t[1]) + (t[2] + t[3])) * (1.f / 1024.f) + 1e-6f); }
                    __syncthreads(); }
                { TIDS; pg8::gemm_phase<pg8::EpiDyn, pg8::StaticOrder, true, true>((LAS unsigned char*)lds, g, S, E, tid); }
            }
            else if (k == 0) { TIDS; phase_xn(inp(a, 0), inp(a, 4), modl, 0, 1024, (bf16*)(a.ws + WS_XN), wave, lane); phase_bias(a, wave, lane); }
            else if (k == 2) { TIDS; phase_premix(a, l, lds, tid, wave, lane); }
            else if (k == 3) { TIDS; phase_scan_attn(a, l, lds, tid, wave, lane); }
            else { TIDS; phase_mix(a, l, lds, tid, wave, lane); }
        }
        if (ph + 1 < a.ph_hi) {
            if (!posted) { grid.sync(); xbar = xcd_barrier_post(barw, (volatile LAS unsigned*)(lds + LDS_CTL)); posted = true; }
            else xcd_barrier(xbar);
        }
    }
}

#ifndef MK_MULTI
#define MK_MULTI 0
#endif
extern "C" void kernel_launch(void* const* d_in, const int* in_sizes, int n_in, void* d_out, int out_size, void* d_ws, size_t ws_size, hipStream_t stream) {
    static int grid = 0;
    if (grid == 0) {
        if (n_in != 32 || out_size != M * D || ws_size < WS_END) { fprintf(stderr, "kernel_launch: unexpected shapes (n_in %d out %d ws %zu)\n", n_in, out_size, ws_size); grid = -1; return; }
        int dev = 0, cus = 0, per_cu = 0;
        (void)hipGetDevice(&dev); (void)hipDeviceGetAttribute(&cus, hipDeviceAttributeMultiprocessorCount, dev);
        (void)hipFuncSetAttribute((const void*)mk_fwd, hipFuncAttributeMaxDynamicSharedMemorySize, LDS_BYTES);
        (void)hipOccupancyMaxActiveBlocksPerMultiprocessor(&per_cu, (const void*)mk_fwd, 512, LDS_BYTES);
        if (per_cu < 1) { fprintf(stderr, "kernel_launch: occupancy query says %d blocks per CU\n", per_cu); per_cu = 1; }
        grid = cus * per_cu;
        (void)hipGetLastError();
    }
    if (grid < 0) return;
    Args a{};
    for (int i = 0; i < 32; ++i) a.in[i] = (const float*)d_in[i];
    a.out = (float*)d_out; a.ws = (unsigned char*)d_ws;
#if MK_MULTI
    for (int p = 0; p < 19; ++p) { a.ph_lo = p; a.ph_hi = p + 1; hipLaunchKernelGGL(mk_fwd, dim3(grid), dim3(512), LDS_BYTES, stream, a); }
#else
    a.ph_lo = 0; a.ph_hi = 19;
    void* args[] = {&a};
    hipError_t e = hipLaunchCooperativeKernel((const void*)mk_fwd, dim3(grid), dim3(512), args, LDS_BYTES, stream);
    if (e != hipSuccess) fprintf(stderr, "cooperative launch failed: %s (grid %d)\n", hipGetErrorString(e), grid);
#endif
}
```

```cpp
#include <hip/hip_runtime.h>
#include <hip/hip_cooperative_groups.h>
#include <hip/hip_fp16.h>
#include <cstdio>
#include <cstdint>
namespace cg = cooperative_groups;
namespace pg8 {
#define PG8_LAS __attribute__((address_space(3)))
typedef unsigned short bf16_t;
typedef short bf16x8 __attribute__((ext_vector_type(8)));
typedef float f32x4 __attribute__((ext_vector_type(4)));
typedef unsigned u32x4 __attribute__((ext_vector_type(4)));
constexpr int BM = 256, BK = 64, HALF = 128, HTB = HALF * BK * 2  , STAGE_BYTES = 8 * HTB, NXCD = 8, WGM = 8;

__host__ __device__ __forceinline__ int lds_byte(int r, int c) { const int st = (r >> 4) * 2 + (c >> 5), rr = r & 15, cc = c & 31, ob = rr * 64 + cc * 2; return st * 1024 + (ob ^ (((ob >> 9) & 1) << 5)); }
__host__ __device__ __forceinline__ void stage_rc(int b, int& R, int& C) { const int st = b / 1024, sb = b % 1024, swz = sb ^ (((sb >> 9) & 1) << 5); R = (st >> 1) * 16 + swz / 64; C = (st & 1) * 32 + (swz % 64) / 2; }
__host__ __device__ __forceinline__ int perm32(int rho) { const int n = rho >> 4, i = rho & 15; return 8 * (i >> 2) + 4 * n + (i & 3); }

struct Unit { int pm, pn; };
struct Gemm { const bf16_t* A; const bf16_t* Bt; int M, N, K; };

struct StaticOrder {
    int nM, nN, nwg, G, c;
    __host__ __device__ void init(int M, int N, int G_, int c_) { nM = M / BM; nN = N / BM; nwg = nM * nN; G = G_; c = c_; }
    __host__ __device__ bool next(int i, Unit& u) const {
        const long L = (long)i * G + c; if (L >= nwg) return false;
        int wgid = (int)L; { const int q = nwg / NXCD, r = nwg % NXCD, xcd = wgid % NXCD, off = wgid / NXCD; wgid = (xcd < r ? xcd * (q + 1) : r * (q + 1) + (xcd - r) * q) + off; }
        const int nig = WGM * nN, gid = wgid / nig, fm = gid * WGM, gsz = (nM - fm) < WGM ? (nM - fm) : WGM;
        u.pm = fm + ((wgid % nig) % gsz); u.pn = (wgid % nig) / gsz; return true;
    }
    __device__ __forceinline__ void a_ready(const Unit&) const {}
    __device__ __forceinline__ void done(const Unit&) const {}
};

typedef __bf16 bf16x2_t __attribute__((ext_vector_type(2)));
typedef float f32x2_t __attribute__((ext_vector_type(2)));
__device__ __forceinline__ unsigned cvt_pk_bf16(float lo, float hi) { const f32x2_t v = {lo, hi}; return __builtin_bit_cast(unsigned, __builtin_convertvector(v, bf16x2_t)); }
template <int ACT  > struct EpiAct {
    static constexpr bool PERM = true, AFTER_DRAIN = false;
    bf16_t* O; int ldc;
    __device__ __forceinline__ void operator()(const f32x4 (&acc)[2][2][4][2], const Unit& u, int wr, int wc, int fr, int fq) const {
        const int row0 = u.pm * BM + wr * 64 + fr; const int col0 = u.pn * BM + wc * 32 + 8 * fq;
#pragma unroll
        for (int ai = 0; ai < 2; ++ai)
#pragma unroll
            for (int m = 0; m < 4; ++m) { bf16_t* rowp = O + (size_t)(row0 + ai * HALF + m * 16) * ldc + col0;
#pragma unroll
                for (int bj = 0; bj < 2; ++bj) { f32x4 v0 = acc[ai][bj][m][0], v1 = acc[ai][bj][m][1];
                    if (ACT == 1) {
#pragma unroll
                        for (int e = 0; e < 4; ++e) { float a = fmaxf(v0[e], 0.f), b = fmaxf(v1[e], 0.f); v0[e] = a * a; v1[e] = b * b; } }
                    u32x4 w; w.x = cvt_pk_bf16(v0[0], v0[1]); w.y = cvt_pk_bf16(v0[2], v0[3]); w.z = cvt_pk_bf16(v1[0], v1[1]); w.w = cvt_pk_bf16(v1[2], v1[3]);
                    *(u32x4*)(rowp + bj * HALF) = w; } }
    }
};
struct EpiRes {
    static constexpr bool PERM = false, AFTER_DRAIN = false;
    const float* base; float* out; const float* gate;
    __device__ __forceinline__ void operator()(const f32x4 (&acc)[2][2][4][2], const Unit& u, int wr, int wc, int fr, int fq) const {
        const int col0 = u.pn * BM + wc * 32 + 4 * fq;
        const float* gp = gate + (size_t)((u.pm * BM) >> 11) * 6144 + col0;
        f32x4 gv[2][2];
#pragma unroll
        for (int bj = 0; bj < 2; ++bj)
#pragma unroll
            for (int n = 0; n < 2; ++n) gv[bj][n] = *(const f32x4*)(gp + bj * HALF + n * 16);
#pragma unroll
        for (int ai = 0; ai < 2; ++ai)
#pragma unroll
            for (int m = 0; m < 4; ++m) { const size_t off = (size_t)(u.pm * BM + ai * HALF + wr * 64 + m * 16 + fr) * 1024 + col0;
#pragma unroll
                for (int bj = 0; bj < 2; ++bj)
#pragma unroll
                    for (int n = 0; n < 2; ++n) { const f32x4 bs = *(const f32x4*)(base + off + bj * HALF + n * 16);
                        *(f32x4*)(out + off + bj * HALF + n * 16) = bs + gv[bj][n] * acc[ai][bj][m][n]; } }
    }
};
typedef unsigned u32x2_ __attribute__((ext_vector_type(2)));
__device__ __forceinline__ float shx_(float v, int m) { int l = __builtin_amdgcn_mbcnt_hi(~0u, __builtin_amdgcn_mbcnt_lo(~0u, 0u)); asm volatile("" : "+v"(l));
    return __builtin_bit_cast(float, __builtin_amdgcn_ds_bpermute((l ^ m) << 2, __builtin_bit_cast(int, v))); }
struct EpiDyn {
    static constexpr bool PERM = true, AFTER_DRAIN = false;
    int kind; bf16_t* O; int ldc; const float* base; float* out; const float* gate;
    const float* ssq_in; const float* bias; int bstride; const PG8_LAS float* rtab;
    bf16_t* XS; float* ssq_out; const float* gn; const float* scv;
    __device__ __forceinline__ void operator()(const f32x4 (&acc)[2][2][4][2], const Unit& u, int wr, int wc, int fr, int fq, int ui) const {
        const int row0 = u.pm * BM + wr * 64 + fr; const int col0 = u.pn * BM + wc * 32 + 8 * fq; const int b = (u.pm * BM) >> 11;
        if (kind < 2) {
            f32x4 bv[2][2];
#pragma unroll
            for (int bj = 0; bj < 2; ++bj)
#pragma unroll
                for (int n = 0; n < 2; ++n) bv[bj][n] = ssq_in ? *(const f32x4*)(bias + (size_t)b * bstride + col0 + bj * HALF + n * 4) : (f32x4){0.f, 0.f, 0.f, 0.f};
#pragma unroll
            for (int ai = 0; ai < 2; ++ai)
#pragma unroll
                for (int m = 0; m < 4; ++m) { const int row = row0 + ai * HALF + m * 16; bf16_t* rowp = O + (size_t)row * ldc + col0;
                    float rstd = 1.f;
                    if (ssq_in) rstd = rtab[ui * 256 + wr * 64 + fr + ai * HALF + m * 16];
#pragma unroll
                    for (int bj = 0; bj < 2; ++bj) { f32x4 v0 = acc[ai][bj][m][0] * rstd + bv[bj][0], v1 = acc[ai][bj][m][1] * rstd + bv[bj][1];
                        if (kind == 1) {
#pragma unroll
                            for (int e = 0; e < 4; ++e) { float a = fmaxf(v0[e], 0.f), c = fmaxf(v1[e], 0.f); v0[e] = a * a; v1[e] = c * c; } }
                        u32x4 w; w.x = cvt_pk_bf16(v0[0], v0[1]); w.y = cvt_pk_bf16(v0[2], v0[3]); w.z = cvt_pk_bf16(v1[0], v1[1]); w.w = cvt_pk_bf16(v1[2], v1[3]);
                        *(u32x4*)(rowp + bj * HALF) = w; } }
        } else {
            const float* gp = gate + (size_t)b * 6144 + col0;
            f32x4 gv[2][2], gm[2][2];
#pragma unroll
            for (int bj = 0; bj < 2; ++bj)
#pragma unroll
                for (int n = 0; n < 2; ++n) { gv[bj][n] = *(const f32x4*)(gp + bj * HALF + n * 4);
                    gm[bj][n] = XS ? *(const f32x4*)(gn + col0 + bj * HALF + n * 4) * (*(const f32x4*)(scv + (size_t)b * 6144 + col0 + bj * HALF + n * 4) + 1.f) : (f32x4){0.f, 0.f, 0.f, 0.f}; }
#pragma unroll
            for (int aim = 0; aim < 4; ++aim) { const int ai = aim >> 1, m0 = (aim & 1) * 2;
                f32x4 bs[4][2][2];
#pragma unroll
                for (int m = m0; m < m0 + 2; ++m) { const size_t off = (size_t)(row0 + ai * HALF + m * 16) * 1024 + col0;
#pragma unroll
                    for (int bj = 0; bj < 2; ++bj)
#pragma unroll
                        for (int n = 0; n < 2; ++n) bs[m][bj][n] = *(const f32x4*)(base + off + bj * HALF + n * 4); }
                asm volatile("" ::: "memory");
#pragma unroll
                for (int m = m0; m < m0 + 2; ++m) { const int row = row0 + ai * HALF + m * 16; const size_t off = (size_t)row * 1024 + col0; float sq = 0.f;
#pragma unroll
                    for (int bj = 0; bj < 2; ++bj)
#pragma unroll
                        for (int n = 0; n < 2; ++n) {
                            const f32x4 o = bs[m][bj][n] + gv[bj][n] * acc[ai][bj][m][n];
                            *(f32x4*)(out + off + bj * HALF + n * 4) = o;
                            if (XS) { sq += (o[0] * o[0] + o[1] * o[1]) + (o[2] * o[2] + o[3] * o[3]); const f32x4 x = o * gm[bj][n];
                                u32x2_ w; w.x = cvt_pk_bf16(x[0], x[1]); w.y = cvt_pk_bf16(x[2], x[3]); *(u32x2_*)(XS + off + bj * HALF + n * 4) = w; } }
                    if (XS) { sq += shx_(sq, 16); sq += shx_(sq, 32); if (fq == 0) ssq_out[(size_t)row * 16 + u.pn * 4 + wc] = sq; } }
                asm volatile("" ::: "memory");
            }
        }
    }
};
template <class Epi, class Sched, bool ALIGN_EPI = false, bool SP2 = false>
__device__ __forceinline__ void gemm_phase(PG8_LAS unsigned char* lds, const Gemm g, const Sched& S, const Epi& E, const int tid_in) {
    int tid = tid_in; asm volatile("" : "+v"(tid));
    const int wid = __builtin_amdgcn_readfirstlane(tid >> 6), lane = tid & 63, wr = wid >> 2, wc = wid & 3, fr = lane & 15, fq = lane >> 4;
    const int K = g.K, nt = K / BK;
    unsigned voffA[2], voffB[2];
#pragma unroll
    for (int i = 0; i < 2; ++i) { int R, C; stage_rc(tid * 16 + i * 8192, R, C); const int Rb = Epi::PERM ? ((R & ~31) + perm32(R & 31)) : R;
        voffA[i] = (unsigned)(R * K + C) * 2u; voffB[i] = (unsigned)(Rb * K + C) * 2u; }
    const size_t kstep = (size_t)(BK * 2);
    const size_t hstep = (size_t)HALF * K * 2;
    const size_t tstep = 2 * hstep;
    const unsigned ldsw = (unsigned)wid * 1024u;
    const int aoff = lds_byte(wr * 64 + fr, fq * 8), boff = lds_byte(wc * 32 + fr, fq * 8);
#define PG8_SA(b, h) (((b) * 2 + (h)) * HTB)
#define PG8_SB(b, h) ((4 + (b) * 2 + (h)) * HTB)
#define PG8_STAGE(bufoff, gbase, voff) do { _Pragma("unroll") for (int _i = 0; _i < 2; ++_i) \
        __builtin_amdgcn_global_load_lds((const unsigned*)((const char*)(gbase) + (voff)[_i]), (PG8_LAS unsigned*)(lds + (bufoff) + ldsw + _i * 8192), 16, 0, 0); } while (0)
#define PG8_LDA(dst, b, h) do { _Pragma("unroll") for (int m = 0; m < 4; ++m) _Pragma("unroll") for (int k = 0; k < 2; ++k) dst[m][k] = *(const PG8_LAS bf16x8*)(lds + PG8_SA(b, h) + aoff + m * 2048 + k * 1024); } while (0)
#define PG8_LDB(dst, b, h) do { _Pragma("unroll") for (int n = 0; n < 2; ++n) _Pragma("unroll") for (int k = 0; k < 2; ++k) dst[n][k] = *(const PG8_LAS bf16x8*)(lds + PG8_SB(b, h) + boff + n * 2048 + k * 1024); } while (0)
#define PG8_MMA(ai, bj, At, Bt) do { __builtin_amdgcn_s_setprio(1); _Pragma("unroll") for (int m = 0; m < 4; ++m) _Pragma("unroll") for (int n = 0; n < 2; ++n) _Pragma("unroll") for (int k = 0; k < 2; ++k) \
        acc[ai][bj][m][n] = __builtin_amdgcn_mfma_f32_16x16x32_bf16(Bt[n][k], At[m][k], acc[ai][bj][m][n], 0, 0, 0); __builtin_amdgcn_s_setprio(0); } while (0)
#define PG8_WAIT_V(n) asm volatile("s_waitcnt vmcnt(" #n ")" ::: "memory")
#define PG8_WAIT_L(n) asm volatile("s_waitcnt lgkmcnt(" #n ")" ::: "memory")
#define PG8_BAR __builtin_amdgcn_s_barrier()
#define PG8_SCHED __builtin_amdgcn_sched_barrier(0)
    Unit cur, nxt; int ui = 0;
    if (!S.next(0, cur)) return;
    f32x4 acc[2][2][4][2];
#pragma unroll
    for (int a = 0; a < 2; ++a)
#pragma unroll
        for (int b = 0; b < 2; ++b)
#pragma unroll
            for (int m = 0; m < 4; ++m)
#pragma unroll
                for (int n = 0; n < 2; ++n) acc[a][b][m][n] = (f32x4){0.f, 0.f, 0.f, 0.f};
    bf16x8 At[4][2], B0[2][2], B1[2][2];
    const char* cA = (const char*)g.A + (size_t)cur.pm * tstep; const char* cB = (const char*)g.Bt + (size_t)cur.pn * tstep;
    S.a_ready(cur);
    if constexpr (SP2) {
        PG8_STAGE(PG8_SB(0, 0), cB, voffB); PG8_STAGE(PG8_SB(0, 1), cB + hstep, voffB); PG8_STAGE(PG8_SA(0, 0), cA, voffA); PG8_STAGE(PG8_SA(0, 1), cA + hstep, voffA);
        if (wr == 1) PG8_BAR;
        PG8_WAIT_V(2); PG8_BAR;
        PG8_STAGE(PG8_SB(1, 0), cB + kstep, voffB); PG8_STAGE(PG8_SA(1, 0), cA + kstep, voffA); PG8_STAGE(PG8_SB(1, 1), cB + hstep + kstep, voffB);
        PG8_WAIT_V(6); PG8_BAR;
    } else {
        PG8_STAGE(PG8_SB(0, 0), cB, voffB); PG8_STAGE(PG8_SA(0, 0), cA, voffA); PG8_STAGE(PG8_SB(0, 1), cB + hstep, voffB); PG8_STAGE(PG8_SA(0, 1), cA + hstep, voffA);
        if (wr == 1) PG8_BAR;
        PG8_WAIT_V(4); PG8_BAR;
        PG8_STAGE(PG8_SB(1, 0), cB + kstep, voffB); PG8_STAGE(PG8_SA(1, 0), cA + kstep, voffA); PG8_STAGE(PG8_SB(1, 1), cB + hstep + kstep, voffB);
        PG8_WAIT_V(6); PG8_BAR;
    }
    for (;;) {
        const bool has_next = S.next(ui + 1, nxt);
        const char* nA = has_next ? (const char*)g.A + (size_t)nxt.pm * tstep : cA; const char* nB = has_next ? (const char*)g.Bt + (size_t)nxt.pn * tstep : cB;
        for (int t = 0; t < nt; t += 2) {
            const bool last = (t == nt - 2);
            const char* a1 = cA + (size_t)(t + 1) * kstep;
            const char* a2 = last ? nA : cA + (size_t)(t + 2) * kstep; const char* b2 = last ? nB : cB + (size_t)(t + 2) * kstep;
            const char* a3 = a2 + kstep; const char* b3 = b2 + kstep;
            if (last && has_next) S.a_ready(nxt);
            if constexpr (SP2) {
            PG8_LDB(B0, 0, 0); PG8_LDB(B1, 0, 1); PG8_SCHED; PG8_LDA(At, 0, 0); PG8_STAGE(PG8_SA(1, 1), a1 + hstep, voffA);
            PG8_WAIT_V(8); PG8_WAIT_L(0); PG8_BAR; PG8_MMA(0, 0, At, B0); PG8_MMA(0, 1, At, B1); PG8_BAR; PG8_SCHED;
            PG8_LDA(At, 0, 1); PG8_STAGE(PG8_SB(0, 0), b2, voffB); PG8_STAGE(PG8_SB(0, 1), b2 + hstep, voffB); PG8_STAGE(PG8_SA(0, 0), a2, voffA);
            PG8_WAIT_V(8); PG8_WAIT_L(0); PG8_BAR; PG8_MMA(1, 0, At, B0); PG8_MMA(1, 1, At, B1); PG8_BAR; PG8_SCHED;
            PG8_LDB(B0, 1, 0); PG8_LDB(B1, 1, 1); PG8_SCHED; PG8_LDA(At, 1, 0); PG8_STAGE(PG8_SA(0, 1), a2 + hstep, voffA);
            PG8_WAIT_V(8); PG8_WAIT_L(0); PG8_BAR; PG8_MMA(0, 0, At, B0); PG8_MMA(0, 1, At, B1); PG8_BAR; PG8_SCHED;
            PG8_LDA(At, 1, 1); PG8_STAGE(PG8_SB(1, 0), b3, voffB); PG8_STAGE(PG8_SB(1, 1), b3 + hstep, voffB); PG8_STAGE(PG8_SA(1, 0), a3, voffA);
            PG8_WAIT_V(8); PG8_WAIT_L(0); PG8_BAR; PG8_MMA(1, 0, At, B0); PG8_MMA(1, 1, At, B1); PG8_BAR; PG8_SCHED;
            } else {
            PG8_LDB(B0, 0, 0); PG8_SCHED; PG8_LDA(At, 0, 0); PG8_STAGE(PG8_SA(1, 1), a1 + hstep, voffA);
            PG8_WAIT_L(8); PG8_BAR; PG8_WAIT_L(0); PG8_MMA(0, 0, At, B0); PG8_BAR; PG8_SCHED;
            PG8_LDB(B1, 0, 1); PG8_STAGE(PG8_SB(0, 0), b2, voffB);
            PG8_BAR; PG8_WAIT_L(0); PG8_MMA(0, 1, At, B1); PG8_BAR;
            PG8_LDA(At, 0, 1); PG8_STAGE(PG8_SA(0, 0), a2, voffA);
            PG8_BAR; PG8_WAIT_L(0); PG8_MMA(1, 0, At, B0); PG8_BAR; PG8_SCHED;
            PG8_STAGE(PG8_SB(0, 1), b2 + hstep, voffB);
            PG8_WAIT_V(6); PG8_BAR; PG8_MMA(1, 1, At, B1); PG8_BAR;
            PG8_LDB(B0, 1, 0); PG8_SCHED; PG8_LDA(At, 1, 0); PG8_STAGE(PG8_SA(0, 1), a2 + hstep, voffA);
            PG8_WAIT_L(8); PG8_BAR; PG8_WAIT_L(0); PG8_MMA(0, 0, At, B0); PG8_BAR; PG8_SCHED;
            PG8_LDB(B1, 1, 1); PG8_STAGE(PG8_SB(1, 0), b3, voffB);
            PG8_BAR; PG8_WAIT_L(0); PG8_MMA(0, 1, At, B1); PG8_BAR;
            PG8_LDA(At, 1, 1); PG8_STAGE(PG8_SA(1, 0), a3, voffA);
            PG8_BAR; PG8_WAIT_L(0); PG8_MMA(1, 0, At, B0); PG8_BAR; PG8_SCHED;
            PG8_STAGE(PG8_SB(1, 1), b3 + hstep, voffB);
            PG8_WAIT_V(6); PG8_BAR; PG8_MMA(1, 1, At, B1); PG8_BAR;
            }
        }
        if constexpr (ALIGN_EPI) { if (wr == 0) PG8_BAR; }
        if constexpr (!Epi::AFTER_DRAIN) { E(acc, cur, wr, wc, fr, fq, ui); S.done(cur); }
        if (!has_next) break;
#pragma unroll
        for (int a = 0; a < 2; ++a)
#pragma unroll
            for (int b = 0; b < 2; ++b)
#pragma unroll
                for (int m = 0; m < 4; ++m)
#pragma unroll
                    for (int n = 0; n < 2; ++n) acc[a][b][m][n] = (f32x4){0.f, 0.f, 0.f, 0.f};
        cur = nxt; cA = nA; cB = nB; ++ui;
        if constexpr (ALIGN_EPI) { if (wr == 1) PG8_BAR; }
    }
    PG8_WAIT_V(0);
    if constexpr (!ALIGN_EPI) { if (wr == 0) PG8_BAR; }
    PG8_BAR;
    if constexpr (Epi::AFTER_DRAIN) { E.fused(acc, cur, wr, wc, fr, fq, lds, wid, lane); S.done(cur); }
#undef PG8_SA
#undef PG8_SB
#undef PG8_STAGE
#undef PG8_LDA
#undef PG8_LDB
#undef PG8_MMA
#undef PG8_WAIT_V
#undef PG8_WAIT_L
#undef PG8_BAR
#undef PG8_SCHED
}
}

constexpr int BATCH = 16, T = 2048, D = 1024, M = BATCH * T, NIN = 3072, FF = 4096;
constexpr size_t MiB = 1u << 20;
constexpr size_t WS_WB = 1 * MiB;
constexpr size_t WB_LAYER = 24 * MiB, WB_IN = 0, WB_OUT = 6 * MiB, WB_W1 = 8 * MiB, WB_W2 = 16 * MiB;
constexpr size_t WS_MOD = 49 * MiB;
constexpr size_t WS_LORA = 50 * MiB;
constexpr size_t LORA_LAYER = 131072, LORA_W2 = 0, LORA_A2 = 32768, LORA_G2 = 65536;
constexpr size_t WS_SCAL = 51 * MiB;
constexpr size_t WS_XN = 53 * MiB;
constexpr size_t WS_SW = WS_XN, WS_YR = WS_XN + 32 * MiB;
constexpr size_t WS_Y = 117 * MiB;
constexpr size_t WS_P = 181 * MiB;
constexpr size_t WS_S16 = 373 * MiB;
constexpr size_t S16_ARR = 16 * MiB;
constexpr size_t WS_G = 453 * MiB;
constexpr size_t WS_H = WS_P;
constexpr size_t WS_VT = 469 * MiB;
constexpr size_t WS_SSQA = 501 * MiB, WS_SSQB = 503 * MiB;
constexpr size_t WS_BIAS = 505 * MiB;
constexpr size_t WS_END = 506 * MiB;
constexpr int LDS_BYTES = 147456;
constexpr size_t WS_BAR = 16384;
constexpr int LDS_CTL = LDS_BYTES - 64;

#define LAS __attribute__((address_space(3)))
typedef unsigned short bf16;
typedef _Float16 h16;
typedef float f32x4 __attribute__((ext_vector_type(4)));
typedef float f32x2 __attribute__((ext_vector_type(2)));
typedef short bf16x8 __attribute__((ext_vector_type(8)));
typedef unsigned u32x4 __attribute__((ext_vector_type(4)));
typedef unsigned u32x2 __attribute__((ext_vector_type(2)));
typedef h16 h16x4 __attribute__((ext_vector_type(4)));
typedef h16 h16x8 __attribute__((ext_vector_type(8)));

__device__ __forceinline__ unsigned pk2(float lo, float hi) { return pg8::cvt_pk_bf16(lo, hi); }
__device__ __forceinline__ unsigned f2bf(float f) { return pg8::cvt_pk_bf16(f, 0.f) & 0xffffu; }
__device__ __forceinline__ float bf2f(unsigned h) { return __builtin_bit_cast(float, h << 16); }
__device__ __forceinline__ float bflo(unsigned w) { return __builtin_bit_cast(float, w << 16); }
__device__ __forceinline__ float bfhi(unsigned w) { return __builtin_bit_cast(float, w & 0xffff0000u); }
__device__ __forceinline__ float shx(float v, int m) { int l = __builtin_amdgcn_mbcnt_hi(~0u, __builtin_amdgcn_mbcnt_lo(~0u, 0u)); asm volatile("" : "+v"(l));
    return __builtin_bit_cast(float, __builtin_amdgcn_ds_bpermute((l ^ m) << 2, __builtin_bit_cast(int, v))); }
__device__ __forceinline__ float wave_sum(float v) {
#pragma unroll
    for (int o = 1; o < 64; o <<= 1) v += shx(v, o);
    return v;
}
__device__ __forceinline__ float sum16(float v) {
    v += shx(v, 1); v += shx(v, 2); v += shx(v, 4); v += shx(v, 8); return v;
}
__device__ __forceinline__ float sigmoidf_(float x) { return 1.f / (1.f + __expf(-x)); }
#define LDS_WAIT() asm volatile("s_waitcnt lgkmcnt(0)" ::: "memory")

struct Args { const float* in[32]; float* out; unsigned char* ws; int ph_lo, ph_hi; };

__device__ __forceinline__ const float* inp(const Args& a, int i) { asm volatile("" : "+s"(i)); return a.in[i]; }
__device__ __forceinline__ void p0_transpose_item(const float* W, int K, int N, bf16* WT, float* scr, int item, int lane) {
    const int nblk = N / 32, kb = item / nblk, nb = item % nblk, k0 = 64 * kb, n0 = 32 * nb;
    float wv_[32];
#pragma unroll
    for (int i = 0; i < 32; ++i) wv_[i] = W[(size_t)(k0 + 2 * i + (lane >> 5)) * N + n0 + (lane & 31)];
#pragma unroll
    for (int i = 0; i < 32; ++i) scr[(2 * i + (lane >> 5)) * 33 + (lane & 31)] = wv_[i];
    LDS_WAIT(); asm volatile("" ::: "memory");
    const int c = lane & 7;
#pragma unroll
    for (int j = 0; j < 4; ++j) { const int n = (lane >> 3) + 8 * j; const float* s = scr + (8 * c) * 33 + n;
        u32x4 o; o.x = pk2(s[0 * 33], s[1 * 33]); o.y = pk2(s[2 * 33], s[3 * 33]); o.z = pk2(s[4 * 33], s[5 * 33]); o.w = pk2(s[6 * 33], s[7 * 33]);
        *(u32x4*)(WT + (size_t)(n0 + n) * K + k0 + 8 * c) = o; }
    LDS_WAIT(); asm volatile("" ::: "memory");
}
__device__ __forceinline__ void phase_weights(const Args& a, unsigned char* lds, int wave, int lane) {
    float* scr = (float*)(lds + wave * 16384);
    const int gw = blockIdx.x * 8 + wave, NGW = gridDim.x * 8;
    constexpr int I_IN = 16 * 96, I_OUT = 16 * 32, I_W1 = 16 * 128, I_W2 = 64 * 32, I_L2 = 8, I_G2 = 16;
    constexpr int PER = I_IN + I_OUT + I_W1 + I_W2 + 2 * I_L2 + I_G2;
    for (int it = gw; it < 2 * PER; it += NGW) {
        const int l = it / PER; int r = it % PER;
        unsigned char* wb = a.ws + WS_WB + (size_t)l * WB_LAYER; unsigned char* lo = a.ws + WS_LORA + (size_t)l * LORA_LAYER;
        if (r < I_IN) { p0_transpose_item(inp(a, 5) + (size_t)l * D * NIN, D, NIN, (bf16*)(wb + WB_IN), scr, r, lane); continue; } r -= I_IN;
        if (r < I_OUT) { p0_transpose_item(inp(a, 28) + (size_t)l * D * D, D, D, (bf16*)(wb + WB_OUT), scr, r, lane); continue; } r -= I_OUT;
        if (r < I_W1) { p0_transpose_item(inp(a, 30) + (size_t)l * D * FF, D, FF, (bf16*)(wb + WB_W1), scr, r, lane); continue; } r -= I_W1;
        if (r < I_W2) { p0_transpose_item(inp(a, 31) + (size_t)l * FF * D, FF, D, (bf16*)(wb + WB_W2), scr, r, lane); continue; } r -= I_W2;
        if (r < I_L2) { p0_transpose_item(inp(a, 8) + (size_t)l * 64 * 256, 64, 256, (bf16*)(lo + LORA_W2), scr, r, lane); continue; } r -= I_L2;
        if (r < I_L2) { p0_transpose_item(inp(a, 10) + (size_t)l * 64 * 256, 64, 256, (bf16*)(lo + LORA_A2), scr, r, lane); continue; } r -= I_L2;
        p0_transpose_item(inp(a, 11) + (size_t)l * 128 * 256, 128, 256, (bf16*)(lo + LORA_G2), scr, r, lane);
    }
}
__device__ __forceinline__ void phase_ada(const Args& a, unsigned char* lds, int tid, int wave, int lane) {
    float* cond = (float*)lds; float* red = cond + 16384;
    const float* c = inp(a, 1); float* mod = (float*)(a.ws + WS_MOD);
    for (int i = tid; i < 16384; i += 512) { const float v = c[i]; cond[i] = v / (1.f + __expf(-v)); }
    __syncthreads();
    for (int item = blockIdx.x; item < 192; item += gridDim.x) {
        const int l = item / 96, n0 = (item % 96) * 64;
        const float* W = inp(a, 2) + (size_t)l * 1024 * 6144 + n0 + lane;
        float acc[16];
#pragma unroll
        for (int b = 0; b < 16; ++b) acc[b] = 0.f;
        const int k0 = wave * 128;
#pragma unroll 1
        for (int k = k0; k < k0 + 128; k += 16) {
            float wq[16];
#pragma unroll
            for (int i = 0; i < 16; ++i) wq[i] = W[(size_t)(k + i) * 6144];
#pragma unroll
            for (int i = 0; i < 16; i += 4)
#pragma unroll
                for (int b = 0; b < 16; ++b) { const f32x4 cv = *(const f32x4*)(cond + b * 1024 + k + i); acc[b] += cv[0] * wq[i] + cv[1] * wq[i + 1] + cv[2] * wq[i + 2] + cv[3] * wq[i + 3]; }
        }
#pragma unroll
        for (int b = 0; b < 16; ++b) red[(wave * 16 + b) * 64 + lane] = acc[b];
        __syncthreads();
        for (int o = tid; o < 1024; o += 512) { const int b = o >> 6, n = o & 63; float s = 0.f;
#pragma unroll
            for (int w = 0; w < 8; ++w) s += red[(w * 16 + b) * 64 + n];
            mod[(size_t)(l * 16 + b) * 6144 + n0 + n] = s + inp(a, 3)[(size_t)l * 6144 + n0 + n]; }
        __syncthreads();
    }
}
__device__ __forceinline__ void phase_xn(const float* x, const float* g, const float* modl, int sh_off, int sc_off, bf16* XN, int wave, int lane) {
    const int gw = blockIdx.x * 8 + wave, NGW = gridDim.x * 8, rpw = ((M + NGW - 1) / NGW + 3) & ~3;
    const int mend = (gw + 1) * rpw < M ? (gw + 1) * rpw : M;
    for (int m = gw * rpw; m < mend; m += 4) {
        const int b = m >> 11;
        f32x4 v[4][4];
#pragma unroll
        for (int i = 0; i < 4; ++i) { const f32x4* xr = (const f32x4*)(x + (size_t)(m + i) * D) + lane;
#pragma unroll
            for (int j = 0; j < 4; ++j) v[i][j] = xr[64 * j]; }
        const float* mb = modl + (size_t)b * 6144;
        f32x4 ga[4], sh[4];
#pragma unroll
        for (int j = 0; j < 4; ++j) { const int col = 4 * lane + 256 * j; ga[j] = *(const f32x4*)(g + col) * (*(const f32x4*)(mb + sc_off + col) + 1.f); sh[j] = *(const f32x4*)(mb + sh_off + col); }
#pragma unroll
        for (int i = 0; i < 4; ++i) { float ss = 0.f;
#pragma unroll
            for (int j = 0; j < 4; ++j) ss += (v[i][j][0] * v[i][j][0] + v[i][j][1] * v[i][j][1]) + (v[i][j][2] * v[i][j][2] + v[i][j][3] * v[i][j][3]);
            const float rstd = rsqrtf(wave_sum(ss) * (1.f / D) + 1e-6f);
#pragma unroll
            for (int j = 0; j < 4; ++j) { const int col = 4 * lane + 256 * j; const f32x4 y = (v[i][j] * rstd) * ga[j] + sh[j];
                u32x2 w; w.x = pk2(y[0], y[1]); w.y = pk2(y[2], y[3]);
                *(u32x2*)(XN + (size_t)(m + i) * D + col) = w; } }
    }
}

__device__ __forceinline__ f32x4 mfma16(bf16x8 A, bf16x8 B, f32x4 C) { return __builtin_amdgcn_mfma_f32_16x16x32_bf16(A, B, C, 0, 0, 0); }
__device__ __forceinline__ void phase_bias(const Args& a, int wave, int lane) {
    const int gw = blockIdx.x * 8 + wave, NGW = gridDim.x * 8;
    const int r = lane & 15, g = lane >> 4;
    float* BIAS = (float*)(a.ws + WS_BIAS);
    for (int t = gw; t < 704; t += NGW) {
        int idx, tile; if (t < 192) { idx = 0; tile = t; } else if (t < 448) { idx = 1; tile = t - 192; } else { idx = 2; tile = t - 448; }
        const int lsel = idx == 1 ? 0 : 1, N = idx == 0 ? NIN : FF;
        const float* sh = (const float*)(a.ws + WS_MOD) + (size_t)lsel * 16 * 6144 + (idx == 0 ? 0 : 3072) + (size_t)r * 6144 + g * 8;
        const bf16* Bt = (const bf16*)(a.ws + WS_WB + (size_t)lsel * WB_LAYER + (idx == 0 ? WB_IN : WB_W1)) + (size_t)(tile * 16 + r) * 1024 + g * 8;
        float* outp = BIAS + (idx == 0 ? 0 : (idx == 1 ? 16 * NIN : 16 * NIN + 16 * FF));
        f32x4 acc = {0.f, 0.f, 0.f, 0.f};
#pragma unroll 4
        for (int ks = 0; ks < 32; ++ks) {
            const f32x4 x0 = *(const f32x4*)(sh + ks * 32), x1 = *(const f32x4*)(sh + ks * 32 + 4);
            u32x4 hi, lo;
            hi.x = pk2(x0[0], x0[1]); hi.y = pk2(x0[2], x0[3]); hi.z = pk2(x1[0], x1[1]); hi.w = pk2(x1[2], x1[3]);
            lo.x = pk2(x0[0] - bflo(hi.x), x0[1] - bfhi(hi.x)); lo.y = pk2(x0[2] - bflo(hi.y), x0[3] - bfhi(hi.y));
            lo.z = pk2(x1[0] - bflo(hi.z), x1[1] - bfhi(hi.z)); lo.w = pk2(x1[2] - bflo(hi.w), x1[3] - bfhi(hi.w));
            const bf16x8 B = *(const bf16x8*)(Bt + ks * 32);
            acc = mfma16(__builtin_bit_cast(bf16x8, hi), B, acc); acc = mfma16(__builtin_bit_cast(bf16x8, lo), B, acc);
        }
#pragma unroll
        for (int j = 0; j < 4; ++j) outp[(size_t)(4 * g + j) * N + tile * 16 + r] = acc[j];
    }
}

template <int CTRL> __device__ __forceinline__ float dppf(float x) { return __builtin_bit_cast(float, __builtin_amdgcn_update_dpp(0, __builtin_bit_cast(int, x), CTRL, 0xf, 0xf, true)); }
__device__ __forceinline__ float rowsum16(float x) { x += dppf<0xB1>(x); x += dppf<0x4E>(x); x += dppf<0x124>(x); x += dppf<0x128>(x); return x; }
__device__ __forceinline__ float softplusf_(float x) { return x > 0.f ? x + log1pf(__expf(-x)) : log1pf(__expf(x)); }
__device__ __forceinline__ float sel4(f32x4 v, int j) { return j == 0 ? v[0] : (j == 1 ? v[1] : (j == 2 ? v[2] : v[3])); }
__device__ __forceinline__ float tanhf_(float x) { return 1.f - 2.f / (1.f + __expf(2.f * x)); }
__device__ __forceinline__ void phase_premix(const Args& a, int l, unsigned char* lds, int tid, int wave, int lane) {
    bf16* P = (bf16*)(a.ws + WS_P);
    const bf16* w2t = (const bf16*)(a.ws + WS_LORA + (size_t)l * LORA_LAYER + LORA_W2);
    const bf16* a2t = (const bf16*)(a.ws + WS_LORA + (size_t)l * LORA_LAYER + LORA_A2);
    const bf16* g2t = (const bf16*)(a.ws + WS_LORA + (size_t)l * LORA_LAYER + LORA_G2);
    h16* S16 = (h16*)(a.ws + WS_S16); float* SW = (float*)(a.ws + WS_SW); bf16* G = (bf16*)(a.ws + WS_G); float* SCAL = (float*)(a.ws + WS_SCAL);
    constexpr size_t ARR = (size_t)M * 256;
    bf16* praw = (bf16*)lds;
    bf16* act = (bf16*)(lds + 33 * 2048);
    bf16* vbuf = (bf16*)(lds + 33 * 2048 + 32 * 264 * 2);
    float* par = (float*)(lds + 33 * 2048 + 32 * 264 * 2 + 32 * 520 * 2);
    bf16* VT = (bf16*)(a.ws + WS_VT);
    if (tid < 256) { const float* mu = inp(a, 6) + l * 1024;
        par[tid] = mu[tid]; par[256 + tid] = mu[256 + tid]; par[512 + tid] = mu[512 + tid]; par[768 + tid] = mu[768 + tid];
        par[1024 + tid] = inp(a, 7)[l * 256 + tid]; par[1280 + tid] = inp(a, 9)[l * 256 + tid]; par[1536 + tid] = inp(a, 12)[l * 256 + tid];
        par[1792 + tid] = inp(a, 13)[l * 256 + tid]; par[2048 + tid] = inp(a, 14)[l * 256 + tid]; }
    else if (tid < 320) par[2304 + tid - 256] = inp(a, 17)[l * 64 + tid - 256];
    else if (tid < 384) par[2368 + tid - 320] = inp(a, 18)[l * 64 + tid - 320];
    __syncthreads();
    for (int tile = blockIdx.x; tile < M / 32; tile += gridDim.x) {
        int ln_ = lane; asm volatile("" : "+v"(ln_)); const int r = ln_ & 15, g = ln_ >> 4;
        const int b = tile >> 6, t0 = (tile & 63) * 32; const size_t row0 = (size_t)b * T + t0;
        const int tt = wave >> 2, h = wave & 3;
        u32x4 pr_[9], vv_[4], q0_[4], q1_[4]; u32x2 ga_[4], gb_[4];
#pragma unroll
        for (int i = 0; i < 9; ++i) { const int ch = tid + 512 * i, rr = ch >> 7, cc = ch & 127; pr_[i] = (u32x4){0u, 0u, 0u, 0u};
            if (ch < 33 * 128 && (rr > 0 || t0 > 0)) pr_[i] = *(const u32x4*)(P + (row0 + rr - 1) * NIN + cc * 8); }
#pragma unroll
        for (int i = 0; i < 4; ++i) { const int ch = tid + 512 * i, rr = ch >> 6, cc = ch & 63; vv_[i] = *(const u32x4*)(P + (row0 + rr) * NIN + 2048 + cc * 8);
            const bf16* prow = P + (row0 + wave * 4 + i) * NIN;
            q0_[i] = *(const u32x4*)(prow + 1024 + ln_ * 16); q1_[i] = *(const u32x4*)(prow + 1024 + ln_ * 16 + 8);
            ga_[i] = *(const u32x2*)(prow + 2560 + ln_ * 4); gb_[i] = *(const u32x2*)(prow + 2816 + ln_ * 4); }
#pragma unroll
        for (int i = 0; i < 9; ++i) { const int ch = tid + 512 * i, rr = ch >> 7, cc = ch & 127; if (ch < 33 * 128) *(u32x4*)(praw + rr * 1024 + cc * 8) = pr_[i]; }
#pragma unroll
        for (int i = 0; i < 4; ++i) { const int ch = tid + 512 * i, rr = ch >> 6, cc = ch & 63; *(u32x4*)(vbuf + rr * 520 + cc * 8) = vv_[i]; }
        {
            const float* gam = par + (ln_ < 32 ? 2304 : 2368) + (ln_ & 3) * 16;
            const float qs_ = ln_ < 32 ? 0.125f * 1.4426950408889634f : 1.f;
#pragma unroll
            for (int i = 0; i < 4; ++i) { bf16* prow = P + (row0 + wave * 4 + i) * NIN;
                float f[16];
#pragma unroll
                for (int e = 0; e < 4; ++e) { f[2 * e] = bflo(q0_[i][e]); f[2 * e + 1] = bfhi(q0_[i][e]); f[8 + 2 * e] = bflo(q1_[i][e]); f[8 + 2 * e + 1] = bfhi(q1_[i][e]); }
                float ss = 0.f;
#pragma unroll
                for (int e = 0; e < 16; ++e) ss += f[e] * f[e];
                ss += dppf<0xB1>(ss); ss += dppf<0x4E>(ss);
                const float sc = rsqrtf(ss * (1.f / 64.f) + 1e-6f) * qs_;
                u32x4 o0, o1;
#pragma unroll
                for (int e = 0; e < 4; ++e) { o0[e] = pk2(f[2 * e] * sc * gam[2 * e], f[2 * e + 1] * sc * gam[2 * e + 1]); o1[e] = pk2(f[8 + 2 * e] * sc * gam[8 + 2 * e], f[8 + 2 * e + 1] * sc * gam[8 + 2 * e + 1]); }
                *(u32x4*)(prow + 1024 + ln_ * 16) = o0; *(u32x4*)(prow + 1024 + ln_ * 16 + 8) = o1;
                u32x2 hv;
                hv.x = pk2(bflo(ga_[i].x) * sigmoidf_(bflo(gb_[i].x)), bfhi(ga_[i].x) * sigmoidf_(bfhi(gb_[i].x)));
                hv.y = pk2(bflo(ga_[i].y) * sigmoidf_(bflo(gb_[i].y)), bfhi(ga_[i].y) * sigmoidf_(bfhi(gb_[i].y)));
                *(u32x2*)(prow + 2560 + ln_ * 4) = hv; }
        }
        __syncthreads();
        bf16x8 Bw[2][4], Ba[2][4], Bg[4][4];
#pragma unroll
        for (int ct = 0; ct < 4; ++ct) {
#pragma unroll
            for (int ks = 0; ks < 2; ++ks) { const size_t wo = (size_t)(h * 64 + ct * 16 + r) * 64 + ks * 32 + g * 8; Bw[ks][ct] = *(const bf16x8*)(w2t + wo); Ba[ks][ct] = *(const bf16x8*)(a2t + wo); }
#pragma unroll
            for (int ks = 0; ks < 4; ++ks) Bg[ks][ct] = *(const bf16x8*)(g2t + (size_t)(h * 64 + ct * 16 + r) * 128 + ks * 32 + g * 8); }
        {
            bf16* dst = VT + ((size_t)b * 512 + tid) * T + t0;
#pragma unroll
            for (int q = 0; q < 4; ++q) { u32x4 o;
#pragma unroll
                for (int e = 0; e < 4; ++e) { const int k0_ = (e >> 1) * 16 + q * 4 + (e & 1) * 2; o[e] = (unsigned)vbuf[k0_ * 520 + tid] | ((unsigned)vbuf[(k0_ + 1) * 520 + tid] << 16); }
                *(u32x4*)(dst + q * 8) = o; } }
#pragma unroll 4
        for (int idx = tid; idx < 32 * 256; idx += 512) { const int tok = idx >> 8, c = idx & 255, col = 768 + c;
            const float cur = bf2f(praw[(tok + 1) * 1024 + col]), prev = bf2f(praw[tok * 1024 + col]);
            const float pa = cur + par[768 + c] * (prev - cur);
            const float o = c < 64 ? tanhf_(pa) : (c < 128 ? pa : sigmoidf_(pa));
            act[tok * 264 + c] = (bf16)f2bf(o); }
        __syncthreads();
        f32x4 aw[4], aa[4], ag[4];
#pragma unroll
        for (int ct = 0; ct < 4; ++ct) { aw[ct] = (f32x4){0.f, 0.f, 0.f, 0.f}; aa[ct] = aw[ct]; ag[ct] = aw[ct]; }
        const bf16* arow = act + (tt * 16 + r) * 264 + g * 8;
#pragma unroll
        for (int ks = 0; ks < 2; ++ks) { const bf16x8 A = *(const bf16x8*)(arow + ks * 32), A2 = *(const bf16x8*)(arow + 64 + ks * 32);
#pragma unroll
            for (int ct = 0; ct < 4; ++ct) { aw[ct] = mfma16(A, Bw[ks][ct], aw[ct]); aa[ct] = mfma16(A2, Ba[ks][ct], aa[ct]); } }
#pragma unroll
        for (int ks = 0; ks < 4; ++ks) { const bf16x8 A = *(const bf16x8*)(arow + 128 + ks * 32);
#pragma unroll
            for (int ct = 0; ct < 4; ++ct) ag[ct] = mfma16(A, Bg[ks][ct], ag[ct]); }
#pragma unroll 1
        for (int j = 0; j < 4; ++j) {
            const int tok = tt * 16 + 4 * g + j; const size_t token = row0 + tok;
            float kkv[4], k2v[4], rv[4], av[4], vv[4], dv[4]; float ss = 0.f;
#pragma unroll
            for (int ct = 0; ct < 4; ++ct) { const int c = h * 64 + ct * 16 + r;
                const bf16* pc = praw + (tok + 1) * 1024; const bf16* pp = praw + tok * 1024;
                float x0 = bf2f(pc[c]), x1 = bf2f(pc[256 + c]), x2 = bf2f(pc[512 + c]);
                x0 += par[c] * (bf2f(pp[c]) - x0); x1 += par[256 + c] * (bf2f(pp[256 + c]) - x1); x2 += par[512 + c] * (bf2f(pp[512 + c]) - x2);
                const float wl = par[1024 + c] + sel4(aw[ct], j);
                const float wlog = -__logf(1.f + __expf(-wl)) - 0.5f;
                dv[ct] = __expf(-__expf(wlog));
                av[ct] = sigmoidf_(par[1280 + c] + sel4(aa[ct], j));
                rv[ct] = x0; vv[ct] = x2;
                kkv[ct] = x1 * par[1536 + c]; ss += kkv[ct] * kkv[ct];
                k2v[ct] = x1 * (1.f + (av[ct] - 1.f) * par[1792 + c]); }
            ss = rowsum16(ss);
            const float inv = 1.f / fmaxf(sqrtf(ss), 1e-12f);
            float c1 = 0.f, c2 = 0.f, bn = 0.f;
#pragma unroll
            for (int ct = 0; ct < 4; ++ct) { const int c = h * 64 + ct * 16 + r; const size_t o = token * 256 + c;
                const float kkn = kkv[ct] * inv, ka = kkn * av[ct];
                c1 += ka * rv[ct]; c2 += k2v[ct] * rv[ct]; bn += rv[ct] * k2v[ct] * par[2048 + c];
                S16[o] = (h16)(-kkn); S16[ARR + o] = (h16)(dv[ct] * rv[ct]); S16[2 * ARR + o] = (h16)ka; S16[3 * ARR + o] = (h16)k2v[ct]; S16[4 * ARR + o] = (h16)vv[ct];
                SW[o] = dv[ct]; G[o] = (bf16)f2bf(sel4(ag[ct], j)); }
            c1 = rowsum16(c1); c2 = rowsum16(c2); bn = rowsum16(bn);
            if (r == 0) { float* sp = SCAL + (token * 4 + h) * 4; sp[0] = c1; sp[1] = c2; sp[2] = bn; sp[3] = 0.f; }
            asm volatile("" ::: "memory");
        }
        __syncthreads();
    }
}

__device__ __forceinline__ void st8(float* d, h16x8 v) {
    *(f32x4*)d = (f32x4){(float)v[0], (float)v[1], (float)v[2], (float)v[3]}; *(f32x4*)(d + 4) = (f32x4){(float)v[4], (float)v[5], (float)v[6], (float)v[7]}; }
constexpr int SC_REC = 384, SC_CH = 32, SC_NCH = T / SC_CH;
__device__ __forceinline__ void scan_load(const h16* S16, const float* SW, const float* SCAL, size_t tok0, int h, int rg, float* dst, int ltid) {
    constexpr size_t ARR = (size_t)M * 256;
    { const int s = ltid >> 3, q = ltid & 7; const h16* p = S16 + (tok0 + s) * 256 + h * 64 + q * 8; float* rec = dst + s * SC_REC + q * 8;
      const h16x8 v0 = *(const h16x8*)p, v1 = *(const h16x8*)(p + ARR), v2 = *(const h16x8*)(p + 2 * ARR), v3 = *(const h16x8*)(p + 3 * ARR);
      st8(rec, v0); st8(rec + 64, v1); st8(rec + 192, v2); st8(rec + 256, v3); }
#pragma unroll
    for (int i = 0; i < 2; ++i) { const int id = ltid + 256 * i, s = id >> 4, q = id & 15;
        *(f32x4*)(dst + s * SC_REC + 128 + q * 4) = *(const f32x4*)(SW + (tok0 + s) * 256 + h * 64 + q * 4); }
    if (ltid < 64) { const int s = ltid >> 1, q = ltid & 1; st8(dst + s * SC_REC + 320 + q * 8, *(const h16x8*)(S16 + 4 * ARR + (tok0 + s) * 256 + h * 64 + rg * 16 + q * 8)); }
    else if (ltid < 128) { const int s = (ltid - 64) >> 1, wh = ltid & 1; dst[s * SC_REC + 336 + wh] = SCAL[((tok0 + s) * 4 + h) * 4 + wh]; }
}
struct ScanOps { f32x4 nkk, wr, w, ka, k2; f32x2 c; float vi; };
__device__ __forceinline__ void scan_ld(ScanOps& o, const float* rec, int jq, int rowl) {
    o.nkk = *(const f32x4*)(rec + 4 * jq); o.wr = *(const f32x4*)(rec + 64 + 4 * jq); o.w = *(const f32x4*)(rec + 128 + 4 * jq);
    o.ka = *(const f32x4*)(rec + 192 + 4 * jq); o.k2 = *(const f32x4*)(rec + 256 + 4 * jq); o.vi = rec[320 + rowl]; o.c = *(const f32x2*)(rec + 336);
}
__device__ __forceinline__ void scan_step(f32x4& S, float& yk, const ScanOps& o, int jq, int sidx) {
    float sa = (S[0] * o.nkk[0] + S[1] * o.nkk[1]) + (S[2] * o.nkk[2] + S[3] * o.nkk[3]);
    float ys = (S[0] * o.wr[0] + S[1] * o.wr[1]) + (S[2] * o.wr[2] + S[3] * o.wr[3]);
    sa = rowsum16(sa); ys = rowsum16(ys);
    const float y = ys + sa * o.c[0] + o.vi * o.c[1];
    yk = (jq == (sidx & 15)) ? y : yk;
    S = S * o.w + o.ka * sa + o.k2 * o.vi;
}
__device__ __forceinline__ void phase_scan(const Args& a, unsigned char* lds, int tid, int wave, int lane) {
    const h16* S16 = (const h16*)(a.ws + WS_S16); const float* SW = (const float*)(a.ws + WS_SW); const float* SCAL = (const float*)(a.ws + WS_SCAL); float* YR = (float*)(a.ws + WS_YR);
    float* buf = (float*)lds;
    for (int it = blockIdx.x; it < 256; it += gridDim.x) {
        asm volatile("" : "+v"(tid), "+v"(lane));
        const int bh = it >> 2, rg = it & 3, b = bh >> 2, h = bh & 3;
        const size_t tokb = (size_t)b * T;
        if (wave >= 4) scan_load(S16, SW, SCAL, tokb, h, rg, buf, tid - 256);
        __syncthreads();
        const int rowl = (wave & 3) * 4 + (lane >> 4), jq = lane & 15;
        f32x4 S = {0.f, 0.f, 0.f, 0.f}; float yk = 0.f;
        float* yout = YR + (tokb + jq) * 256 + h * 64 + rg * 16 + rowl;
        for (int ch = 0; ch < SC_NCH; ++ch) {
            if (wave >= 4) { if (ch + 1 < SC_NCH) scan_load(S16, SW, SCAL, tokb + (size_t)(ch + 1) * SC_CH, h, rg, buf + ((ch + 1) & 1) * SC_CH * SC_REC, tid - 256); }
            else {
                const float* src = buf + (ch & 1) * SC_CH * SC_REC;
                ScanOps A, B;
                scan_ld(A, src, jq, rowl);
#pragma unroll
                for (int s = 0; s < SC_CH; s += 2) {
                    scan_ld(B, src + (s + 1) * SC_REC, jq, rowl);
                    scan_step(S, yk, A, jq, s);
                    if (s + 2 < SC_CH) scan_ld(A, src + (s + 2) * SC_REC, jq, rowl);
                    scan_step(S, yk, B, jq, s + 1);
                    if ((s & 15) == 14) yout[(size_t)(ch * SC_CH + (s & 16)) * 256] = yk;
                }
            }
            __syncthreads();
        }
    }
}

constexpr int AT_KP = 72;
__device__ __forceinline__ void attn_issue(const bf16* P, const bf16* VT, size_t rowk0, size_t vtb, int h, int tid, u32x4 (&kr)[2], u32x4 (&vr)[2]) {
#pragma unroll
    for (int i = 0; i < 2; ++i) {
        kr[i] = *(const u32x4*)(P + (rowk0 + ((tid >> 3) & 63)) * NIN + 1536 + (h * 2 + i) * 64 + (tid & 7) * 8);
        vr[i] = *(const u32x4*)(VT + vtb + (size_t)((tid >> 3) + 64 * i) * T + (tid & 7) * 8); }
}
__device__ __forceinline__ void attn_store(bf16* Kl, int tid, const u32x4 (&kr)[2], const u32x4 (&vr)[2]) {
#pragma unroll
    for (int i = 0; i < 2; ++i) {
        *(u32x4*)(Kl + i * 64 * AT_KP + ((tid >> 3) & 63) * AT_KP + (tid & 7) * 8) = kr[i];
        *(u32x4*)(Kl + 2 * 64 * AT_KP + ((tid >> 3) + 64 * i) * AT_KP + (tid & 7) * 8) = vr[i]; }
}
constexpr int AT_BUF = (2 * 64 + 128) * AT_KP;
__device__ __forceinline__ void attn_tile(const bf16* Lb, int kt, bool diag, int r, int g, int tq, float slope2, float bsh, const bf16x8* qb, f32x4 (&O)[2][8], float (&lsum)[2]) {
    const bf16* K0 = Lb; const bf16* K1 = Lb + 64 * AT_KP; const bf16* Vt = Lb + 2 * 64 * AT_KP;
    bf16x8 kf0[4][2], kf1[4][2];
#pragma unroll
    for (int k4 = 0; k4 < 4; ++k4)
#pragma unroll
        for (int ks = 0; ks < 2; ++ks) { kf0[k4][ks] = *(const bf16x8*)(K0 + (k4 * 16 + r) * AT_KP + ks * 32 + g * 8); kf1[k4][ks] = *(const bf16x8*)(K1 + (k4 * 16 + r) * AT_KP + ks * 32 + g * 8); }
    bf16x8 qf[2][2];
#pragma unroll
    for (int c = 0; c < 2; ++c)
#pragma unroll
        for (int ks = 0; ks < 2; ++ks) qf[c][ks] = qb[(c * 2 + ks) * 64];
    f32x4 init[4];
    if (diag) {
#pragma unroll
        for (int k4 = 0; k4 < 4; ++k4)
#pragma unroll
            for (int j = 0; j < 4; ++j) init[k4][j] = -slope2 * fabsf((float)(tq - (kt * 64 + k4 * 16 + 4 * g + j))) - bsh;
    } else {
        const float base = slope2 * (float)(kt * 64 + 4 * g - tq) - bsh;
#pragma unroll
        for (int k4 = 0; k4 < 4; ++k4)
#pragma unroll
            for (int j = 0; j < 4; ++j) init[k4][j] = fmaf(slope2, (float)(k4 * 16 + j), base);
    }
    __builtin_amdgcn_sched_barrier(0);
    f32x4 s0[4], s1[4];
#pragma unroll
    for (int k4 = 0; k4 < 4; ++k4) { s0[k4] = mfma16(kf0[k4][0], qf[0][0], init[k4]); s1[k4] = mfma16(kf1[k4][0], qf[1][0], init[k4]); }
#pragma unroll
    for (int k4 = 0; k4 < 4; ++k4) { s0[k4] = mfma16(kf0[k4][1], qf[0][1], s0[k4]); s1[k4] = mfma16(kf1[k4][1], qf[1][1], s1[k4]); }
    bf16x8 vf0[8], vf1[8];
#pragma unroll
    for (int nt = 0; nt < 8; ++nt) { vf0[nt] = *(const bf16x8*)(Vt + (nt * 16 + r) * AT_KP + g * 8); vf1[nt] = *(const bf16x8*)(Vt + (nt * 16 + r) * AT_KP + 32 + g * 8); }
    __builtin_amdgcn_sched_barrier(0);
    float p0 = 0.f, p1 = 0.f;
#pragma unroll
    for (int k4 = 0; k4 < 4; ++k4)
#pragma unroll
        for (int j = 0; j < 4; ++j) { s0[k4][j] = __builtin_amdgcn_exp2f(s0[k4][j]); p0 += s0[k4][j]; s1[k4][j] = __builtin_amdgcn_exp2f(s1[k4][j]); p1 += s1[k4][j]; }
    lsum[0] += p0; lsum[1] += p1;
    u32x4 a0, a1, b0, b1;
    a0.x = pg8::cvt_pk_bf16(s0[0][0], s0[0][1]); a0.y = pg8::cvt_pk_bf16(s0[0][2], s0[0][3]); a0.z = pg8::cvt_pk_bf16(s0[1][0], s0[1][1]); a0.w = pg8::cvt_pk_bf16(s0[1][2], s0[1][3]);
    a1.x = pg8::cvt_pk_bf16(s0[2][0], s0[2][1]); a1.y = pg8::cvt_pk_bf16(s0[2][2], s0[2][3]); a1.z = pg8::cvt_pk_bf16(s0[3][0], s0[3][1]); a1.w = pg8::cvt_pk_bf16(s0[3][2], s0[3][3]);
    b0.x = pg8::cvt_pk_bf16(s1[0][0], s1[0][1]); b0.y = pg8::cvt_pk_bf16(s1[0][2], s1[0][3]); b0.z = pg8::cvt_pk_bf16(s1[1][0], s1[1][1]); b0.w = pg8::cvt_pk_bf16(s1[1][2], s1[1][3]);
    b1.x = pg8::cvt_pk_bf16(s1[2][0], s1[2][1]); b1.y = pg8::cvt_pk_bf16(s1[2][2], s1[2][3]); b1.z = pg8::cvt_pk_bf16(s1[3][0], s1[3][1]); b1.w = pg8::cvt_pk_bf16(s1[3][2], s1[3][3]);
    const bf16x8 A0 = __builtin_bit_cast(bf16x8, a0), A1 = __builtin_bit_cast(bf16x8, a1), B0 = __builtin_bit_cast(bf16x8, b0), B1 = __builtin_bit_cast(bf16x8, b1);
#pragma unroll
    for (int nt = 0; nt < 8; ++nt) { O[0][nt] = mfma16(vf0[nt], A0, O[0][nt]); O[1][nt] = mfma16(vf0[nt], B0, O[1][nt]); }
#pragma unroll
    for (int nt = 0; nt < 8; ++nt) { O[0][nt] = mfma16(vf1[nt], A1, O[0][nt]); O[1][nt] = mfma16(vf1[nt], B1, O[1][nt]); }
}
__device__ __forceinline__ void attn_unit(const Args& a, int l, float lam, float one_m_li, float bsh, int b, int h, int p, unsigned char* lds, int tid, int wave, int lane) {
    asm volatile("" : "+v"(tid), "+v"(lane));
    const bf16* P = (const bf16*)(a.ws + WS_P); const bf16* VT = (const bf16*)(a.ws + WS_VT); bf16* Y = (bf16*)(a.ws + WS_Y);
    bf16* L0 = (bf16*)lds;
    const int r = lane & 15, g = lane >> 4;
    const int qc = 2 * p + (wave >> 2), nt_all = 2 * p + 2;
    const int tq = 128 * p + 16 * wave + r; const size_t rowb = (size_t)b * T; const size_t vtb = ((size_t)b * 4 + h) * 128 * T;
    const float slope2 = exp2f(-2.f * (float)(h + 1)) * 1.4426950408889634f;
    bf16x8* qb = (bf16x8*)(lds + 2 * AT_BUF * 2) + wave * 256 + lane;
#pragma unroll
    for (int c = 0; c < 2; ++c)
#pragma unroll
        for (int ks = 0; ks < 2; ++ks) qb[(c * 2 + ks) * 64] = *(const bf16x8*)(P + (rowb + tq) * NIN + 1024 + (h * 2 + c) * 64 + ks * 32 + g * 8);
    float lsum[2] = {0.f, 0.f};
    f32x4 O[2][8];
#pragma unroll
    for (int nt = 0; nt < 8; ++nt) { O[0][nt] = (f32x4){0.f, 0.f, 0.f, 0.f}; O[1][nt] = O[0][nt]; }
    u32x4 kr[2], vr[2];
    attn_issue(P, VT, rowb, vtb, h, tid, kr, vr);
    attn_store(L0, tid, kr, vr);
    attn_issue(P, VT, rowb + 64, vtb + 64, h, tid, kr, vr);
    __syncthreads();
    for (int kt = 0; kt < nt_all; ++kt) {
        if (kt + 1 < nt_all) { attn_store(L0 + ((kt + 1) & 1) * AT_BUF, tid, kr, vr);
            if (kt + 2 < nt_all) attn_issue(P, VT, rowb + (size_t)(kt + 2) * 64, vtb + (size_t)(kt + 2) * 64, h, tid, kr, vr); }
        if (kt <= qc) attn_tile(L0 + (kt & 1) * AT_BUF, kt, kt == qc, r, g, tq, slope2, bsh, qb, O, lsum);
        __syncthreads();
    }
    float l0 = lsum[0], l1 = lsum[1];
    l0 += shx(l0, 16); l0 += shx(l0, 32); l1 += shx(l1, 16); l1 += shx(l1, 32);
    const float i0 = 1.f / l0, i1 = lam / l1;
    float ss = 0.f;
#pragma unroll
    for (int nt = 0; nt < 8; ++nt)
#pragma unroll
        for (int j = 0; j < 4; ++j) { const float o = O[0][nt][j] * i0 - O[1][nt][j] * i1; O[0][nt][j] = o; ss += o * o; }
    ss += shx(ss, 16); ss += shx(ss, 32);
    const float sc = rsqrtf(ss * (1.f / 128.f) + 1e-6f) * one_m_li;
    const float* sg = inp(a, 23) + l * 128;
    bf16* yp = Y + (rowb + tq) * 1024 + 256 + h * 128;
#pragma unroll
    for (int nt = 0; nt < 8; ++nt) { const int v0 = nt * 16 + 4 * g; const f32x4 gg = *(const f32x4*)(sg + v0);
        u32x2 w; w.x = pk2(O[0][nt][0] * sc * gg[0], O[0][nt][1] * sc * gg[1]); w.y = pk2(O[0][nt][2] * sc * gg[2], O[0][nt][3] * sc * gg[3]);
        *(u32x2*)(yp + v0) = w; }
}
constexpr int SA_CH = 16, SA_NCH = T / SA_CH, SA_TICKS = 132;
constexpr int SA_SCB = 0, SA_KV = 2 * SA_CH * SC_REC * 4, SA_STAGE = 32768, SA_QB = SA_KV + 2 * SA_STAGE;
static_assert(SA_QB + 4 * 4096 <= LDS_CTL, "LDS map of the fused scan/attention phase");
#define SA_BAR() do { asm volatile("s_waitcnt vmcnt(0) lgkmcnt(0)" ::: "memory"); __builtin_amdgcn_s_barrier(); asm volatile("" ::: "memory"); } while (0)
#define SA_BAR_L() do { asm volatile("s_waitcnt lgkmcnt(0)" ::: "memory"); __builtin_amdgcn_s_barrier(); asm volatile("" ::: "memory"); } while (0)
__device__ __forceinline__ void role_bar(volatile LAS unsigned* cnt, unsigned& target, int lane, bool drain_vm) {
    if (drain_vm) asm volatile("s_waitcnt vmcnt(0) lgkmcnt(0)" ::: "memory"); else asm volatile("s_waitcnt lgkmcnt(0)" ::: "memory");
    target += 4u;
    if (lane == 0) __hip_atomic_fetch_add((LAS unsigned*)cnt, 1u, __ATOMIC_RELAXED, __HIP_MEMORY_SCOPE_WORKGROUP);
    unsigned spins = 0u;
    for (;;) { const unsigned v = (unsigned)__builtin_amdgcn_readfirstlane((int)*cnt); if (v >= target || ++spins > (1u << 18)) break; __builtin_amdgcn_s_sleep(1); }
    asm volatile("s_waitcnt lgkmcnt(0)" ::: "memory");
}
struct ScanPre { h16x8 a0, a1, v; f32x4 w; float sc; };
__device__ __forceinline__ void scanpre_issue(ScanPre& p, const h16* S16, const float* SW, const float* SCAL, size_t tok0, int h, int rg, int stid) {
    constexpr size_t ARR = (size_t)M * 256;
    const int ps = stid >> 7, sq = stid & 127, s = sq >> 3, q = sq & 7;
    const h16* bp = S16 + (size_t)(2 * ps) * ARR + (tok0 + s) * 256 + h * 64 + q * 8;
    p.a0 = *(const h16x8*)bp; p.a1 = *(const h16x8*)(bp + ARR);
    p.w = *(const f32x4*)(SW + (tok0 + (stid >> 4)) * 256 + h * 64 + (stid & 15) * 4);
    if (stid < 32) p.v = *(const h16x8*)(S16 + 4 * ARR + (tok0 + (stid >> 1)) * 256 + h * 64 + rg * 16 + (stid & 1) * 8);
    else if (stid < 64) p.sc = SCAL[((tok0 + ((stid - 32) >> 1)) * 4 + h) * 4 + (stid & 1)];
}
__device__ __forceinline__ void scanpre_store(const ScanPre& p, float* dst, int stid) {
    const int ps = stid >> 7, sq = stid & 127, s = sq >> 3, q = sq & 7;
    float* rec = dst + s * SC_REC + q * 8 + (ps ? 192 : 0);
    st8(rec, p.a0); st8(rec + 64, p.a1);
    *(f32x4*)(dst + (stid >> 4) * SC_REC + 128 + (stid & 15) * 4) = p.w;
    if (stid < 32) st8(dst + (stid >> 1) * SC_REC + 320 + (stid & 1) * 8, p.v);
    else if (stid < 64) dst[((stid - 32) >> 1) * SC_REC + 336 + (stid & 1)] = p.sc;
}
__device__ __forceinline__ void attn_dma(const bf16* P, const bf16* VT, size_t rowk, size_t vtk, int h, int aw, int lane, LAS unsigned char* stage) {
    const int q = (lane & 7) ^ ((lane >> 3) & 7);
    const char* ub; unsigned voff, kstride;
    if (aw < 2) { ub = (const char*)(P + rowk * NIN + 1536 + (h * 2 + aw) * 64); voff = (unsigned)(((lane >> 3) * NIN + q * 8) * 2); kstride = 8u * NIN * 2u; }
    else { ub = (const char*)(VT + vtk + (size_t)(aw - 2) * 64 * T); voff = (unsigned)(((lane >> 3) * T + q * 8) * 2); kstride = 8u * T * 2u; }
#pragma unroll
    for (int k = 0; k < 8; ++k)
        __builtin_amdgcn_global_load_lds((const unsigned*)(ub + (size_t)k * kstride + voff), (LAS unsigned*)(stage + aw * 8192 + k * 1024), 16, 0, 0);
}
__device__ __forceinline__ void attn_tile_sw(const unsigned char* Lb, int kt, bool diag, int r, int g, int tq, float slope2, float bsh, const bf16x8* qb, f32x4 (&O)[2][8], float (&lsum)[2]) {
    const int r7 = r & 7;
    bf16x8 kf0[4][2], kf1[4][2];
#pragma unroll
    for (int k4 = 0; k4 < 4; ++k4)
#pragma unroll
        for (int ks = 0; ks < 2; ++ks) { const int off = ((k4 * 16 + r) * 8 + ((ks * 4 + g) ^ r7)) * 16; kf0[k4][ks] = *(const bf16x8*)(Lb + off); kf1[k4][ks] = *(const bf16x8*)(Lb + 8192 + off); }
    bf16x8 qf[2][2];
#pragma unroll
    for (int c = 0; c < 2; ++c)
#pragma unroll
        for (int ks = 0; ks < 2; ++ks) if (c * 2 + ks < 3) qf[c][ks] = qb[(c * 2 + ks) * 64];
    f32x4 init[4];
    if (diag) {
#pragma unroll
        for (int k4 = 0; k4 < 4; ++k4)
#pragma unroll
            for (int j = 0; j < 4; ++j) init[k4][j] = -slope2 * fabsf((float)(tq - (kt * 64 + k4 * 16 + 4 * g + j))) - bsh;
    } else {
        const float base = slope2 * (float)(kt * 64 + 4 * g - tq) - bsh;
#pragma unroll
        for (int k4 = 0; k4 < 4; ++k4)
#pragma unroll
            for (int j = 0; j < 4; ++j) init[k4][j] = fmaf(slope2, (float)(k4 * 16 + j), base);
    }
    __builtin_amdgcn_sched_barrier(0);
    f32x4 s0[4], s1[4];
#pragma unroll
    for (int k4 = 0; k4 < 4; ++k4) { s0[k4] = mfma16(kf0[k4][0], qf[0][0], init[k4]); s1[k4] = mfma16(kf1[k4][0], qf[1][0], init[k4]); s0[k4] = mfma16(kf0[k4][1], qf[0][1], s0[k4]); }
    __builtin_amdgcn_sched_barrier(0);
    bf16x8 vf0[8], vf1[8];
#pragma unroll
    for (int nt = 0; nt < 8; ++nt) vf0[nt] = *(const bf16x8*)(Lb + 16384 + (nt * 16 + r) * 128 + ((g ^ r7) * 16));
    __builtin_amdgcn_sched_barrier(0);
    qf[1][1] = qb[3 * 64];
    float p0 = 0.f, p1 = 0.f;
    unsigned pa[8], pbk[8];
#pragma unroll
    for (int k4 = 0; k4 < 4; ++k4) {
        s1[k4] = mfma16(kf1[k4][1], qf[1][1], s1[k4]);
#pragma unroll
        for (int j = 0; j < 4; ++j) { s0[k4][j] = __builtin_amdgcn_exp2f(s0[k4][j]); p0 += s0[k4][j]; }
        pa[2 * k4] = pg8::cvt_pk_bf16(s0[k4][0], s0[k4][1]); pa[2 * k4 + 1] = pg8::cvt_pk_bf16(s0[k4][2], s0[k4][3]);
        __builtin_amdgcn_sched_barrier(0);
    }
    const bf16x8 A0 = __builtin_bit_cast(bf16x8, (u32x4){pa[0], pa[1], pa[2], pa[3]}), A1 = __builtin_bit_cast(bf16x8, (u32x4){pa[4], pa[5], pa[6], pa[7]});
#pragma unroll
    for (int nt = 0; nt < 8; ++nt) vf1[nt] = *(const bf16x8*)(Lb + 16384 + (nt * 16 + r) * 128 + (((4 + g) ^ r7) * 16));
    __builtin_amdgcn_sched_barrier(0);
#pragma unroll
    for (int k4 = 0; k4 < 4; ++k4) {
#pragma unroll
        for (int q = 0; q < 4; ++q) { const int nt = (4 * k4 + q) & 7; if (k4 < 2) O[0][nt] = mfma16(vf0[nt], A0, O[0][nt]); else O[0][nt] = mfma16(vf1[nt], A1, O[0][nt]); }
#pragma unroll
        for (int j = 0; j < 4; ++j) { s1[k4][j] = __builtin_amdgcn_exp2f(s1[k4][j]); p1 += s1[k4][j]; }
        pbk[2 * k4] = pg8::cvt_pk_bf16(s1[k4][0], s1[k4][1]); pbk[2 * k4 + 1] = pg8::cvt_pk_bf16(s1[k4][2], s1[k4][3]);
        __builtin_amdgcn_sched_barrier(0);
    }
    lsum[0] += p0; lsum[1] += p1;
    const bf16x8 B0 = __builtin_bit_cast(bf16x8, (u32x4){pbk[0], pbk[1], pbk[2], pbk[3]}), B1 = __builtin_bit_cast(bf16x8, (u32x4){pbk[4], pbk[5], pbk[6], pbk[7]});
#pragma unroll
    for (int nt = 0; nt < 8; ++nt) { O[1][nt] = mfma16(vf0[nt], B0, O[1][nt]); O[1][nt] = mfma16(vf1[nt], B1, O[1][nt]); }
}
__device__ __forceinline__ void conv_role(const Args& a, int l, int b, int t0, unsigned char* base, int atid, int aw, int lane, volatile LAS unsigned* cnt, unsigned& target) {
    const bf16* P = (const bf16*)(a.ws + WS_P); bf16* Y = (bf16*)(a.ws + WS_Y);
    constexpr int HP = 264, OP = 260;
    bf16* hb = (bf16*)base;
    float* ob = (float*)(base + 62 * HP * 2);
    const size_t rowb = (size_t)b * T;
    { u32x4 hv_[8];
#pragma unroll
        for (int i = 0; i < 8; ++i) { const int ch = atid + 256 * i, rr = ch >> 5, cc = ch & 31, t = t0 - 30 + rr; hv_[i] = (u32x4){0u, 0u, 0u, 0u};
            if (ch < 62 * 32 && t >= 0) hv_[i] = *(const u32x4*)(P + (rowb + t) * NIN + 2560 + cc * 8); }
#pragma unroll
        for (int i = 0; i < 8; ++i) { const int ch = atid + 256 * i, rr = ch >> 5, cc = ch & 31; if (ch < 62 * 32) *(u32x4*)(hb + rr * HP + cc * 8) = hv_[i]; } }
    role_bar(cnt, target, lane, true);
    const int cp = atid & 127, tg = atid >> 7;
    const float* cw = inp(a, 24) + (size_t)l * 31 * 256 + 2 * cp;
    const f32x2 cb = *(const f32x2*)(inp(a, 25) + l * 256 + 2 * cp);
    float acc0[16], acc1[16];
#pragma unroll
    for (int i = 0; i < 16; ++i) { acc0[i] = cb[0]; acc1[i] = cb[1]; }
    f32x2 wv[31];
#pragma unroll
    for (int w = 0; w < 31; ++w) wv[w] = *(const f32x2*)(cw + w * 256);
#pragma unroll
    for (int rho = 0; rho < 46; ++rho) { const unsigned hv = *(const unsigned*)(hb + (tg * 16 + rho) * HP + 2 * cp); const float h0 = bflo(hv), h1 = bfhi(hv);
#pragma unroll
        for (int i = 0; i < 16; ++i) { const int w = rho - i; if (w >= 0 && w < 31) { acc0[i] += h0 * wv[w][0]; acc1[i] += h1 * wv[w][1]; } } }
#pragma unroll
    for (int i = 0; i < 16; ++i) *(f32x2*)(ob + (tg * 16 + i) * OP + 2 * cp) = (f32x2){acc0[i], acc1[i]};
    role_bar(cnt, target, lane, true);
    const f32x4 lw = *(const f32x4*)(inp(a, 26) + l * 256 + 4 * lane), lb = *(const f32x4*)(inp(a, 27) + l * 256 + 4 * lane);
    for (int i = 0; i < 8; ++i) { const int tok = aw * 8 + i;
        const f32x4 x = *(const f32x4*)(ob + tok * OP + 4 * lane);
        const float mu = wave_sum((x[0] + x[1]) + (x[2] + x[3])) * (1.f / 256.f);
        const f32x4 d = x - mu;
        const float var = wave_sum((d[0] * d[0] + d[1] * d[1]) + (d[2] * d[2] + d[3] * d[3])) * (1.f / 256.f);
        const f32x4 y = d * rsqrtf(var + 1e-5f) * lw + lb;
        u32x2 w; w.x = pk2(y[0] * sigmoidf_(y[0]), y[1] * sigmoidf_(y[1])); w.y = pk2(y[2] * sigmoidf_(y[2]), y[3] * sigmoidf_(y[3]));
        *(u32x2*)(Y + (rowb + t0 + tok) * 1024 + 768 + 4 * lane) = w; }
    role_bar(cnt, target, lane, true);
}
__device__ __forceinline__ void phase_scan_attn(const Args& a, int l, unsigned char* lds, int tid, int wave, int lane) {
    for (int w0 = blockIdx.x; w0 < 256; w0 += gridDim.x) {
        asm volatile("" : "+v"(tid), "+v"(lane));
        const int w = (gridDim.x == 256) ? ((w0 & 7) * 32 + (w0 >> 3)) : w0;
        const int bh = w >> 2, sub = w & 3, b = bh >> 2, h = bh & 3;
        const size_t tokb = (size_t)b * T;
        volatile LAS unsigned* rcnt = (volatile LAS unsigned*)((LAS unsigned char*)lds + LDS_CTL - 64);
        if (tid < 8) rcnt[tid] = 0u;
        __syncthreads();
        unsigned rtarget = 0u;
        if (wave < 4) {
            const h16* S16 = (const h16*)(a.ws + WS_S16); const float* SW = (const float*)(a.ws + WS_SW); const float* SCAL = (const float*)(a.ws + WS_SCAL); float* YR = (float*)(a.ws + WS_YR);
            float* scb = (float*)(lds + SA_SCB);
            const int rg = sub, rowl = wave * 4 + (lane >> 4), jq = lane & 15;
            ScanPre pre; pre.a0 = (h16x8)(h16)0.f; pre.a1 = pre.a0; pre.v = pre.a0; pre.w = (f32x4){0.f, 0.f, 0.f, 0.f}; pre.sc = 0.f;
            scanpre_issue(pre, S16, SW, SCAL, tokb, h, rg, tid); scanpre_store(pre, scb, tid);
            role_bar(rcnt, rtarget, lane, false);
            f32x4 S = {0.f, 0.f, 0.f, 0.f}; float yk = 0.f;
            float* yout = YR + (tokb + jq) * 256 + h * 64 + rg * 16 + rowl;
#pragma unroll 1
            for (int i = 0; i < SA_TICKS; ++i) {
                if (i < SA_NCH) {
                    if (i + 1 < SA_NCH) scanpre_issue(pre, S16, SW, SCAL, tokb + (size_t)(i + 1) * SA_CH, h, rg, tid);
                    const float* src = scb + (i & 1) * SA_CH * SC_REC;
                    ScanOps A, B;
                    scan_ld(A, src, jq, rowl);
#pragma unroll
                    for (int s_ = 0; s_ < SA_CH; s_ += 2) {
                        scan_ld(B, src + (s_ + 1) * SC_REC, jq, rowl);
                        scan_step(S, yk, A, jq, s_);
                        if (s_ + 2 < SA_CH) scan_ld(A, src + (s_ + 2) * SC_REC, jq, rowl);
                        scan_step(S, yk, B, jq, s_ + 1);
                    }
                    yout[(size_t)(i * SA_CH) * 256] = yk;
                    if (i + 1 < SA_NCH) scanpre_store(pre, scb + ((i + 1) & 1) * SA_CH * SC_REC, tid);
                }
                role_bar(rcnt, rtarget, lane, false);
            }
        } else {
            const bf16* P = (const bf16*)(a.ws + WS_P); const bf16* VT = (const bf16*)(a.ws + WS_VT); bf16* Y = (bf16*)(a.ws + WS_Y);
            float s1 = 0.f, s2 = 0.f, mq = 0.f, mk = 0.f;
            for (int i = 0; i < 64; ++i) { s1 += inp(a, 19)[l * 64 + i] * inp(a, 20)[l * 64 + i]; s2 += inp(a, 21)[l * 64 + i] * inp(a, 22)[l * 64 + i];
                mq = fmaxf(mq, fabsf(inp(a, 17)[l * 64 + i])); mk = fmaxf(mk, fabsf(inp(a, 18)[l * 64 + i])); }
            const float li = __builtin_bit_cast(float, __builtin_amdgcn_readfirstlane(l == 0 ? 0x3e4ccccd : 0x3eb60549));
            const float lam = __builtin_bit_cast(float, __builtin_amdgcn_readfirstlane(__builtin_bit_cast(int, expf(s1) - expf(s2) + li))), one_m_li = 1.f - li;
            const float bsh = __builtin_bit_cast(float, __builtin_amdgcn_readfirstlane(__builtin_bit_cast(int, 8.f * mq * mk * 1.4426950408889634f)));
            const int aw = wave - 4, r = lane & 15, g = lane >> 4;
            const size_t vtb = ((size_t)b * 4 + h) * 128 * T;
            const float slope2 = exp2f(-2.f * (float)(h + 1)) * 1.4426950408889634f;
            LAS unsigned char* kv = (LAS unsigned char*)lds + SA_KV;
            bf16x8* qb = (bf16x8*)(lds + SA_QB) + aw * 256 + lane;
            const float* sg = inp(a, 23) + l * 128;
            attn_dma(P, VT, tokb, vtb, h, aw, lane, kv);
            role_bar(rcnt + 4, rtarget, lane, true);
            int ti = 0;
#pragma unroll 1
            for (int u = 0; u < 8; ++u) {
                const int pq = sub * 4 + (u >> 1), qc = (u & 1) ? 31 - pq : pq;
                const int pqn = sub * 4 + ((u + 1) >> 1);
                const int tq = qc * 64 + aw * 16 + r;
#pragma unroll
                for (int c = 0; c < 2; ++c)
#pragma unroll
                    for (int ks = 0; ks < 2; ++ks) qb[(c * 2 + ks) * 64] = *(const bf16x8*)(P + (tokb + tq) * NIN + 1024 + (h * 2 + c) * 64 + ks * 32 + g * 8);
                float lsum[2] = {0.f, 0.f};
                f32x4 O[2][8];
#pragma unroll
                for (int nt = 0; nt < 8; ++nt) { O[0][nt] = (f32x4){0.f, 0.f, 0.f, 0.f}; O[1][nt] = O[0][nt]; }
#pragma unroll 1
                for (int kt = 0; kt <= qc; ++kt) {
                    const int ktn = kt < qc ? kt + 1 : 0;
                    if (kt < qc || u < 7) attn_dma(P, VT, tokb + (size_t)ktn * 64, vtb + (size_t)ktn * 64, h, aw, lane, kv + ((ti + 1) & 1) * SA_STAGE);
                    attn_tile_sw((const unsigned char*)lds + SA_KV + (ti & 1) * SA_STAGE, kt, kt == qc, r, g, tq, slope2, bsh, qb, O, lsum);
                    if (kt == qc) {
                        float l0 = lsum[0], l1 = lsum[1];
                        l0 += shx(l0, 16); l0 += shx(l0, 32); l1 += shx(l1, 16); l1 += shx(l1, 32);
                        const float i0 = 1.f / l0, i1 = lam / l1;
                        float ss = 0.f;
#pragma unroll
                        for (int nt = 0; nt < 8; ++nt)
#pragma unroll
                            for (int j = 0; j < 4; ++j) { const float o = O[0][nt][j] * i0 - O[1][nt][j] * i1; O[0][nt][j] = o; ss += o * o; }
                        ss += shx(ss, 16); ss += shx(ss, 32);
                        const float sc = rsqrtf(ss * (1.f / 128.f) + 1e-6f) * one_m_li;
                        bf16* yp = Y + (tokb + tq) * 1024 + 256 + h * 128;
#pragma unroll
                        for (int nt = 0; nt < 8; ++nt) { const int v0 = nt * 16 + 4 * g; const f32x4 gg = *(const f32x4*)(sg + v0);
                            u32x2 wv; wv.x = pk2(O[0][nt][0] * sc * gg[0], O[0][nt][1] * sc * gg[1]); wv.y = pk2(O[0][nt][2] * sc * gg[2], O[0][nt][3] * sc * gg[3]);
                            *(u32x2*)(yp + v0) = wv; }
                    }
                    role_bar(rcnt + 4, rtarget, lane, true); ++ti;
                }
                (void)pqn;
            }
            for (int q = 0; q < 4; ++q) { const int cu = w * 4 + q; conv_role(a, l, cu >> 6, (cu & 63) * 32, lds + SA_KV, aw * 64 + lane, aw, lane, rcnt + 4, rtarget); }
        }
        __syncthreads();
    }
}
__device__ __forceinline__ void conv_unit(const Args& a, int l, int b, int t0, unsigned char* lds, int tid, int wave, int lane) {
    const bf16* P = (const bf16*)(a.ws + WS_P); bf16* Y = (bf16*)(a.ws + WS_Y);
    constexpr int HP = 264, OP = 260;
    bf16* hb = (bf16*)lds;
    float* ob = (float*)(lds + 94 * HP * 2);
    asm volatile("" : "+v"(tid), "+v"(lane));
    const size_t rowb = (size_t)b * T;
    for (int ch = tid; ch < 94 * 32; ch += 512) { const int rr = ch >> 5, cc = ch & 31; const int t = t0 - 30 + rr;
        u32x4 v = {0u, 0u, 0u, 0u};
        if (t >= 0) v = *(const u32x4*)(P + (rowb + t) * NIN + 2560 + cc * 8);
        *(u32x4*)(hb + rr * HP + cc * 8) = v; }
    __syncthreads();
    const int cp = tid & 127, tg = tid >> 7;
    const float* cw = inp(a, 24) + (size_t)l * 31 * 256 + 2 * cp;
    const f32x2 cb = *(const f32x2*)(inp(a, 25) + l * 256 + 2 * cp);
    float acc0[16], acc1[16];
#pragma unroll
    for (int i = 0; i < 16; ++i) { acc0[i] = cb[0]; acc1[i] = cb[1]; }
    f32x2 wv[31];
#pragma unroll
    for (int w = 0; w < 31; ++w) wv[w] = *(const f32x2*)(cw + w * 256);
#pragma unroll
    for (int rho = 0; rho < 46; ++rho) { const unsigned hv = *(const unsigned*)(hb + (tg * 16 + rho) * HP + 2 * cp); const float h0 = bflo(hv), h1 = bfhi(hv);
#pragma unroll
        for (int i = 0; i < 16; ++i) { const int w = rho - i; if (w >= 0 && w < 31) { acc0[i] += h0 * wv[w][0]; acc1[i] += h1 * wv[w][1]; } } }
#pragma unroll
    for (int i = 0; i < 16; ++i) *(f32x2*)(ob + (tg * 16 + i) * OP + 2 * cp) = (f32x2){acc0[i], acc1[i]};
    __syncthreads();
    const f32x4 lw = *(const f32x4*)(inp(a, 26) + l * 256 + 4 * lane), lb = *(const f32x4*)(inp(a, 27) + l * 256 + 4 * lane);
    for (int i = 0; i < 8; ++i) { const int tok = wave * 8 + i;
        const f32x4 x = *(const f32x4*)(ob + tok * OP + 4 * lane);
        const float mu = wave_sum((x[0] + x[1]) + (x[2] + x[3])) * (1.f / 256.f);
        const f32x4 d = x - mu;
        const float var = wave_sum((d[0] * d[0] + d[1] * d[1]) + (d[2] * d[2] + d[3] * d[3])) * (1.f / 256.f);
        const f32x4 y = d * rsqrtf(var + 1e-5f) * lw + lb;
        u32x2 w; w.x = pk2(y[0] * sigmoidf_(y[0]), y[1] * sigmoidf_(y[1])); w.y = pk2(y[2] * sigmoidf_(y[2]), y[3] * sigmoidf_(y[3]));
        *(u32x2*)(Y + (rowb + t0 + tok) * 1024 + 768 + 4 * lane) = w; }
    __syncthreads();
}
__device__ __forceinline__ void phase_mix(const Args& a, int l, unsigned char* lds, int tid, int wave, int lane) {
    const float* YR = (const float*)(a.ws + WS_YR); const h16* SV = (const h16*)(a.ws + WS_S16) + 4 * (size_t)M * 256; const bf16* G = (const bf16*)(a.ws + WS_G);
    const float* SCAL = (const float*)(a.ws + WS_SCAL); bf16* Y = (bf16*)(a.ws + WS_Y);
    const f32x4 lw = *(const f32x4*)(inp(a, 15) + l * 256 + 4 * lane), lb = *(const f32x4*)(inp(a, 16) + l * 256 + 4 * lane);
    const int gw = blockIdx.x * 8 + wave, NGW = gridDim.x * 8, tpw = ((M + NGW - 1) / NGW + 3) & ~3;
    const int tend = (gw + 1) * tpw < M ? (gw + 1) * tpw : M;
    for (int t0_ = gw * tpw; t0_ < tend; t0_ += 4) {
        f32x4 y[4]; h16x4 v[4]; u32x2 gv[4]; float bn[4];
#pragma unroll
        for (int i = 0; i < 4; ++i) { const size_t tok = (size_t)(t0_ + i);
            y[i] = *(const f32x4*)(YR + tok * 256 + 4 * lane); v[i] = *(const h16x4*)(SV + tok * 256 + 4 * lane); gv[i] = *(const u32x2*)(G + tok * 256 + 4 * lane);
            bn[i] = SCAL[(tok * 4 + (lane >> 4)) * 4 + 2]; }
#pragma unroll
        for (int i = 0; i < 4; ++i) {
            const float mu = rowsum16((y[i][0] + y[i][1]) + (y[i][2] + y[i][3])) * (1.f / 64.f);
            const f32x4 d = y[i] - mu;
            const float var = rowsum16((d[0] * d[0] + d[1] * d[1]) + (d[2] * d[2] + d[3] * d[3])) * (1.f / 64.f);
            const f32x4 yn = d * rsqrtf(var + 64e-5f) * lw + lb;
            u32x2 w; w.x = pk2((yn[0] + bn[i] * (float)v[i][0]) * bflo(gv[i].x), (yn[1] + bn[i] * (float)v[i][1]) * bfhi(gv[i].x));
            w.y = pk2((yn[2] + bn[i] * (float)v[i][2]) * bflo(gv[i].y), (yn[3] + bn[i] * (float)v[i][3]) * bfhi(gv[i].y));
            *(u32x2*)(Y + (size_t)(t0_ + i) * 1024 + 4 * lane) = w; }
    }
}

#define XB_TMO      128
#define XB_XCNT(j)  (256  + 64 * (j))
#define XB_XSUB(j)  (1280 + 64 * (j))
#define XB_XGEN(j)  (2304 + 64 * (j))
#define XB_TOP      3328
#define XB_TOPGEN   3392
#define XCD_BAR_WORDS 3456
#define XB_SPIN_CAP (1u << 18)

__device__ __forceinline__ unsigned xb_ld(unsigned* p)              { return __hip_atomic_load(p, __ATOMIC_RELAXED, __HIP_MEMORY_SCOPE_AGENT); }
__device__ __forceinline__ unsigned xb_add(unsigned* p, unsigned v) { return __hip_atomic_fetch_add(p, v, __ATOMIC_RELAXED, __HIP_MEMORY_SCOPE_AGENT); }
__device__ __forceinline__ unsigned xb_xcc_id() { return (unsigned)__builtin_amdgcn_s_getreg((3 << 11) | 20) & 0xFu; }
#define XB_SPIN(cond, bar) do { unsigned _sp = 0; while (cond) { __builtin_amdgcn_s_sleep(1); \
    if ((++_sp & 255u) == 0u) { if (xb_ld(&(bar)[XB_TMO])) break; if (_sp > XB_SPIN_CAP) { atomicAdd(&(bar)[XB_TMO], 1u); break; } } } } while (0)

struct XcdBarrier {
    unsigned* bar; unsigned x;
    volatile LAS unsigned* st;
};

__device__ __forceinline__ XcdBarrier xcd_barrier_post(unsigned* bar, volatile LAS unsigned* st) {
    XcdBarrier b; b.bar = bar; b.x = xb_xcc_id(); b.st = st;
    if (threadIdx.x == 0) (void)xb_add(&bar[XB_XCNT(b.x)], 1u);
    return b;
}
__device__ __forceinline__ void xcd_barrier_complete(unsigned* bar, unsigned x, unsigned& nloc, unsigned& nx) {
    const unsigned G = gridDim.x * gridDim.y * gridDim.z;
    unsigned sum, cnt, mine, sp = 0u;
    for (;;) {
        sum = 0u; cnt = 0u; mine = 0u;
#pragma unroll
        for (unsigned j = 0; j < 16; ++j) { const unsigned c = xb_ld(&bar[XB_XCNT(j)]); sum += c; cnt += (c > 0u) ? 1u : 0u; mine = (j == x) ? c : mine; }
        if (sum == G) break;
        __builtin_amdgcn_s_sleep(1);
        if ((++sp & 255u) == 0u) { if (xb_ld(&bar[XB_TMO])) break; if (sp > XB_SPIN_CAP) { atomicAdd(&bar[XB_TMO], 1u); break; } }
    }
    nloc = mine > 0u ? mine : 1u; nx = cnt > 0u ? cnt : 1u;
}

__device__ __forceinline__ void xcd_barrier(const XcdBarrier& b) {
    asm volatile("s_waitcnt vmcnt(0)" ::: "memory");
    __syncthreads();
    if (threadIdx.x == 0) {
        unsigned* bar = b.bar;
        __builtin_amdgcn_s_waitcnt(0);
        unsigned nloc = b.st[0], nx = b.st[1];
        if (nloc == 0u) { xcd_barrier_complete(bar, b.x, nloc, nx); b.st[0] = nloc; b.st[1] = nx; }
        const unsigned old = xb_add(&bar[XB_XSUB(b.x)], 1u);
        const unsigned gen = old / nloc;
        if (old + 1u == (gen + 1u) * nloc) {
            __builtin_amdgcn_fence(__ATOMIC_RELEASE, "agent");
            asm volatile("s_waitcnt vmcnt(0)" ::: "memory");
            const unsigned og = xb_add(&bar[XB_TOP], 1u);
            const unsigned tg = og / nx;
            if (og + 1u == (tg + 1u) * nx) xb_add(&bar[XB_TOPGEN], 1u);
            else XB_SPIN(xb_ld(&bar[XB_TOPGEN]) == tg, bar);
            __builtin_amdgcn_fence(__ATOMIC_ACQUIRE, "agent");
            xb_add(&bar[XB_XGEN(b.x)], 1u);
            asm volatile("s_waitcnt vmcnt(0)" ::: "memory");
        } else {
            XB_SPIN(xb_ld(&bar[XB_XGEN(b.x)]) == gen, bar);
            __builtin_amdgcn_fence(__ATOMIC_ACQUIRE, "agent");
            asm volatile("s_waitcnt vmcnt(0)" ::: "memory");
        }
    }
    __syncthreads();
}

__global__ void __launch_bounds__(512, 2) mk_fwd(Args a) {
    extern __shared__ __attribute__((aligned(16))) unsigned char lds[];
    cg::grid_group grid = cg::this_grid();
    const int wave_s = __builtin_amdgcn_readfirstlane((int)threadIdx.x >> 6);
#define TIDS int lane_ = __builtin_amdgcn_mbcnt_hi(~0u, __builtin_amdgcn_mbcnt_lo(~0u, 0u)); asm volatile("" : "+v"(lane_)); const int lane = lane_, wave = wave_s; int tid = wave * 64 + lane; (void)lane; (void)wave; (void)tid
    unsigned* barw = (unsigned*)(a.ws + WS_BAR);
    if (a.ph_lo == 0 && blockIdx.x == 0) for (int i = threadIdx.x; i < XCD_BAR_WORDS; i += 512) barw[i] = 0u;
    if (threadIdx.x < 2) ((volatile LAS unsigned*)(lds + LDS_CTL))[threadIdx.x] = 0u;
    __syncthreads();
    XcdBarrier xbar; xbar.bar = barw; xbar.x = 0; xbar.st = (volatile LAS unsigned*)(lds + LDS_CTL);
    bool posted = false;
    if (a.ph_lo == 0 && a.ph_hi > 1) { grid.sync(); xbar = xcd_barrier_post(barw, (volatile LAS unsigned*)(lds + LDS_CTL)); posted = true; }
#pragma unroll 1
    for (int ph = a.ph_lo; ph < a.ph_hi; ++ph) {
        if (ph == 0) { { TIDS; phase_weights(a, lds, wave, lane); } __syncthreads(); { TIDS; phase_ada(a, lds, tid, wave, lane); } }
        else {
            const int l = (ph - 1) / 9, k = (ph - 1) % 9;
            const float* modl = (const float*)(a.ws + WS_MOD) + (size_t)l * 16 * 6144;
            if (k == 6 || (k == 0 && l == 1)) continue;
            if (k == 1 || k == 5 || k == 7 || k == 8) {
                const unsigned char* wb = a.ws + WS_WB + (size_t)l * WB_LAYER;
                pg8::Gemm g; pg8::EpiDyn E; E.O = nullptr; E.ldc = 0; E.base = nullptr; E.out = nullptr; E.gate = nullptr;
                E.ssq_in = nullptr; E.bias = nullptr; E.bstride = 0; E.rtab = nullptr; E.XS = nullptr; E.ssq_out = nullptr; E.gn = nullptr; E.scv = nullptr;
                const float* BIAS = (const float*)(a.ws + WS_BIAS);
                if (k == 1) { g.A = (const bf16*)(a.ws + WS_XN); g.Bt = (const bf16*)(wb + WB_IN); g.N = NIN; g.K = D; E.kind = 0; E.O = (bf16*)(a.ws + WS_P); E.ldc = NIN;
                    if (l == 1) { E.ssq_in = (const float*)(a.ws + WS_SSQA); E.bias = BIAS; E.bstride = NIN; } }
                else if (k == 5) { g.A = (const bf16*)(a.ws + WS_Y); g.Bt = (const bf16*)(wb + WB_OUT); g.N = D; g.K = D; E.kind = 2; E.base = l == 0 ? inp(a, 0) : a.out; E.out = a.out; E.gate = modl + 2048;
                    E.XS = (bf16*)(a.ws + WS_XN); E.ssq_out = (float*)(a.ws + WS_SSQB); E.gn = inp(a, 29) + l * 1024; E.scv = modl + 4096; }
                else if (k == 7) { g.A = (const bf16*)(a.ws + WS_XN); g.Bt = (const bf16*)(wb + WB_W1); g.N = FF; g.K = D; E.kind = 1; E.O = (bf16*)(a.ws + WS_H); E.ldc = FF;
                    E.ssq_in = (const float*)(a.ws + WS_SSQB); E.bias = BIAS + 16 * NIN + (size_t)l * 16 * FF; E.bstride = FF; }
                else { g.A = (const bf16*)(a.ws + WS_H); g.Bt = (const bf16*)(wb + WB_W2); g.N = D; g.K = FF; E.kind = 2; E.base = a.out; E.out = a.out; E.gate = modl + 5120;
                    if (l == 0) { E.XS = (bf16*)(a.ws + WS_XN); E.ssq_out = (float*)(a.ws + WS_SSQA); E.gn = inp(a, 4) + 1024; E.scv = (const float*)(a.ws + WS_MOD) + (size_t)16 * 6144 + 1024; } }
                g.M = M;
                pg8::StaticOrder S; S.init(M, g.N, gridDim.x, blockIdx.x);
                E.rtab = (const LAS float*)((LAS unsigned char*)lds + 131072);
                if (E.ssq_in) { TIDS;
                    LAS float* rt = (LAS float*)((LAS unsigned char*)lds + 131072);
                    f32x4 sq_[4][4]; bool ok_[4];
#pragma unroll
                    for (int i = 0; i < 4; ++i) { const int idx = tid + 512 * i; pg8::Unit u_; ok_[i] = S.next(idx >> 8, u_);
                        const f32x4* sp = (const f32x4*)(E.ssq_in + (size_t)((ok_[i] ? u_.pm : 0) * 256 + (idx & 255)) * 16);
#pragma unroll
                        for (int q = 0; q < 4; ++q) sq_[i][q] = sp[q]; }
#pragma unroll
                    for (int i = 0; i < 4; ++i) { const f32x4 t = (sq_[i][0] + sq_[i][1]) + (sq_[i][2] + sq_[i][3]);
                        if (ok_[i]) rt[tid + 512 * i] = rsqrtf(((t[0] + t[1]) + (t[2] + t[3])) * (1.f / 1024.f) + 1e-6f); }
                    __syncthreads(); }
                { TIDS; pg8::gemm_phase<pg8::EpiDyn, pg8::StaticOrder, true, true>((LAS unsigned char*)lds, g, S, E, tid); }
            }
            else if (k == 0) { TIDS; phase_xn(inp(a, 0), inp(a, 4), modl, 0, 1024, (bf16*)(a.ws + WS_XN), wave, lane); phase_bias(a, wave, lane); }
            else if (k == 2) { TIDS; phase_premix(a, l, lds, tid, wave, lane); }
            else if (k == 3) { TIDS; phase_scan_attn(a, l, lds, tid, wave, lane); }
            else { TIDS; phase_mix(a, l, lds, tid, wave, lane); }
        }
        if (ph + 1 < a.ph_hi) {
            if (!posted) { grid.sync(); xbar = xcd_barrier_post(barw, (volatile LAS unsigned*)(lds + LDS_CTL)); posted = true; }
            else xcd_barrier(xbar);
        }
    }
}

#ifndef MK_MULTI
#define MK_MULTI 0
#endif
extern "C" void kernel_launch(void* const* d_in, const int* in_sizes, int n_in, void* d_out, int out_size, void* d_ws, size_t ws_size, hipStream_t stream) {
    static int grid = 0;
    if (grid == 0) {
        if (n_in != 32 || out_size != M * D || ws_size < WS_END) { fprintf(stderr, "kernel_launch: unexpected shapes (n_in %d out %d ws %zu)\n", n_in, out_size, ws_size); grid = -1; return; }
        int dev = 0, cus = 0, per_cu = 0;
        (void)hipGetDevice(&dev); (void)hipDeviceGetAttribute(&cus, hipDeviceAttributeMultiprocessorCount, dev);
        (void)hipFuncSetAttribute((const void*)mk_fwd, hipFuncAttributeMaxDynamicSharedMemorySize, LDS_BYTES);
        (void)hipOccupancyMaxActiveBlocksPerMultiprocessor(&per_cu, (const void*)mk_fwd, 512, LDS_BYTES);
        if (per_cu < 1) { fprintf(stderr, "kernel_launch: occupancy query says %d blocks per CU\n", per_cu); per_cu = 1; }
        grid = cus * per_cu;
        (void)hipGetLastError();
    }
    if (grid < 0) return;
    Args a{};
    for (int i = 0; i < 32; ++i) a.in[i] = (const float*)d_in[i];
    a.out = (float*)d_out; a.ws = (unsigned char*)d_ws;
#if MK_MULTI
    for (int p = 0; p < 19; ++p) { a.ph_lo = p; a.ph_hi = p + 1; hipLaunchKernelGGL(mk_fwd, dim3(grid), dim3(512), LDS_BYTES, stream, a); }
#else
    a.ph_lo = 0; a.ph_hi = 19;
    void* args[] = {&a};
    hipError_t e = hipLaunchCooperativeKernel((const void*)mk_fwd, dim3(grid), dim3(512), args, LDS_BYTES, stream);
    if (e != hipSuccess) fprintf(stderr, "cooperative launch failed: %s (grid %d)\n", hipGetErrorString(e), grid);
#endif
}
```
